# Optimizing an MI355X kernel written in HIP

```python
import jax, jax.numpy as jnp
from jax import lax
import numpy as np

D_MODEL = 1024
BATCH = 8
SEQ = 4096
DEPTH = 1

HEAD_DIM = 64
FOX_HEADS = 8
NSA_HEADS = 8
NSA_GROUPS = 2
NSA_HPG = NSA_HEADS // NSA_GROUPS
BRANCH_WIDTH = 512
N_BRANCH = 2
N_NSA_BRANCH = 3
ROPE_DIM = HEAD_DIM // 4
ROPE_THETA = 500000.0
Q_BLOCK = 128
CMP_LEN = 32
CMP_STRIDE = 16
CMP_HIDDEN = 2 * HEAD_DIM
SLC_LEN = 64
SLC_TOP = 16
WINDOW = 512
FORGET_BIAS_INIT = 4.0
FORCED_SCORE = 1e9
NEG_INF = -1e30
PEER_HEADS = 8
N_KEYS = 128
N_EXPERTS = N_KEYS * N_KEYS
PEER_QDIM = 256
PEER_TOPK = 16
PEER_CHUNK = 128
RMS_EPS = 1e-6

KV_WIDTH = NSA_GROUPS * HEAD_DIM
IN_SPLITS = (BRANCH_WIDTH, BRANCH_WIDTH, BRANCH_WIDTH, FOX_HEADS, BRANCH_WIDTH,
             KV_WIDTH, KV_WIDTH, KV_WIDTH, KV_WIDTH, KV_WIDTH, KV_WIDTH,
             NSA_HEADS * N_NSA_BRANCH, N_BRANCH * D_MODEL)
D_IN = sum(IN_SPLITS)

kernel_name = "fox_nsa_gated_hybrid_peer"


def rmsnorm(x, g):
    xf = x.astype(jnp.float32)
    y = xf * lax.rsqrt(jnp.mean(xf * xf, axis=-1, keepdims=True) + RMS_EPS)
    return (y * g.astype(jnp.float32)).astype(x.dtype)


def split_columns(t, sizes):
    offs = np.cumsum((0,) + tuple(sizes))
    return [t[..., int(a):int(b)] for a, b in zip(offs[:-1], offs[1:])]


def rope_tables(pos):
    inv = jnp.power(ROPE_THETA, -jnp.arange(0, ROPE_DIM, 2, dtype=jnp.float32) / ROPE_DIM)
    ang = pos[:, None] * inv[None, :]
    return jnp.cos(ang), jnp.sin(ang)


def apply_partial_rope(x, cos, sin):
    half = ROPE_DIM // 2
    xr = x[..., :ROPE_DIM].astype(jnp.float32)
    x1, x2 = xr[..., :half], xr[..., half:]
    c, s = cos[:, None, :], sin[:, None, :]
    rot = jnp.concatenate([x1 * c - x2 * s, x1 * s + x2 * c], axis=-1)
    return jnp.concatenate([rot.astype(x.dtype), x[..., ROPE_DIM:]], axis=-1)


def fox_attention(q, k, v, log_f):
    B_, S_, H, Dh = q.shape
    scale = Dh ** -0.5
    c = jnp.swapaxes(jnp.cumsum(log_f, axis=1), 1, 2)
    k_pos = jnp.arange(S_)

    def block(i):
        q0 = i * Q_BLOCK
        q_pos = q0 + jnp.arange(Q_BLOCK)
        qb = lax.dynamic_slice_in_dim(q, q0, Q_BLOCK, axis=1)
        cb = lax.dynamic_slice_in_dim(c, q0, Q_BLOCK, axis=2)
        logits = jnp.einsum('bqhd,bkhd->bhqk', qb, k).astype(jnp.float32) * scale
        logits = logits + (cb[..., :, None] - c[..., None, :])
        mask = k_pos[None, :] <= q_pos[:, None]
        p = jax.nn.softmax(jnp.where(mask, logits, NEG_INF), axis=-1)
        return jnp.einsum('bhqk,bkhd->bqhd', p.astype(v.dtype), v).reshape(B_, Q_BLOCK, H * Dh)

    out = lax.map(block, jnp.arange(S_ // Q_BLOCK))
    return jnp.moveaxis(out, 0, 1).reshape(B_, S_, H * Dh)


def compress_kv(k, v, cmp_pos, w1, w2):
    B_, S_ = k.shape[0], k.shape[1]
    n_cmp = (S_ - CMP_LEN) // CMP_STRIDE + 1
    starts = np.arange(n_cmp) * CMP_STRIDE
    idx = starts[:, None] + np.arange(CMP_LEN)[None, :]

    def phi(t, j):
        blocks = t[:, idx] + cmp_pos[j][None, None, :, None, :]
        flat = jnp.swapaxes(blocks, 2, 3).reshape(B_, n_cmp, NSA_GROUPS, CMP_LEN * HEAD_DIM)
        return jax.nn.gelu(flat @ w1[j], approximate=False) @ w2[j]

    return phi(k, 0), phi(v, 1), jnp.asarray(starts + CMP_LEN - 1, dtype=jnp.int32)


def nsa_attention(q, k_cmp, v_cmp, cmp_end, k_slc, v_slc, k_win, v_win, gates):
    B_, S_, H, Dh = q.shape
    G = NSA_GROUPS
    scale = Dh ** -0.5
    n_cmp = k_cmp.shape[1]
    n_slc = S_ // SLC_LEN
    top = min(SLC_TOP, n_slc)
    cs = np.arange(n_cmp)[:, None] * CMP_STRIDE
    ss = np.arange(n_slc)[None, :] * SLC_LEN
    ov = np.clip(np.minimum(cs + CMP_LEN, ss + SLC_LEN) - np.maximum(cs, ss), 0, None) / CMP_LEN
    overlap = jnp.asarray(ov, dtype=jnp.float32)
    kb = k_slc.reshape(B_, n_slc, SLC_LEN, G, Dh).transpose(0, 3, 1, 2, 4)
    vb = v_slc.reshape(B_, n_slc, SLC_LEN, G, Dh).transpose(0, 3, 1, 2, 4)
    pad = ((0, 0), (WINDOW, 0), (0, 0), (0, 0))
    kwp, vwp = jnp.pad(k_win, pad), jnp.pad(v_win, pad)
    bi = jnp.arange(B_)[:, None, None, None]
    gi = jnp.arange(G)[None, :, None, None]
    blk_ids = jnp.arange(n_slc)

    def block(i):
        q0 = i * Q_BLOCK
        q_pos = q0 + jnp.arange(Q_BLOCK)
        qb = lax.dynamic_slice_in_dim(q, q0, Q_BLOCK, axis=1).reshape(B_, Q_BLOCK, G, NSA_HPG, Dh)
        gb = lax.dynamic_slice_in_dim(gates, q0, Q_BLOCK, axis=1).reshape(B_, Q_BLOCK, G, NSA_HPG, N_NSA_BRANCH)
        lc = jnp.einsum('bqghd,bngd->bghqn', qb, k_cmp).astype(jnp.float32) * scale
        mc = cmp_end[None, :] <= q_pos[:, None]
        pc = jax.nn.softmax(jnp.where(mc, lc, NEG_INF), axis=-1) * mc
        o_cmp = jnp.einsum('bghqn,bngd->bqghd', pc.astype(v_cmp.dtype), v_cmp)
        imp = jnp.einsum('bghqn,nj->bgqj', pc, overlap)
        q_blk = q_pos // SLC_LEN
        forced = (blk_ids[None, :] == 0) | (blk_ids[None, :] == q_blk[:, None]) | (blk_ids[None, :] == q_blk[:, None] - 1)
        causal = blk_ids[None, :] <= q_blk[:, None]
        score = jnp.where(forced, FORCED_SCORE, jnp.where(causal, imp, -1.0))
        _, sel = lax.top_k(score, top)
        k_sel = kb[bi, gi, sel]
        v_sel = vb[bi, gi, sel]
        ls = jnp.einsum('bqghd,bgqkld->bghqkl', qb, k_sel).astype(jnp.float32) * scale
        tok = sel[..., None] * SLC_LEN + jnp.arange(SLC_LEN)
        ms = (tok <= q_pos[None, None, :, None, None])[:, :, None]
        ls = jnp.where(ms, ls, NEG_INF).reshape(B_, G, NSA_HPG, Q_BLOCK, top * SLC_LEN)
        ps = jax.nn.softmax(ls, axis=-1).reshape(B_, G, NSA_HPG, Q_BLOCK, top, SLC_LEN)
        o_slc = jnp.einsum('bghqkl,bgqkld->bqghd', ps.astype(v_sel.dtype), v_sel)
        kwb = lax.dynamic_slice_in_dim(kwp, q0, WINDOW + Q_BLOCK, axis=1)
        vwb = lax.dynamic_slice_in_dim(vwp, q0, WINDOW + Q_BLOCK, axis=1)
        k_pos = q0 - WINDOW + jnp.arange(WINDOW + Q_BLOCK)
        lw = jnp.einsum('bqghd,bkgd->bghqk', qb, kwb).astype(jnp.float32) * scale
        rel = q_pos[:, None] - k_pos[None, :]
        mw = (rel >= 0) & (rel < WINDOW) & (k_pos[None, :] >= 0)
        pw = jax.nn.softmax(jnp.where(mw, lw, NEG_INF), axis=-1)
        o_win = jnp.einsum('bghqk,bkgd->bqghd', pw.astype(vwb.dtype), vwb)
        o = gb[..., 0:1] * o_cmp + gb[..., 1:2] * o_slc + gb[..., 2:3] * o_win
        return o.astype(q.dtype).reshape(B_, Q_BLOCK, H * Dh)

    out = lax.map(block, jnp.arange(S_ // Q_BLOCK))
    return jnp.moveaxis(out, 0, 1).reshape(B_, S_, H * Dh)


def hybrid_mixer(h, w_in, fox_f_bias, cmp_pos, cmp_w1, cmp_w2, w_branch, w_out):
    B_, S_, _ = h.shape
    proj = h @ w_in
    (fq, fk, fv, f_logit, nq, kc, vc, ksl, vsl, kwn, vwn,
     nsa_gate_logit, merge_logit) = split_columns(proj, IN_SPLITS)
    heads = lambda t, n: t.reshape(B_, S_, n, HEAD_DIM)
    log_f = jax.nn.log_sigmoid(f_logit.astype(jnp.float32) + fox_f_bias.astype(jnp.float32))
    y_fox = fox_attention(heads(fq, FOX_HEADS), heads(fk, FOX_HEADS), heads(fv, FOX_HEADS), log_f)
    cos, sin = rope_tables(jnp.arange(S_, dtype=jnp.float32))
    q_nsa = apply_partial_rope(heads(nq, NSA_HEADS), cos, sin)
    k_slc = apply_partial_rope(heads(ksl, NSA_GROUPS), cos, sin)
    k_win = apply_partial_rope(heads(kwn, NSA_GROUPS), cos, sin)
    k_cmp, v_cmp, cmp_end = compress_kv(heads(kc, NSA_GROUPS), heads(vc, NSA_GROUPS), cmp_pos, cmp_w1, cmp_w2)
    k_cmp = apply_partial_rope(k_cmp, *rope_tables(cmp_end.astype(jnp.float32)))
    gates = jax.nn.sigmoid(nsa_gate_logit.astype(jnp.float32)).reshape(B_, S_, NSA_HEADS, N_NSA_BRANCH)
    y_nsa = nsa_attention(q_nsa, k_cmp, v_cmp, cmp_end, k_slc, heads(vsl, NSA_GROUPS),
                          k_win, heads(vwn, NSA_GROUPS), gates)
    g = jax.nn.sigmoid(merge_logit.astype(jnp.float32)).reshape(B_, S_, N_BRANCH, D_MODEL).astype(h.dtype)
    ys = jnp.stack([y_fox, y_nsa], axis=2)
    up = jnp.einsum('bsnc,ncd->bsnd', ys, w_branch)
    merged = jnp.sum(g * up, axis=2)
    return merged @ w_out


def peer_ffn(h, wq, subkeys, u, v):
    B_, S_, D = h.shape
    T = B_ * S_
    hf = h.reshape(T, D)
    q = (hf @ wq).reshape(T, PEER_HEADS, 2, PEER_QDIM // 2)
    s = jnp.einsum('thpd,hpnd->thpn', q, subkeys).astype(jnp.float32)
    s1, i1 = lax.top_k(s[:, :, 0], PEER_TOPK)
    s2, i2 = lax.top_k(s[:, :, 1], PEER_TOPK)
    cand = (s1[..., :, None] + s2[..., None, :]).reshape(T, PEER_HEADS, PEER_TOPK * PEER_TOPK)
    cand_idx = (i1[..., :, None] * N_KEYS + i2[..., None, :]).reshape(T, PEER_HEADS, PEER_TOPK * PEER_TOPK)
    top_s, pos = lax.top_k(cand, PEER_TOPK)
    idx = jnp.take_along_axis(cand_idx, pos, axis=-1)
    w = jax.nn.softmax(top_s, axis=-1)

    def chunk(args):
        x_c, idx_c, w_c = args
        act = jax.nn.gelu(jnp.einsum('cd,chkd->chk', x_c, u[idx_c]).astype(jnp.float32), approximate=False)
        coef = (w_c * act).astype(v.dtype)
        return jnp.einsum('chk,chkd->cd', coef, v[idx_c])

    nc = T // PEER_CHUNK
    out = lax.map(chunk, (hf.reshape(nc, PEER_CHUNK, D),
                          idx.reshape(nc, PEER_CHUNK, PEER_HEADS, PEER_TOPK),
                          w.reshape(nc, PEER_CHUNK, PEER_HEADS, PEER_TOPK)))
    return out.reshape(B_, S_, D)


def setup_inputs(seed: int = 0) -> dict:
    key = jax.random.key(seed)
    ks = jax.random.split(key, 16)
    f32 = jnp.float32
    nrm = lambda k, shape, scale: scale * jax.random.normal(k, shape, f32)
    L = DEPTH
    return {
        "x": jax.random.normal(ks[0], (BATCH, SEQ, D_MODEL), f32),
        "norm_mix": 1.0 + nrm(ks[1], (L, D_MODEL), 0.02),
        "w_in": nrm(ks[2], (L, D_MODEL, D_IN), D_MODEL ** -0.5),
        "fox_f_bias": FORGET_BIAS_INIT + nrm(ks[3], (L, FOX_HEADS), 0.1),
        "nsa_cmp_pos": nrm(ks[4], (L, 2, CMP_LEN, HEAD_DIM), 0.02),
        "nsa_cmp_w1": nrm(ks[5], (L, 2, CMP_LEN * HEAD_DIM, CMP_HIDDEN), (CMP_LEN * HEAD_DIM) ** -0.5),
        "nsa_cmp_w2": nrm(ks[6], (L, 2, CMP_HIDDEN, HEAD_DIM), CMP_HIDDEN ** -0.5),
        "w_branch": nrm(ks[7], (L, N_BRANCH, BRANCH_WIDTH, D_MODEL), BRANCH_WIDTH ** -0.5),
        "w_out": nrm(ks[8], (L, D_MODEL, D_MODEL), D_MODEL ** -0.5),
        "norm_ffn": 1.0 + nrm(ks[9], (L, D_MODEL), 0.02),
        "peer_wq": nrm(ks[10], (L, D_MODEL, PEER_HEADS * PEER_QDIM), D_MODEL ** -0.5),
        "peer_subkeys": nrm(ks[11], (L, PEER_HEADS, 2, N_KEYS, PEER_QDIM // 2), (PEER_QDIM // 2) ** -0.5),
        "peer_u": nrm(ks[12], (L, N_EXPERTS, D_MODEL), D_MODEL ** -0.5),
        "peer_v": nrm(ks[13], (L, N_EXPERTS, D_MODEL), (PEER_HEADS * PEER_TOPK) ** -0.5),
        "norm_final": 1.0 + nrm(ks[14], (D_MODEL,), 0.02),
    }


def reference(x, norm_mix, w_in, fox_f_bias, nsa_cmp_pos, nsa_cmp_w1, nsa_cmp_w2, w_branch, w_out,
              norm_ffn, peer_wq, peer_subkeys, peer_u, peer_v, norm_final):
    h = x
    for l in range(DEPTH):
        h = h + hybrid_mixer(rmsnorm(h, norm_mix[l]), w_in[l], fox_f_bias[l], nsa_cmp_pos[l],
                             nsa_cmp_w1[l], nsa_cmp_w2[l], w_branch[l], w_out[l])
        h = h + peer_ffn(rmsnorm(h, norm_ffn[l]), peer_wq[l], peer_subkeys[l], peer_u[l], peer_v[l])
    return rmsnorm(h, norm_final)
```

```cpp
#include <hip/hip_runtime.h>
#include <cstdio>
#include <cstdint>
namespace pg8 {
#define PG8_LAS __attribute__((address_space(3)))
typedef unsigned short bf16_t;
typedef short bf16x8 __attribute__((ext_vector_type(8)));
typedef float f32x4 __attribute__((ext_vector_type(4)));
typedef unsigned u32x4 __attribute__((ext_vector_type(4)));
constexpr int BM = 256, BK = 64, HALF = 128, HTB = HALF * BK * 2  , STAGE_BYTES = 8 * HTB, NXCD = 8, WGM = 8;

__host__ __device__ __forceinline__ int lds_byte(int r, int c) { const int st = (r >> 4) * 2 + (c >> 5), rr = r & 15, cc = c & 31, ob = rr * 64 + cc * 2; return st * 1024 + (ob ^ (((ob >> 9) & 1) << 5)); }
__host__ __device__ __forceinline__ void stage_rc(int b, int& R, int& C) { const int st = b / 1024, sb = b % 1024, swz = sb ^ (((sb >> 9) & 1) << 5); R = (st >> 1) * 16 + swz / 64; C = (st & 1) * 32 + (swz % 64) / 2; }
__host__ __device__ __forceinline__ int perm32(int rho) { const int n = rho >> 4, i = rho & 15; return 8 * (i >> 2) + 4 * n + (i & 3); }

struct Unit { int pm, pn; };
struct Gemm { const bf16_t* A; const bf16_t* Bt; int M, N, K; };

struct StaticOrder {
    int nM, nN, nwg, G, c;
    __host__ __device__ void init(int M, int N, int G_, int c_) { nM = M / BM; nN = N / BM; nwg = nM * nN; G = G_; c = c_; }
    __host__ __device__ bool next(int i, Unit& u) const {
        const long L = (long)i * G + c; if (L >= nwg) return false;
        int wgid = (int)L; { const int q = nwg / NXCD, r = nwg % NXCD, xcd = wgid % NXCD, off = wgid / NXCD; wgid = (xcd < r ? xcd * (q + 1) : r * (q + 1) + (xcd - r) * q) + off; }
        const int nig = WGM * nN, gid = wgid / nig, fm = gid * WGM, gsz = (nM - fm) < WGM ? (nM - fm) : WGM;
        u.pm = fm + ((wgid % nig) % gsz); u.pn = (wgid % nig) / gsz; return true;
    }
    __device__ __forceinline__ void a_ready(const Unit&) const {}
    __device__ __forceinline__ void done(const Unit&) const {}
};

__device__ __forceinline__ unsigned cvt_pk_bf16(float lo, float hi) { unsigned r; asm volatile("v_cvt_pk_bf16_f32 %0, %1, %2" : "=v"(r) : "v"(lo), "v"(hi)); return r; }
template <class Epi, class Sched, bool ALIGN_EPI = false, bool SP2 = false>
__device__ __forceinline__ void gemm_phase(PG8_LAS unsigned char* lds, const Gemm g, const Sched& S, const Epi& E) {
    const int tid = threadIdx.x, wid = __builtin_amdgcn_readfirstlane(tid >> 6), lane = tid & 63, wr = wid >> 2, wc = wid & 3, fr = lane & 15, fq = lane >> 4;
    const int K = g.K, nt = K / BK;
    unsigned voffA[2], voffB[2];
#pragma unroll
    for (int i = 0; i < 2; ++i) { int R, C; stage_rc(tid * 16 + i * 8192, R, C); const int Rb = Epi::PERM ? ((R & ~31) + perm32(R & 31)) : R;
        voffA[i] = (unsigned)(R * K + C) * 2u; voffB[i] = (unsigned)(Rb * K + C) * 2u; }
    const size_t kstep = (size_t)(BK * 2);
    const size_t hstep = (size_t)HALF * K * 2;
    const size_t tstep = 2 * hstep;
    const unsigned ldsw = (unsigned)wid * 1024u;
    const int aoff = lds_byte(wr * 64 + fr, fq * 8), boff = lds_byte(wc * 32 + fr, fq * 8);
#define PG8_SA(b, h) (((b) * 2 + (h)) * HTB)
#define PG8_SB(b, h) ((4 + (b) * 2 + (h)) * HTB)
#define PG8_STAGE(bufoff, gbase, voff) do { _Pragma("unroll") for (int _i = 0; _i < 2; ++_i) \
        __builtin_amdgcn_global_load_lds((const unsigned*)((const char*)(gbase) + (voff)[_i]), (PG8_LAS unsigned*)(lds + (bufoff) + ldsw + _i * 8192), 16, 0, 0); } while (0)
#define PG8_LDA(dst, b, h) do { _Pragma("unroll") for (int m = 0; m < 4; ++m) _Pragma("unroll") for (int k = 0; k < 2; ++k) dst[m][k] = *(const PG8_LAS bf16x8*)(lds + PG8_SA(b, h) + aoff + m * 2048 + k * 1024); } while (0)
#define PG8_LDB(dst, b, h) do { _Pragma("unroll") for (int n = 0; n < 2; ++n) _Pragma("unroll") for (int k = 0; k < 2; ++k) dst[n][k] = *(const PG8_LAS bf16x8*)(lds + PG8_SB(b, h) + boff + n * 2048 + k * 1024); } while (0)
#define PG8_MMA(ai, bj, At, Bt) do { __builtin_amdgcn_s_setprio(1); _Pragma("unroll") for (int m = 0; m < 4; ++m) _Pragma("unroll") for (int n = 0; n < 2; ++n) _Pragma("unroll") for (int k = 0; k < 2; ++k) \
        acc[ai][bj][m][n] = __builtin_amdgcn_mfma_f32_16x16x32_bf16(Bt[n][k], At[m][k], acc[ai][bj][m][n], 0, 0, 0); __builtin_amdgcn_s_setprio(0); } while (0)
#define PG8_WAIT_V(n) asm volatile("s_waitcnt vmcnt(" #n ")" ::: "memory")
#define PG8_WAIT_L(n) asm volatile("s_waitcnt lgkmcnt(" #n ")" ::: "memory")
#define PG8_BAR __builtin_amdgcn_s_barrier()
#define PG8_SCHED __builtin_amdgcn_sched_barrier(0)
    Unit cur, nxt; int ui = 0;
    if (!S.next(0, cur)) return;
    f32x4 acc[2][2][4][2];
#pragma unroll
    for (int a = 0; a < 2; ++a)
#pragma unroll
        for (int b = 0; b < 2; ++b)
#pragma unroll
            for (int m = 0; m < 4; ++m)
#pragma unroll
                for (int n = 0; n < 2; ++n) acc[a][b][m][n] = (f32x4){0.f, 0.f, 0.f, 0.f};
    bf16x8 At[4][2], B0[2][2], B1[2][2];
    const char* cA = (const char*)g.A + (size_t)cur.pm * tstep; const char* cB = (const char*)g.Bt + (size_t)cur.pn * tstep;
    S.a_ready(cur);
    if constexpr (SP2) {
        PG8_STAGE(PG8_SB(0, 0), cB, voffB); PG8_STAGE(PG8_SB(0, 1), cB + hstep, voffB); PG8_STAGE(PG8_SA(0, 0), cA, voffA); PG8_STAGE(PG8_SA(0, 1), cA + hstep, voffA);
        if (wr == 1) PG8_BAR;
        PG8_WAIT_V(2); PG8_BAR;
        PG8_STAGE(PG8_SB(1, 0), cB + kstep, voffB); PG8_STAGE(PG8_SA(1, 0), cA + kstep, voffA); PG8_STAGE(PG8_SB(1, 1), cB + hstep + kstep, voffB);
        PG8_WAIT_V(6); PG8_BAR;
    } else {
        PG8_STAGE(PG8_SB(0, 0), cB, voffB); PG8_STAGE(PG8_SA(0, 0), cA, voffA); PG8_STAGE(PG8_SB(0, 1), cB + hstep, voffB); PG8_STAGE(PG8_SA(0, 1), cA + hstep, voffA);
        if (wr == 1) PG8_BAR;
        PG8_WAIT_V(4); PG8_BAR;
        PG8_STAGE(PG8_SB(1, 0), cB + kstep, voffB); PG8_STAGE(PG8_SA(1, 0), cA + kstep, voffA); PG8_STAGE(PG8_SB(1, 1), cB + hstep + kstep, voffB);
        PG8_WAIT_V(6); PG8_BAR;
    }
    for (;;) {
        const bool has_next = S.next(ui + 1, nxt);
        const char* nA = has_next ? (const char*)g.A + (size_t)nxt.pm * tstep : cA; const char* nB = has_next ? (const char*)g.Bt + (size_t)nxt.pn * tstep : cB;
        for (int t = 0; t < nt; t += 2) {
            const bool last = (t == nt - 2);
            const char* a1 = cA + (size_t)(t + 1) * kstep;
            const char* a2 = last ? nA : cA + (size_t)(t + 2) * kstep; const char* b2 = last ? nB : cB + (size_t)(t + 2) * kstep;
            const char* a3 = a2 + kstep; const char* b3 = b2 + kstep;
            if (last && has_next) S.a_ready(nxt);
            if constexpr (SP2) {
            PG8_LDB(B0, 0, 0); PG8_LDB(B1, 0, 1); PG8_SCHED; PG8_LDA(At, 0, 0); PG8_STAGE(PG8_SA(1, 1), a1 + hstep, voffA);
            PG8_WAIT_V(8); PG8_WAIT_L(0); PG8_BAR; PG8_MMA(0, 0, At, B0); PG8_MMA(0, 1, At, B1); PG8_BAR; PG8_SCHED;
            PG8_LDA(At, 0, 1); PG8_STAGE(PG8_SB(0, 0), b2, voffB); PG8_STAGE(PG8_SB(0, 1), b2 + hstep, voffB); PG8_STAGE(PG8_SA(0, 0), a2, voffA);
            PG8_WAIT_V(8); PG8_WAIT_L(0); PG8_BAR; PG8_MMA(1, 0, At, B0); PG8_MMA(1, 1, At, B1); PG8_BAR; PG8_SCHED;
            PG8_LDB(B0, 1, 0); PG8_LDB(B1, 1, 1); PG8_SCHED; PG8_LDA(At, 1, 0); PG8_STAGE(PG8_SA(0, 1), a2 + hstep, voffA);
            PG8_WAIT_V(8); PG8_WAIT_L(0); PG8_BAR; PG8_MMA(0, 0, At, B0); PG8_MMA(0, 1, At, B1); PG8_BAR; PG8_SCHED;
            PG8_LDA(At, 1, 1); PG8_STAGE(PG8_SB(1, 0), b3, voffB); PG8_STAGE(PG8_SB(1, 1), b3 + hstep, voffB); PG8_STAGE(PG8_SA(1, 0), a3, voffA);
            PG8_WAIT_V(8); PG8_WAIT_L(0); PG8_BAR; PG8_MMA(1, 0, At, B0); PG8_MMA(1, 1, At, B1); PG8_BAR; PG8_SCHED;
            } else {
            PG8_LDB(B0, 0, 0); PG8_SCHED; PG8_LDA(At, 0, 0); PG8_STAGE(PG8_SA(1, 1), a1 + hstep, voffA);
            PG8_WAIT_L(8); PG8_BAR; PG8_WAIT_L(0); PG8_MMA(0, 0, At, B0); PG8_BAR; PG8_SCHED;
            PG8_LDB(B1, 0, 1); PG8_STAGE(PG8_SB(0, 0), b2, voffB);
            PG8_BAR; PG8_WAIT_L(0); PG8_MMA(0, 1, At, B1); PG8_BAR;
            PG8_LDA(At, 0, 1); PG8_STAGE(PG8_SA(0, 0), a2, voffA);
            PG8_BAR; PG8_WAIT_L(0); PG8_MMA(1, 0, At, B0); PG8_BAR; PG8_SCHED;
            PG8_STAGE(PG8_SB(0, 1), b2 + hstep, voffB);
            PG8_WAIT_V(6); PG8_BAR; PG8_MMA(1, 1, At, B1); PG8_BAR;
            PG8_LDB(B0, 1, 0); PG8_SCHED; PG8_LDA(At, 1, 0); PG8_STAGE(PG8_SA(0, 1), a2 + hstep, voffA);
            PG8_WAIT_L(8); PG8_BAR; PG8_WAIT_L(0); PG8_MMA(0, 0, At, B0); PG8_BAR; PG8_SCHED;
            PG8_LDB(B1, 1, 1); PG8_STAGE(PG8_SB(1, 0), b3, voffB);
            PG8_BAR; PG8_WAIT_L(0); PG8_MMA(0, 1, At, B1); PG8_BAR;
            PG8_LDA(At, 1, 1); PG8_STAGE(PG8_SA(1, 0), a3, voffA);
            PG8_BAR; PG8_WAIT_L(0); PG8_MMA(1, 0, At, B0); PG8_BAR; PG8_SCHED;
            PG8_STAGE(PG8_SB(1, 1), b3 + hstep, voffB);
            PG8_WAIT_V(6); PG8_BAR; PG8_MMA(1, 1, At, B1); PG8_BAR;
            }
        }
        if constexpr (ALIGN_EPI) { if (wr == 0) PG8_BAR; }
        bool keep_ = false; if constexpr (!Epi::AFTER_DRAIN) { keep_ = E(acc, cur, wr, wc, fr, fq); S.done(cur); }
        if (!has_next) break;
        if (!keep_)
#pragma unroll
        for (int a = 0; a < 2; ++a)
#pragma unroll
            for (int b = 0; b < 2; ++b)
#pragma unroll
                for (int m = 0; m < 4; ++m)
#pragma unroll
                    for (int n = 0; n < 2; ++n) acc[a][b][m][n] = (f32x4){0.f, 0.f, 0.f, 0.f};
        cur = nxt; cA = nA; cB = nB; ++ui;
        if constexpr (ALIGN_EPI) { if (wr == 1) PG8_BAR; }
    }
    PG8_WAIT_V(0);
    if constexpr (!ALIGN_EPI) { if (wr == 0) PG8_BAR; }
    PG8_BAR;
    if constexpr (Epi::AFTER_DRAIN) { E.fused(acc, cur, wr, wc, fr, fq, lds, wid, lane); S.done(cur); }
#undef PG8_SA
#undef PG8_SB
#undef PG8_STAGE
#undef PG8_LDA
#undef PG8_LDB
#undef PG8_MMA
#undef PG8_WAIT_V
#undef PG8_WAIT_L
#undef PG8_BAR
#undef PG8_SCHED
}
}
#ifndef DBG_ACTSCALE
#define DBG_ACTSCALE 1.0f
#endif
#ifndef DBG_OUTSCALE
#define DBG_OUTSCALE 1.0f
#endif
#ifndef DBG_KEEP
#define DBG_KEEP 16
#endif
#define COARSE2(w) (((w) + 0x00020002u) & 0xfffcfffcu)
#ifndef DBG_KROPE
#define DBG_KROPE 31
#endif
#ifndef DBG_FOXT
#define DBG_FOXT 1.0f
#endif
#ifndef DBG_NSAT
#define DBG_NSAT 1.0f
#endif
#ifndef DBG_DECAY
#define DBG_DECAY 1.0f
#endif

constexpr int NB = 8, SEQ = 4096, DM = 1024, NTOK = NB * SEQ;
constexpr int NIN = 5120;
constexpr int NEXP = 16384;
constexpr float LOG2E = 1.4426950408889634f;
constexpr float C2 = 0.125f * LOG2E;
constexpr float RMS_EPS = 1e-6f;
constexpr int NWAVES = 8;

constexpr size_t MiB = 1u << 20;
constexpr size_t WS_CTL = 0, CTL_ZERO_BYTES = 1 * MiB;
constexpr size_t WS_SS = 512 * 1024;
constexpr size_t WS_BIAS1 = 768 * 1024;
constexpr size_t WS_WTIN = 2 * MiB, WS_WTBR = 12 * MiB, WS_WTOUT = 14 * MiB, WS_WTPEER = 16 * MiB, WS_W1T = 20 * MiB;
constexpr size_t WS_W2T = 21 * MiB, WS_ROPE = 21 * MiB + 128 * 1024, WS_KCMP = 22 * MiB, WS_VCMP = 22 * MiB + 512 * 1024, WS_LOGF = 23 * MiB;
constexpr size_t WS_UB = 24 * MiB, WS_VB = 56 * MiB;
constexpr size_t WS_XN = 88 * MiB;
constexpr size_t WS_Y = WS_XN, WS_HB = WS_XN;
constexpr size_t WS_QF = 152 * MiB, WS_KF = 184 * MiB, WS_VF = 216 * MiB, WS_QN = 248 * MiB;
constexpr size_t WS_MERGED = WS_QF;
constexpr size_t WS_KVC = 280 * MiB, WS_KVS = 296 * MiB, WS_KVW = 312 * MiB;
constexpr size_t WS_GM = 328 * MiB;
constexpr size_t WS_GATES = 456 * MiB, WS_CUM = 459 * MiB, WS_END = 460 * MiB;
constexpr size_t WS_SC = 152 * MiB;
static_assert(WS_SC + (size_t)NTOK * 2048 * 4 <= WS_GATES, "score overlay");
constexpr int CW_BAR = 4096;
constexpr int CW_QATT = 8192, CW_QPEER = 8256;

constexpr int RING_BYTES = 131072;
constexpr int LDS_BYTES = 147456;
constexpr int LDSCTL_OFF = LDS_BYTES - 512, MISC_OFF = LDSCTL_OFF + 64;

#define GAS __attribute__((address_space(1)))
#define LAS __attribute__((address_space(3)))
typedef unsigned short bf16;
typedef unsigned v4u __attribute__((ext_vector_type(4)));
typedef unsigned v2u __attribute__((ext_vector_type(2)));
typedef float f32x4 __attribute__((ext_vector_type(4)));
typedef float f32x2 __attribute__((ext_vector_type(2)));
typedef short bf16x8 __attribute__((ext_vector_type(8)));
typedef short s16x4 __attribute__((ext_vector_type(4)));
typedef float f32x16 __attribute__((ext_vector_type(16)));
typedef GAS unsigned gu32;
#define RLX_AGENT __ATOMIC_RELAXED, __HIP_MEMORY_SCOPE_AGENT
#define LDS_WAIT() asm volatile("s_waitcnt lgkmcnt(0)" ::: "memory")
#define VM_WAIT() asm volatile("s_waitcnt vmcnt(0)" ::: "memory")
__device__ __forceinline__ unsigned pk2(float lo, float hi) { return pg8::cvt_pk_bf16(lo, hi); }
__device__ __forceinline__ float bf_lo(unsigned w) { return __uint_as_float(w << 16); }
__device__ __forceinline__ float bf_hi(unsigned w) { return __uint_as_float(w & 0xffff0000u); }
__device__ __forceinline__ float sigmoidf_(float x) { return __builtin_amdgcn_rcpf(1.0f + __builtin_amdgcn_exp2f(-x * LOG2E)); }
__device__ __forceinline__ float gelu_erf(float v) { return 0.5f * v * (1.0f + erff(v * 0.70710678118654752f)); }
__device__ __forceinline__ float wave_sum(float v) {
#pragma unroll
    for (int o = 1; o < 64; o <<= 1) v += __shfl_xor(v, o);
    return v;
}

#define XB_TMO      128
#define XB_XCNT(j)  (256  + 64 * (j))
#define XB_XSUB(j)  (1280 + 64 * (j))
#define XB_XGEN(j)  (2304 + 64 * (j))
#define XB_TOP      3328
#define XB_TOPGEN   3392
#define XCD_BAR_WORDS 3456
#define XB_SPIN_CAP (1u << 18)

__device__ __forceinline__ unsigned xb_ld(unsigned* p)              { return __hip_atomic_load(p, __ATOMIC_RELAXED, __HIP_MEMORY_SCOPE_AGENT); }
__device__ __forceinline__ unsigned xb_add(unsigned* p, unsigned v) { return __hip_atomic_fetch_add(p, v, __ATOMIC_RELAXED, __HIP_MEMORY_SCOPE_AGENT); }
__device__ __forceinline__ unsigned xb_xcc_id() { return (unsigned)__builtin_amdgcn_s_getreg((3 << 11) | 20) & 0xFu; }
#define XB_SPIN(cond, bar) do { unsigned _sp = 0; while (cond) { __builtin_amdgcn_s_sleep(1); \
    if ((++_sp & 255u) == 0u) { if (xb_ld(&(bar)[XB_TMO])) break; if (_sp > XB_SPIN_CAP) { atomicAdd(&(bar)[XB_TMO], 1u); break; } } } } while (0)

struct XcdBarrier {
    unsigned* bar; unsigned x;
    volatile LAS unsigned* st;
};

__device__ __forceinline__ XcdBarrier xcd_barrier_post(unsigned* bar, volatile LAS unsigned* st) {
    XcdBarrier b; b.bar = bar; b.x = xb_xcc_id(); b.st = st;
    if (threadIdx.x == 0) (void)xb_add(&bar[XB_XCNT(b.x)], 1u);
    return b;
}
__device__ __forceinline__ void xcd_barrier_complete(unsigned* bar, unsigned x, unsigned& nloc, unsigned& nx) {
    const unsigned G = gridDim.x * gridDim.y * gridDim.z;
    unsigned sum, cnt, mine, sp = 0u;
    for (;;) {
        sum = 0u; cnt = 0u; mine = 0u;
#pragma unroll
        for (unsigned j = 0; j < 16; ++j) { const unsigned c = xb_ld(&bar[XB_XCNT(j)]); sum += c; cnt += (c > 0u) ? 1u : 0u; mine = (j == x) ? c : mine; }
        if (sum == G) break;
        __builtin_amdgcn_s_sleep(1);
        if ((++sp & 255u) == 0u) { if (xb_ld(&bar[XB_TMO])) break; if (sp > XB_SPIN_CAP) { atomicAdd(&bar[XB_TMO], 1u); break; } }
    }
    nloc = mine > 0u ? mine : 1u; nx = cnt > 0u ? cnt : 1u;
}

__device__ __forceinline__ void xcd_barrier(const XcdBarrier& b) {
    asm volatile("s_waitcnt vmcnt(0)" ::: "memory");
    __syncthreads();
    if (threadIdx.x == 0) {
        unsigned* bar = b.bar;
        __builtin_amdgcn_s_waitcnt(0);
        unsigned nloc = b.st[0], nx = b.st[1];
        if (nloc == 0u) { xcd_barrier_complete(bar, b.x, nloc, nx); b.st[0] = nloc; b.st[1] = nx; }
        const unsigned old = xb_add(&bar[XB_XSUB(b.x)], 1u);
        const unsigned gen = old / nloc;
        if (old + 1u == (gen + 1u) * nloc) {
            __builtin_amdgcn_fence(__ATOMIC_RELEASE, "agent");
            asm volatile("s_waitcnt vmcnt(0)" ::: "memory");
            const unsigned og = xb_add(&bar[XB_TOP], 1u);
            const unsigned tg = og / nx;
            if (og + 1u == (tg + 1u) * nx) xb_add(&bar[XB_TOPGEN], 1u);
            else XB_SPIN(xb_ld(&bar[XB_TOPGEN]) == tg, bar);
            __builtin_amdgcn_fence(__ATOMIC_ACQUIRE, "agent");
            xb_add(&bar[XB_XGEN(b.x)], 1u);
            asm volatile("s_waitcnt vmcnt(0)" ::: "memory");
        } else {
            XB_SPIN(xb_ld(&bar[XB_XGEN(b.x)]) == gen, bar);
            __builtin_amdgcn_fence(__ATOMIC_ACQUIRE, "agent");
            asm volatile("s_waitcnt vmcnt(0)" ::: "memory");
        }
    }
    __syncthreads();
}


struct Frame {
    LAS unsigned char* lds;
    volatile LAS unsigned* MISC;
    gu32* ctl;
    int tid, lane, wave, vcu, G;
    unsigned char* ws;
    const float *x, *norm_mix, *w_in, *fbias, *cmp_pos, *cmp_w1, *cmp_w2, *w_branch, *w_out, *norm_ffn, *peer_wq, *peer_sk, *peer_u, *peer_v, *norm_final;
    float* out;
};

__device__ __forceinline__ int src_col_in(int n) {
    if (n < 1536) return n;
    if (n < 2816) return n + 8;
    if (n < 2824) return n - 2816 + 1536;
    if (n < 2848) return n;
    if (n < 3072) return -1;
    return n - 3072 + 2848;
}
__device__ __forceinline__ void p0_tr_item(const float* W, int ldw, int K, bf16* WT, int kb, int dst_row0, int src_col, LAS float* scr, int lane) {
    const int k0 = 64 * kb;
#pragma unroll 8
    for (int i = 0; i < 32; ++i) { const int kk = 2 * i + (lane >> 5); scr[kk * 33 + (lane & 31)] = (src_col >= 0) ? W[(size_t)(k0 + kk) * ldw + src_col] : 0.f; }
    LDS_WAIT(); asm volatile("" ::: "memory");
    const int c = lane & 7;
#pragma unroll
    for (int j = 0; j < 4; ++j) { const int n = (lane >> 3) + 8 * j; const LAS float* s = scr + (8 * c) * 33 + n;
        v4u o; o.x = pk2(s[0 * 33], s[1 * 33]); o.y = pk2(s[2 * 33], s[3 * 33]); o.z = pk2(s[4 * 33], s[5 * 33]); o.w = pk2(s[6 * 33], s[7 * 33]);
#ifdef DBG_C_W
        o.x = COARSE2(o.x); o.y = COARSE2(o.y); o.z = COARSE2(o.z); o.w = COARSE2(o.w);
#endif
        *(GAS v4u*)(WT + (size_t)(dst_row0 + n) * K + k0 + 8 * c) = o; }
    LDS_WAIT(); asm volatile("" ::: "memory");
}
__device__ __forceinline__ void p0_prologue(Frame& F) {
    LAS float* scr = (LAS float*)(F.lds + F.wave * 16384);
    unsigned char* ws = F.ws;
    const int gw = F.vcu * NWAVES + F.wave, NGW = F.G * NWAVES, lane = F.lane;
    const int gt = gw * 64 + lane, NGT = NGW * 64;
    constexpr int I_IN = 16 * 160, I_BR = 8 * 32, I_OUT = 16 * 32, I_W1 = 32 * 4, I_W2 = 2 * 2;
    constexpr int NITEMS = I_IN + 2 * I_BR + I_OUT + 2 * I_W1 + 2 * I_W2;
    for (int it = gw; it < NITEMS; it += NGW) {
        int r = it;
        if (r < I_IN) { const int kb = r / 160, nb = r % 160; p0_tr_item(F.w_in, 4896, 1024, (bf16*)(ws + WS_WTIN), kb, 32 * nb, src_col_in(32 * nb + (lane & 31)), scr, lane); continue; } r -= I_IN;
        if (r < 2 * I_BR) { const int br = r / I_BR, q = r % I_BR, kb = q / 32, nb = q % 32; p0_tr_item(F.w_branch + (size_t)br * 512 * 1024, 1024, 512, (bf16*)(ws + WS_WTBR), kb, br * 1024 + 32 * nb, 32 * nb + (lane & 31), scr, lane); continue; } r -= 2 * I_BR;
        if (r < I_OUT) { const int kb = r / 32, nb = r % 32; p0_tr_item(F.w_out, 1024, 1024, (bf16*)(ws + WS_WTOUT), kb, 32 * nb, 32 * nb + (lane & 31), scr, lane); continue; } r -= I_OUT;
        if (r < 2 * I_W1) { const int j = r / I_W1, q = r % I_W1, kb = q / 4, nb = q % 4; p0_tr_item(F.cmp_w1 + (size_t)j * 2048 * 128, 128, 2048, (bf16*)(ws + WS_W1T), kb, j * 128 + 32 * nb, 32 * nb + (lane & 31), scr, lane); continue; } r -= 2 * I_W1;
        { const int j = r / I_W2, q = r % I_W2, kb = q / 2, nb = q % 2; p0_tr_item(F.cmp_w2 + (size_t)j * 128 * 64, 64, 128, (bf16*)(ws + WS_W2T), kb, j * 64 + 32 * nb, 32 * nb + (lane & 31), scr, lane); }
    }
    for (int it = gt; it < 512 * 256; it += NGT) {
        const int nq = it >> 8, kq = it & 255, n0 = 4 * nq, k0 = 4 * kq, hp = n0 >> 7;
        const f32x4* s4[4]; const f32x4* w4[4];
#pragma unroll
        for (int i = 0; i < 4; ++i) { s4[i] = (const f32x4*)(F.peer_sk + (size_t)(n0 + i) * 128); w4[i] = (const f32x4*)(F.peer_wq + (size_t)(k0 + i) * 2048 + hp * 128); }
        float acc[4][4];
#pragma unroll
        for (int i = 0; i < 4; ++i)
#pragma unroll
            for (int j = 0; j < 4; ++j) acc[i][j] = 0.f;
        for (int d = 0; d < 32; ++d) {
            f32x4 sv[4], wv[4];
#pragma unroll
            for (int i = 0; i < 4; ++i) { sv[i] = s4[i][d]; wv[i] = w4[i][d]; }
#pragma unroll
            for (int i = 0; i < 4; ++i)
#pragma unroll
                for (int j = 0; j < 4; ++j) acc[i][j] += sv[i].x * wv[j].x + sv[i].y * wv[j].y + sv[i].z * wv[j].z + sv[i].w * wv[j].w;
        }
        bf16* WtP = (bf16*)(ws + WS_WTPEER);
#pragma unroll
        for (int i = 0; i < 4; ++i) { v2u o; o.x = pk2(acc[i][0], acc[i][1]); o.y = pk2(acc[i][2], acc[i][3]); *(GAS v2u*)(WtP + (size_t)(n0 + i) * 1024 + k0) = o; }
    }
    for (int it = gt; it < 2 * 128 * 8; it += NGT) {
        const int n = it & 127, j = (it >> 7) & 1, ch = it >> 8;
        const float* p = F.cmp_pos + (size_t)j * 2048 + ch * 256; const float* w = F.cmp_w1 + ((size_t)j * 2048 + ch * 256) * 128 + n;
        float a = 0.f;
        for (int k = 0; k < 256; ++k) a += p[k] * w[(size_t)k * 128];
        atomicAdd((float*)(ws + WS_BIAS1) + j * 128 + n, a);
    }
    for (int it = gt; it < SEQ * 8; it += NGT) {
        const int pos = it >> 3, i = it & 7;
        const double inv[8] = {1.0, 0.19392274474868576, 0.03760603093086393, 0.007292664737217109, 0.001414213562373095, 0.0002742481756762073, 5.318295896944988e-05, 1.031338537721246e-05};
        double iv = inv[0];
#pragma unroll
        for (int q = 1; q < 8; ++q) iv = (i == q) ? inv[q] : iv;
        const double rev = (double)pos * iv * 0.15915494309189535; const float fr = (float)(rev - __builtin_rint(rev));
        f32x2 cs; cs.x = __builtin_amdgcn_cosf(fr); cs.y = __builtin_amdgcn_sinf(fr);
        ((GAS f32x2*)(ws + WS_ROPE))[it] = cs;
    }
    for (int m = gw; m < NTOK; m += NGW) {
        const GAS f32x4* xr = (const GAS f32x4*)(F.x + (size_t)m * DM) + lane; const GAS f32x4* gr = (const GAS f32x4*)F.norm_mix + lane;
        f32x4 v[4]; float s = 0.f;
#pragma unroll
        for (int j = 0; j < 4; ++j) { v[j] = xr[64 * j]; s += (v[j].x * v[j].x + v[j].y * v[j].y) + (v[j].z * v[j].z + v[j].w * v[j].w); }
        const float r = 1.0f / sqrtf(wave_sum(s) * (1.f / DM) + RMS_EPS);
        GAS v2u* o8 = (GAS v2u*)((bf16*)(ws + WS_XN) + (size_t)m * DM) + lane;
#pragma unroll
        for (int j = 0; j < 4; ++j) { const f32x4 g = gr[64 * j]; v2u o; o.x = pk2(v[j].x * r * g.x, v[j].y * r * g.y); o.y = pk2(v[j].z * r * g.z, v[j].w * r * g.w);
#ifdef DBG_XN_COARSE
            o.x = (o.x + 0x00020002u) & 0xfffcfffcu; o.y = (o.y + 0x00020002u) & 0xfffcfffcu;
#endif
            o8[64 * j] = o; }
    }
    for (size_t it = gt; it < (size_t)2 * NEXP * DM / 8; it += NGT) {
        const size_t half = (size_t)NEXP * DM / 8; const bool isv = it >= half; const size_t e = isv ? it - half : it;
        const GAS f32x4* src = (const GAS f32x4*)(isv ? F.peer_v : F.peer_u) + 2 * e;
        const f32x4 a = src[0], b = src[1]; v4u o; o.x = pk2(a.x, a.y); o.y = pk2(a.z, a.w); o.z = pk2(b.x, b.y); o.w = pk2(b.z, b.w);
#ifdef DBG_C_UV
        o.x = COARSE2(o.x); o.y = COARSE2(o.y); o.z = COARSE2(o.z); o.w = COARSE2(o.w);
#endif
        ((GAS v4u*)(ws + (isv ? WS_VB : WS_UB)))[e] = o;
    }
}

struct EpiIn {
    static constexpr bool PERM = true, AFTER_DRAIN = false;
    unsigned char* ws; const float* fbias;
    __device__ __forceinline__ bool operator()(f32x4 (&acc)[2][2][4][2], const pg8::Unit& u, int wr, int wc, int fr, int fq) const {
        const int pn = u.pn, row0 = u.pm * 256 + wr * 64 + fr;
        if (pn == 11) {
            if (wc == 0) {
#pragma unroll
                for (int ai = 0; ai < 2; ++ai)
#pragma unroll
                    for (int m = 0; m < 4; ++m) { const int row = row0 + ai * 128 + m * 16; const f32x4 v0 = acc[ai][0][m][0], v1 = acc[ai][0][m][1];
                        float v[8] = {v0.x, v0.y, v0.z, v0.w, v1.x, v1.y, v1.z, v1.w}, o[8];
                        if (fq == 0) {
#pragma unroll
                            for (int i = 0; i < 8; ++i) { const float z = v[i] + fbias[i]; o[i] = fminf(z, 0.f) - log1pf(__expf(-fabsf(z))); }
                            GAS f32x4* d = (GAS f32x4*)((float*)(ws + WS_LOGF) + (size_t)row * 8); d[0] = (f32x4){o[0], o[1], o[2], o[3]}; d[1] = (f32x4){o[4], o[5], o[6], o[7]};
                        } else {
#pragma unroll
                            for (int i = 0; i < 8; ++i) o[i] = sigmoidf_(v[i]);
                            GAS f32x4* d = (GAS f32x4*)((float*)(ws + WS_GATES) + (size_t)row * 24 + (fq - 1) * 8); d[0] = (f32x4){o[0], o[1], o[2], o[3]}; d[1] = (f32x4){o[4], o[5], o[6], o[7]};
                        } }
            }
            return false;
        }
        bf16* dst; int pitch, colt; float sc = 1.f; int mode = 0;
        bool rope_bj1 = false;
        if (pn < 2)       { dst = (bf16*)(ws + WS_QF); pitch = 512; colt = pn * 256; sc = C2 * DBG_FOXT; }
        else if (pn < 4)  { dst = (bf16*)(ws + WS_KF); pitch = 512; colt = (pn - 2) * 256; }
        else if (pn < 6)  { dst = (bf16*)(ws + WS_VF); pitch = 512; colt = (pn - 4) * 256; }
        else if (pn < 8)  { dst = (bf16*)(ws + WS_QN); pitch = 512; colt = (pn - 6) * 256; sc = C2 * DBG_NSAT; mode = 1; rope_bj1 = true; }
        else if (pn == 8) { dst = (bf16*)(ws + WS_KVC); pitch = 256; colt = 0; }
        else if (pn == 9) { dst = (bf16*)(ws + WS_KVS); pitch = 256; colt = 0; mode = 1; }
        else if (pn == 10){ dst = (bf16*)(ws + WS_KVW); pitch = 256; colt = 0; mode = 1; }
        else              { dst = (bf16*)(ws + WS_GM); pitch = 2048; colt = (pn - 12) * 256; mode = 2; }
        const int cb0 = wc * 32 + 8 * fq;
        const bool ropelane = ((wc & 1) == 0) && (fq < 2);
        const GAS f32x2* rt = (const GAS f32x2*)(ws + WS_ROPE);
#pragma unroll
        for (int ai = 0; ai < 2; ++ai)
#pragma unroll
            for (int m = 0; m < 4; ++m) { const int row = row0 + ai * 128 + m * 16; bf16* rowp = dst + (size_t)row * pitch + colt + cb0;
#pragma unroll
                for (int bj = 0; bj < 2; ++bj) { const f32x4 a0 = acc[ai][bj][m][0], a1 = acc[ai][bj][m][1];
                    float v[8] = {a0.x, a0.y, a0.z, a0.w, a1.x, a1.y, a1.z, a1.w};
                    if (mode == 1 && (bj == 0 || rope_bj1) && ((wc & 1) == 0)) {
                        const int pos = row & (SEQ - 1);
#pragma unroll
                        for (int i = 0; i < 8; ++i) { const float pv = __shfl_xor(v[i], 16); if (ropelane) { const f32x2 cs = rt[pos * 8 + i];
                                v[i] = (fq == 0) ? (v[i] * cs.x - pv * cs.y) : (pv * cs.y + v[i] * cs.x); } }
                    }
                    if (mode == 2) {
#pragma unroll
                        for (int i = 0; i < 8; ++i) v[i] = sigmoidf_(v[i]);
                    }
                    v4u w; w.x = pk2(v[0] * sc, v[1] * sc); w.y = pk2(v[2] * sc, v[3] * sc); w.z = pk2(v[4] * sc, v[5] * sc); w.w = pk2(v[6] * sc, v[7] * sc);
#ifdef DBG_C_INPROJ
                    w.x = COARSE2(w.x); w.y = COARSE2(w.y); w.z = COARSE2(w.z); w.w = COARSE2(w.w);
#endif
                    *(GAS v4u*)(rowp + bj * 128) = w; } }
        return false;
    }
};

__device__ __forceinline__ void p2_compress_unit(Frame& F, int uidx) {
    unsigned char* ws = F.ws; const int lane = F.lane, wid = F.wave;
    const int j = uidx & 1, nb = (uidx >> 1) & 15, g = (uidx >> 5) & 1, b = uidx >> 6;
    const bf16* KVC = (const bf16*)(ws + WS_KVC); const bf16* W1T = (const bf16*)(ws + WS_W1T) + (size_t)j * 128 * 2048; const bf16* W2T = (const bf16*)(ws + WS_W2T) + (size_t)j * 64 * 128;
    LAS float* red = (LAS float*)F.lds;
    LAS bf16* h1b = (LAS bf16*)(F.lds + 65536);
    const int fr = lane & 15, fq = lane >> 4;
    int n = nb * 16 + fr; const int nc = n > 254 ? 254 : n;
    const bf16* arow = KVC + ((size_t)b * SEQ + 16 * nc) * 256 + j * 128 + g * 64;
    f32x4 acc[8];
#pragma unroll
    for (int t = 0; t < 8; ++t) acc[t] = (f32x4){0.f, 0.f, 0.f, 0.f};
#pragma unroll 2
    for (int kk = 0; kk < 8; ++kk) { const int ks = wid * 8 + kk, l = ks >> 1, d = (ks & 1) * 32 + 8 * fq;
        const bf16x8 a = *(const GAS bf16x8*)(arow + (size_t)l * 256 + d);
#pragma unroll
        for (int t = 0; t < 8; ++t) { const bf16x8 bb = *(const GAS bf16x8*)(W1T + (size_t)(t * 16 + fr) * 2048 + ks * 32 + 8 * fq);
            acc[t] = __builtin_amdgcn_mfma_f32_16x16x32_bf16(a, bb, acc[t], 0, 0, 0); } }
#pragma unroll
    for (int t = 0; t < 8; ++t)
#pragma unroll
        for (int r = 0; r < 4; ++r) red[(wid * 16 + 4 * fq + r) * 128 + t * 16 + fr] = acc[t][r];
    __syncthreads();
    { const float* b1 = (const float*)(ws + WS_BIAS1) + j * 128;
#pragma unroll
      for (int i = 0; i < 4; ++i) { const int e = F.tid + 512 * i, rr = e >> 7, cc = e & 127; float s = b1[cc];
#pragma unroll
          for (int w = 0; w < 8; ++w) s += red[(w * 16 + rr) * 128 + cc];
          h1b[rr * 128 + cc] = (bf16)(pk2(gelu_erf(s), 0.f) & 0xffffu); } }
    __syncthreads();
    if (wid < 4) {
        f32x4 a2 = (f32x4){0.f, 0.f, 0.f, 0.f};
#pragma unroll
        for (int k2 = 0; k2 < 4; ++k2) { const bf16x8 a = *(const LAS bf16x8*)(h1b + fr * 128 + k2 * 32 + 8 * fq);
            const bf16x8 bb = *(const GAS bf16x8*)(W2T + (size_t)(wid * 16 + fr) * 128 + k2 * 32 + 8 * fq);
            a2 = __builtin_amdgcn_mfma_f32_16x16x32_bf16(a, bb, a2, 0, 0, 0); }
        bf16* dstb = (bf16*)(ws + (j == 0 ? WS_KCMP : WS_VCMP));
        const GAS f32x2* rt = (const GAS f32x2*)(ws + WS_ROPE);
#pragma unroll
        for (int r = 0; r < 4; ++r) { const int nrow = nb * 16 + 4 * fq + r; float v = a2[r];
            if (j == 0 && wid == 0 && DBG_KROPE >= 0) { const float pv = __shfl_xor(v, 8); const int pos = (16 * nrow + DBG_KROPE) & (SEQ - 1); const f32x2 cs = rt[pos * 8 + (fr & 7)];
                v = (fr < 8) ? (v * cs.x - pv * cs.y) : (pv * cs.y + v * cs.x); }
            if (nrow > 254) v = 0.f;
#ifdef DBG_KCMP_COARSE
            if (j == 0) v = __uint_as_float((__float_as_uint(v) + 0x00020000u) & 0xfffc0000u);
#endif
            dstb[((size_t)b * 256 + nrow) * 128 + g * 64 + wid * 16 + fr] = (bf16)(pk2(v, 0.f) & 0xffffu); }
    }
    __syncthreads();
}
__device__ __forceinline__ void p2_cumsum_wave(Frame& F, int bh) {
    const int b = bh >> 3, h = bh & 7, lane = F.lane;
    const float* lf = (const float*)(F.ws + WS_LOGF) + ((size_t)b * SEQ + lane * 64) * 8 + h;
    float s = 0.f;
    for (int i = 0; i < 64; ++i) s += lf[i * 8];
    float inc = s;
#pragma unroll
    for (int o = 1; o < 64; o <<= 1) { const float t = __shfl_up(inc, o); if (lane >= o) inc += t; }
    float run = inc - s;
    float* cum = (float*)(F.ws + WS_CUM) + (size_t)bh * SEQ + lane * 64;
    for (int i = 0; i < 64; ++i) { run += lf[i * 8]; cum[i] = -LOG2E * DBG_DECAY * run; }
}

namespace att {
constexpr int A_K = 0, A_V = 16384, A_WS = 32768, A_OST = 34816, A_BIG = 67584, A_SEL = 133120, SLOT = 8192;
typedef LAS const char* lds_cptr;
typedef short v4i16_t __attribute__((ext_vector_type(4)));
#define MFMA32(a, b, c) __builtin_amdgcn_mfma_f32_32x32x16_bf16(a, b, c, 0, 0, 0)
__device__ __forceinline__ int crow(int r, int hi) { return (r & 3) + 8 * (r >> 2) + 4 * hi; }
__device__ __forceinline__ void glds16(const void* g, unsigned lds_base) {
    unsigned sv; asm volatile("s_mov_b32 %0, m0\n\ts_mov_b32 m0, %2\n\ts_nop 0\n\tglobal_load_lds_dwordx4 %1, off\n\ts_mov_b32 m0, %0" : "=&s"(sv) : "v"(g), "s"(lds_base) : "memory"); }
__device__ __forceinline__ s16x4 vtr(lds_cptr p) { return __builtin_bit_cast(s16x4, __builtin_amdgcn_ds_read_tr16_b64_v4i16((LAS v4i16_t*)p)); }
#define MX3(a, b, c) __builtin_fmaxf(__builtin_fmaxf((a), (b)), (c))
__device__ __forceinline__ float rowmax(const f32x16& p0, const f32x16& p1) {
    float a = MX3(p0[0], p0[1], p1[0]), b = MX3(p0[2], p0[3], p1[1]); a = MX3(a, p1[2], p1[3]);
#pragma unroll
    for (int r = 4; r < 16; r += 4) { a = MX3(a, p0[r], p0[r + 1]); b = MX3(b, p0[r + 2], p0[r + 3]); a = MX3(a, p1[r], p1[r + 1]); b = MX3(b, p1[r + 2], p1[r + 3]); }
    float m = __builtin_fmaxf(a, b); auto rr = __builtin_amdgcn_permlane32_swap(__float_as_uint(m), __float_as_uint(m), false, false);
    return __builtin_fmaxf(__uint_as_float(rr[0]), __uint_as_float(rr[1])); }

enum { M_FOX = 0, M_CMP1 = 1, M_CMP2 = 2, M_SLC = 3, M_WIN = 4 };
struct St { f32x16 o[2]; float mref, l; };

template <int MODE>
__device__ __forceinline__ void tile_step(LAS unsigned char* lds, int slot, const bf16x8 (&qr)[4], St& st, float rl, int t, int qpos, int q0w, int QBk,
                                          unsigned long long selm, LAS float* wsf, LAS float* impw, const LAS float* cbl, int lane, int r32, int hi) {
    if (MODE == M_FOX) { if (64 * t > q0w + 31) return; }
    const lds_cptr kp = (lds_cptr)lds + A_K + slot * SLOT + hi * 1024 + r32 * 16;
    bf16x8 kf[8];
#pragma unroll
    for (int d0 = 0; d0 < 4; ++d0) { kf[2 * d0] = *(const LAS bf16x8*)(kp + d0 * 2048); kf[2 * d0 + 1] = *(const LAS bf16x8*)(kp + d0 * 2048 + 512); }
    f32x16 s0, s1;
#pragma unroll
    for (int r = 0; r < 16; ++r) { s0[r] = 0.f; s1[r] = 0.f; }
#pragma unroll
    for (int d0 = 0; d0 < 4; ++d0) { s0 = MFMA32(kf[2 * d0], qr[d0], s0); s1 = MFMA32(kf[2 * d0 + 1], qr[d0], s1); }
    if (MODE == M_FOX) {
        const LAS f32x4* cb = (const LAS f32x4*)(cbl + 64 * t + 4 * hi);
#pragma unroll
        for (int g = 0; g < 4; ++g) { const f32x4 a = cb[2 * g], b = cb[8 + 2 * g];
            s0[4 * g] += a.x; s0[4 * g + 1] += a.y; s0[4 * g + 2] += a.z; s0[4 * g + 3] += a.w; s1[4 * g] += b.x; s1[4 * g + 1] += b.y; s1[4 * g + 2] += b.z; s1[4 * g + 3] += b.w; }
    }
    const float NEG = -INFINITY; const int kvb = 64 * t + 4 * hi;
    if (MODE == M_FOX) { if (64 * t + 63 > q0w) {
#pragma unroll
            for (int r = 0; r < 16; ++r) { const int kv = kvb + (r & 3) + 8 * (r >> 2); if (kv > qpos) s0[r] = NEG; if (kv + 32 > qpos) s1[r] = NEG; } } }
    if (MODE == M_CMP1 || MODE == M_CMP2) {
#ifdef DBG_CMP_UNIFORM
#pragma unroll
        for (int r = 0; r < 16; ++r) { s0[r] = 0.f; s1[r] = 0.f; }
#endif
#pragma unroll
        for (int r = 0; r < 16; ++r) { const int n = kvb + (r & 3) + 8 * (r >> 2); if (16 * n + 31 > qpos) s0[r] = NEG; if (16 * (n + 32) + 31 > qpos) s1[r] = NEG; } }
    if (MODE == M_SLC) { const bool allowed = (selm >> t) & 1ull; const bool diag = (t == QBk);
#pragma unroll
        for (int r = 0; r < 16; ++r) { const int kv = kvb + (r & 3) + 8 * (r >> 2); if (!allowed || (diag && kv > qpos)) s0[r] = NEG; if (!allowed || (diag && kv + 32 > qpos)) s1[r] = NEG; } }
    if (MODE == M_WIN) { if (t == QBk || t + 8 == QBk) {
#pragma unroll
            for (int r = 0; r < 16; ++r) { const int kv = kvb + (r & 3) + 8 * (r >> 2); if (kv > qpos || qpos - kv >= 512) s0[r] = NEG; if (kv + 32 > qpos || qpos - (kv + 32) >= 512) s1[r] = NEG; } } }
    if (MODE != M_CMP2) {
        const float rm = rowmax(s0, s1);
        if (__any(rm > st.mref + 8.0f)) {
            const float mnew = fmaxf(st.mref, rm), alpha = __builtin_amdgcn_exp2f(st.mref - mnew); st.l *= alpha; st.mref = mnew;
            if (MODE != M_CMP1) { if (hi == 0) wsf[r32] = alpha; LDS_WAIT();
#pragma unroll
                for (int r = 0; r < 16; ++r) { const float f = wsf[crow(r, hi)]; st.o[0][r] *= f; st.o[1][r] *= f; }
                LDS_WAIT(); }
        }
    }
    float ps = 0.f;
#pragma unroll
    for (int r = 0; r < 16; ++r) { s0[r] = __builtin_amdgcn_exp2f(s0[r] - st.mref); s1[r] = __builtin_amdgcn_exp2f(s1[r] - st.mref); ps += s0[r] + s1[r]; }
    if (MODE != M_CMP2) st.l += ps;
    if (MODE == M_CMP1) return;
    if (MODE == M_CMP2) {
#pragma unroll
        for (int r = 0; r < 16; ++r) { s0[r] *= rl; s1[r] *= rl; }
#pragma unroll
        for (int g = 0; g < 4; ++g) {
            const int j0 = 16 * t + 2 * g + hi, j1 = j0 + 8;
            const float b0 = 0.5f * s0[4 * g + 3], a0 = s0[4 * g] + s0[4 * g + 1] + s0[4 * g + 2] + b0;
            const float b1 = 0.5f * s1[4 * g + 3], a1 = s1[4 * g] + s1[4 * g + 1] + s1[4 * g + 2] + b1;
            __hip_atomic_fetch_add(impw + j0, a0, __ATOMIC_RELAXED, __HIP_MEMORY_SCOPE_WORKGROUP); __hip_atomic_fetch_add(impw + j0 + 1, b0, __ATOMIC_RELAXED, __HIP_MEMORY_SCOPE_WORKGROUP);
            __hip_atomic_fetch_add(impw + j1, a1, __ATOMIC_RELAXED, __HIP_MEMORY_SCOPE_WORKGROUP); if (j1 + 1 < 64) __hip_atomic_fetch_add(impw + j1 + 1, b1, __ATOMIC_RELAXED, __HIP_MEMORY_SCOPE_WORKGROUP);
        }
    }
    v4u pw[4];
    pw[0] = (v4u){pk2(s0[0], s0[1]), pk2(s0[2], s0[3]), pk2(s0[4], s0[5]), pk2(s0[6], s0[7])};
    pw[1] = (v4u){pk2(s0[8], s0[9]), pk2(s0[10], s0[11]), pk2(s0[12], s0[13]), pk2(s0[14], s0[15])};
    pw[2] = (v4u){pk2(s1[0], s1[1]), pk2(s1[2], s1[3]), pk2(s1[4], s1[5]), pk2(s1[6], s1[7])};
    pw[3] = (v4u){pk2(s1[8], s1[9]), pk2(s1[10], s1[11]), pk2(s1[12], s1[13]), pk2(s1[14], s1[15])};
#ifdef DBG_C_P
#pragma unroll
    for (int i_ = 0; i_ < 4; ++i_) { pw[i_].x = COARSE2(pw[i_].x); pw[i_].y = COARSE2(pw[i_].y); pw[i_].z = COARSE2(pw[i_].z); pw[i_].w = COARSE2(pw[i_].w); }
#endif
    const lds_cptr vp = (lds_cptr)lds + A_V + slot * SLOT + ((lane >> 4) & 1) * 32 + (lane & 3) * 8 + (4 * hi + ((lane & 15) >> 2)) * 64;
#pragma unroll
    for (int d0 = 0; d0 < 2; ++d0)
#pragma unroll
        for (int ks = 0; ks < 4; ++ks) { const s16x4 lo = vtr(vp + d0 * 4096 + ks * 1024), hh = vtr(vp + d0 * 4096 + ks * 1024 + 512);
            const bf16x8 vf = (bf16x8){lo[0], lo[1], lo[2], lo[3], hh[0], hh[1], hh[2], hh[3]};
            st.o[d0] = MFMA32(__builtin_bit_cast(bf16x8, pw[ks]), vf, st.o[d0]); }
}

template <int MODE>
__device__ __forceinline__ void run_tiles(LAS unsigned char* lds, unsigned long long tm, const bf16* kbase, const bf16* vbase, int pitch, const bf16x8 (&qr)[4], St& st, float rl,
                                          int qpos, int q0w, int QBk, unsigned long long selm, LAS float* wsf, LAS float* impw, const LAS float* cbl, int lane, int r32, int hi, int wid) {
    const unsigned lds0 = (unsigned)(uintptr_t)lds;
    const bf16* ksrc = kbase + (size_t)lane * pitch + wid * 8;
    const bf16* vsrc = vbase + (size_t)(16 * (wid & 3) + (lane >> 2)) * pitch + (wid >> 2) * 32 + (lane & 3) * 8;
    const unsigned kdst = lds0 + A_K + wid * 1024, vdst = lds0 + A_V + wid * 1024;
    if (tm == 0ull) return;
    int t = __builtin_ctzll(tm); tm &= tm - 1ull; int s = 0;
    glds16(ksrc + (size_t)t * 64 * pitch, (unsigned)__builtin_amdgcn_readfirstlane(kdst));
    if (MODE != M_CMP1) glds16(vsrc + (size_t)t * 64 * pitch, (unsigned)__builtin_amdgcn_readfirstlane(vdst));
    for (;;) {
        VM_WAIT(); __syncthreads();
        int tn = -1;
        if (tm != 0ull) { tn = __builtin_ctzll(tm); tm &= tm - 1ull;
            glds16(ksrc + (size_t)tn * 64 * pitch, (unsigned)__builtin_amdgcn_readfirstlane(kdst + (s ^ 1) * SLOT));
            if (MODE != M_CMP1) glds16(vsrc + (size_t)tn * 64 * pitch, (unsigned)__builtin_amdgcn_readfirstlane(vdst + (s ^ 1) * SLOT)); }
        tile_step<MODE>(lds, s, qr, st, rl, t, qpos, q0w, QBk, selm, wsf, impw, cbl, lane, r32, hi);
        if (tn < 0) break;
        t = tn; s ^= 1;
    }
    LDS_WAIT(); __syncthreads();
}
__device__ __forceinline__ void st_init(St& st) {
#pragma unroll
    for (int r = 0; r < 16; ++r) { st.o[0][r] = 0.f; st.o[1][r] = 0.f; }
    st.mref = -1e30f; st.l = 0.f;
}
__device__ __forceinline__ void store_o(LAS unsigned char* lds, const f32x16 (&o)[2], const float (&rli)[16], bf16* Ow, int lane, int r32, int hi, int wid) {
    LAS bf16* stg = (LAS bf16*)(lds + A_OST) + wid * 2048;
#pragma unroll
    for (int r = 0; r < 16; ++r) { const int orow = crow(r, hi);
#pragma unroll
        for (int d0 = 0; d0 < 2; ++d0) { unsigned w_ = pk2(o[d0][r] * rli[r], 0.f) & 0xffffu;
#ifdef DBG_C_Y
            w_ = (w_ + 2u) & 0xfffcu;
#endif
            stg[orow * 64 + d0 * 32 + r32] = (bf16)w_; } }
    LDS_WAIT();
#pragma unroll
    for (int i = 0; i < 4; ++i) { const int row = i * 8 + (lane >> 3), ch = lane & 7; const v4u v = *(const LAS v4u*)(stg + row * 64 + ch * 8); *(GAS v4u*)(Ow + (size_t)row * 512 + ch * 8) = v; }
    LDS_WAIT();
}
__device__ __forceinline__ void row_to_regs(LAS float* wsf, float val, float (&rli)[16], int r32, int hi) {
    if (hi == 0) wsf[32 + r32] = val; LDS_WAIT();
#pragma unroll
    for (int r = 0; r < 16; ++r) rli[r] = wsf[32 + crow(r, hi)];
    LDS_WAIT();
}

__device__ __forceinline__ void fox_unit(Frame& F, int b, int h, int qb) {
    LAS unsigned char* lds = F.lds; unsigned char* ws = F.ws;
    const int lane = F.lane, wid = F.wave, r32 = lane & 31, hi = lane >> 5, q0 = qb * 256, q0w = q0 + 32 * wid, qpos = q0w + r32;
    LAS float* wsf = (LAS float*)(lds + A_WS) + wid * 64; LAS float* cbl = (LAS float*)(lds + A_BIG);
    const float* cum = (const float*)(ws + WS_CUM) + (size_t)(b * 8 + h) * SEQ;
    for (int i = F.tid; i < 256 * (qb + 1); i += 512) cbl[i] = cum[i];
    const bf16* Qw = (const bf16*)(ws + WS_QF) + ((size_t)b * SEQ + q0w) * 512 + h * 64;
    bf16x8 qr[4];
#pragma unroll
    for (int d0 = 0; d0 < 4; ++d0) qr[d0] = *(const GAS bf16x8*)(Qw + (size_t)r32 * 512 + d0 * 16 + hi * 8);
    St st; st_init(st);
    const int ntile = 4 * (qb + 1); const unsigned long long tm = ntile >= 64 ? ~0ull : ((1ull << ntile) - 1ull);
    const bf16* kb = (const bf16*)(ws + WS_KF) + (size_t)b * SEQ * 512 + h * 64; const bf16* vb = (const bf16*)(ws + WS_VF) + (size_t)b * SEQ * 512 + h * 64;
    run_tiles<M_FOX>(lds, tm, kb, vb, 512, qr, st, 0.f, qpos, q0w, 0, 0ull, wsf, nullptr, cbl, lane, r32, hi, wid);
    float lt = st.l + __shfl_xor(st.l, 32);
#ifndef DBG_SC_FOX
#define DBG_SC_FOX 1.0f
#endif
    float rli[16]; row_to_regs(wsf, DBG_SC_FOX / lt, rli, r32, hi);
    bf16* Ow = (bf16*)(ws + WS_Y) + ((size_t)b * SEQ + q0w) * 512 + h * 64;
    store_o(lds, st.o, rli, Ow, lane, r32, hi, wid);
    __syncthreads();
}

__device__ __forceinline__ void nsa_unit(Frame& F, int b, int g, int QBk) {
    LAS unsigned char* lds = F.lds; unsigned char* ws = F.ws;
    const int lane = F.lane, wid = F.wave, r32 = lane & 31, hi = lane >> 5, hh = wid >> 1, qoff = 32 * (wid & 1), q0 = 64 * QBk, q0w = q0 + qoff, qpos = q0w + r32, head = 4 * g + hh;
    LAS float* wsf = (LAS float*)(lds + A_WS) + wid * 64; LAS float* imp = (LAS float*)(lds + A_BIG);
    LAS unsigned long long* selw = (LAS unsigned long long*)(lds + A_SEL);
    LAS float* impw = imp + (size_t)((hh * 64 + qoff + r32) * 64);
    { LAS float* z = imp + (size_t)((hh * 64 + qoff) * 64);
#pragma unroll 8
      for (int i = 0; i < 32; ++i) z[i * 64 + lane] = 0.f; }
    const bf16* Qw = (const bf16*)(ws + WS_QN) + ((size_t)b * SEQ + q0w) * 512 + head * 64;
    bf16x8 qr[4];
#pragma unroll
    for (int d0 = 0; d0 < 4; ++d0) qr[d0] = *(const GAS bf16x8*)(Qw + (size_t)r32 * 512 + d0 * 16 + hi * 8);
    const float* gat = (const float*)(ws + WS_GATES) + ((size_t)b * SEQ + qpos) * 24 + head * 3;
    float g_cmp = gat[0], g_slc = gat[1], g_win = gat[2];
#ifdef DBG_NO_CMP
    g_cmp = 0.f;
#endif
#ifdef DBG_SC_CMP
    g_cmp *= DBG_SC_CMP;
#endif
#ifdef DBG_SC_SLC
    g_slc *= DBG_SC_SLC;
#endif
#ifdef DBG_SC_WIN
    g_win *= DBG_SC_WIN;
#endif
#ifdef DBG_NO_SLC
    g_slc = 0.f;
#endif
#ifdef DBG_NO_WIN
    g_win = 0.f;
#endif
    float rli[16];
    St st;
    const int ntc = ((q0 + 32) >> 10) + 1;
    const unsigned long long tmc = (1ull << ntc) - 1ull;
    const bf16* kc = (const bf16*)(ws + WS_KCMP) + (size_t)b * 256 * 128 + g * 64; const bf16* vc = (const bf16*)(ws + WS_VCMP) + (size_t)b * 256 * 128 + g * 64;
    st_init(st);
    run_tiles<M_CMP1>(lds, tmc, kc, vc, 128, qr, st, 0.f, qpos, q0w, QBk, 0ull, wsf, impw, nullptr, lane, r32, hi, wid);
    { const float lt = st.l + __shfl_xor(st.l, 32); const float rl = lt > 0.f ? 1.0f / lt : 0.f; const float mkeep = st.mref;
      st_init(st); st.mref = mkeep;
      run_tiles<M_CMP2>(lds, tmc, kc, vc, 128, qr, st, rl, qpos, q0w, QBk, 0ull, wsf, impw, nullptr, lane, r32, hi, wid); }
    __syncthreads();
    for (int qq = 0; qq < 8; ++qq) { const int q = wid * 8 + qq, j = lane;
        float v = ((imp[(0 * 64 + q) * 64 + j] + imp[(1 * 64 + q) * 64 + j]) + imp[(2 * 64 + q) * 64 + j]) + imp[(3 * 64 + q) * 64 + j];
#ifdef DBG_IMPNOISE
        { const unsigned hsh = ((unsigned)(q0 + q) * 2654435761u) ^ ((unsigned)(j + 64 * (b * 2 + g)) * 2246822519u); const float nz = ((float)((hsh >> 9) & 0xffff) * (1.0f / 65536.0f) - 0.5f); v = v * (1.0f + DBG_IMPNOISE * nz); }
#endif
        const bool forced = (j == 0) || (j == QBk) || (j == QBk - 1), causal = j <= QBk;
        const float score = forced ? 1e9f : (causal ? v : -1.0f);
        int rank = 0;
#pragma unroll 16
        for (int i = 0; i < 64; ++i) { const float si = __uint_as_float(__builtin_amdgcn_readlane(__float_as_uint(score), i)); rank += (si > score || (si == score && i < j)) ? 1 : 0; }
        const unsigned long long msk = __ballot(causal && rank < 16);
        if (lane == 0) selw[q] = msk; }
    __syncthreads();
    LAS float* otl = imp + wid * 2048 + lane;
    row_to_regs(wsf, g_cmp, rli, r32, hi);
#pragma unroll
    for (int r = 0; r < 16; ++r) { otl[(2 * r) * 64] = st.o[0][r] * rli[r]; otl[(2 * r + 1) * 64] = st.o[1][r] * rli[r]; }
    const unsigned long long selm = selw[qoff + r32];
    unsigned long long um = selw[lane];
#pragma unroll
    for (int o = 1; o < 64; o <<= 1) { const unsigned lo = __shfl_xor((unsigned)um, o), hi2 = __shfl_xor((unsigned)(um >> 32), o); um |= ((unsigned long long)hi2 << 32) | lo; }
    um = ((unsigned long long)__builtin_amdgcn_readfirstlane((unsigned)(um >> 32)) << 32) | (unsigned)__builtin_amdgcn_readfirstlane((unsigned)um);
    const bf16* ksl = (const bf16*)(ws + WS_KVS) + (size_t)b * SEQ * 256 + g * 64; const bf16* vsl = ksl + 128;
    st_init(st);
    run_tiles<M_SLC>(lds, um, ksl, vsl, 256, qr, st, 0.f, qpos, q0w, QBk, selm, wsf, impw, nullptr, lane, r32, hi, wid);
    { const float lt = st.l + __shfl_xor(st.l, 32); row_to_regs(wsf, g_slc / lt, rli, r32, hi);
#pragma unroll
      for (int r = 0; r < 16; ++r) { otl[(2 * r) * 64] += st.o[0][r] * rli[r]; otl[(2 * r + 1) * 64] += st.o[1][r] * rli[r]; } }
    const bf16* kw = (const bf16*)(ws + WS_KVW) + (size_t)b * SEQ * 256 + g * 64; const bf16* vw = kw + 128;
    { const int tlo = QBk >= 8 ? QBk - 8 : 0; const int nt = QBk - tlo + 1; const unsigned long long tmw = ((1ull << nt) - 1ull) << tlo;
      st_init(st);
      run_tiles<M_WIN>(lds, tmw, kw, vw, 256, qr, st, 0.f, qpos, q0w, QBk, 0ull, wsf, impw, nullptr, lane, r32, hi, wid); }
    { const float lt = st.l + __shfl_xor(st.l, 32); row_to_regs(wsf, g_win / lt, rli, r32, hi);
#pragma unroll
      for (int r = 0; r < 16; ++r) { st.o[0][r] = otl[(2 * r) * 64] + st.o[0][r] * rli[r]; st.o[1][r] = otl[(2 * r + 1) * 64] + st.o[1][r] * rli[r]; } }
#pragma unroll
    for (int r = 0; r < 16; ++r) rli[r] = 1.0f;
    bf16* Ow = (bf16*)(ws + WS_Y) + ((size_t)NTOK + (size_t)b * SEQ + q0w) * 512 + head * 64;
    store_o(lds, st.o, rli, Ow, lane, r32, hi, wid);
    __syncthreads();
}
#undef MFMA32
#undef MX3
}

__device__ __forceinline__ void p3_attention(Frame& F) {
    volatile LAS unsigned* qslot = F.MISC + 16;
    for (;;) {
        if (F.tid == 0) qslot[0] = __hip_atomic_fetch_add(F.ctl + CW_QATT, 1u, RLX_AGENT);
        __syncthreads();
        const unsigned u = qslot[0];
        __syncthreads();
        if (u >= 2048u) break;
        const int k = (int)(u >> 1);
        if ((u & 1u) == 0u) { const int qb = 15 - (k >> 6), bh = k & 63; att::fox_unit(F, bh >> 3, bh & 7, qb); }
        else { const int QBk = 63 - (k >> 4), bg = k & 15; att::nsa_unit(F, bg >> 1, bg & 1, QBk); }
    }
}

struct MergeOrder {
    int vcu, G;
    __device__ __forceinline__ bool next(int i, pg8::Unit& u) const { const int p = (i >> 1) * G + vcu; if (p >= 512) return false; const int br = i & 1, tm = p >> 2, tn = p & 3; u.pm = br * 128 + tm; u.pn = br * 4 + tn; return true; }
    __device__ __forceinline__ void a_ready(const pg8::Unit&) const {}
    __device__ __forceinline__ void done(const pg8::Unit&) const {}
};
struct EpiMerge {
    static constexpr bool PERM = true, AFTER_DRAIN = false;
    unsigned char* ws;
    __device__ __forceinline__ bool operator()(f32x4 (&acc)[2][2][4][2], const pg8::Unit& u, int wr, int wc, int fr, int fq) const {
        const int br = u.pm >> 7, tm = u.pm & 127, tn = u.pn & 3;
        const int row0 = tm * 256 + wr * 64 + fr, col0 = tn * 256 + wc * 32 + 8 * fq;
        const bf16* GM = (const bf16*)(ws + WS_GM); bf16* MG = (bf16*)(ws + WS_MERGED);
#pragma unroll
        for (int ai = 0; ai < 2; ++ai)
#pragma unroll
            for (int m = 0; m < 4; ++m) { const int row = row0 + ai * 128 + m * 16;
#pragma unroll
                for (int bj = 0; bj < 2; ++bj) { const int col = col0 + bj * 128;
                    const v4u g1w = *(const GAS v4u*)(GM + (size_t)row * 2048 + 1024 + col);
                    float g1[8] = {bf_lo(g1w.x), bf_hi(g1w.x), bf_lo(g1w.y), bf_hi(g1w.y), bf_lo(g1w.z), bf_hi(g1w.z), bf_lo(g1w.w), bf_hi(g1w.w)};
                    f32x4& a0 = acc[ai][bj][m][0]; f32x4& a1 = acc[ai][bj][m][1];
                    if (br == 0) {
                        const v4u g0w = *(const GAS v4u*)(GM + (size_t)row * 2048 + col);
                        float g0[8] = {bf_lo(g0w.x), bf_hi(g0w.x), bf_lo(g0w.y), bf_hi(g0w.y), bf_lo(g0w.z), bf_hi(g0w.z), bf_lo(g0w.w), bf_hi(g0w.w)};
                        float rt[8];
#pragma unroll
                        for (int i = 0; i < 8; ++i) rt[i] = g1[i] > 0.f ? g0[i] * __builtin_amdgcn_rcpf(g1[i]) : 0.f;
                        a0.x *= rt[0]; a0.y *= rt[1]; a0.z *= rt[2]; a0.w *= rt[3]; a1.x *= rt[4]; a1.y *= rt[5]; a1.z *= rt[6]; a1.w *= rt[7];
                    } else {
                        v4u w; w.x = pk2(a0.x * g1[0], a0.y * g1[1]); w.y = pk2(a0.z * g1[2], a0.w * g1[3]); w.z = pk2(a1.x * g1[4], a1.y * g1[5]); w.w = pk2(a1.z * g1[6], a1.w * g1[7]);
#ifdef DBG_C_MERGED
                        w.x = COARSE2(w.x); w.y = COARSE2(w.y); w.z = COARSE2(w.z); w.w = COARSE2(w.w);
#endif
                        *(GAS v4u*)(MG + (size_t)row * 1024 + col) = w;
                    } } }
        return br == 0;
    }
};
#ifndef DBG_DECAY
#define DBG_DECAY 1.0f
#endif
#ifndef DBG_TEMP
#define DBG_TEMP 1.0f
#endif
#ifndef DBG_PEERSCALE
#define DBG_PEERSCALE 1.0f
#endif
#ifndef DBG_MIXSCALE
#define DBG_MIXSCALE 1.0f
#endif
struct EpiOut {
    static constexpr bool PERM = false, AFTER_DRAIN = false;
    unsigned char* ws; const float* x; float* out; const float* gffn;
    __device__ __forceinline__ bool operator()(f32x4 (&acc)[2][2][4][2], const pg8::Unit& u, int wr, int wc, int fr, int fq) const {
        const int row0 = u.pm * 256 + wr * 64 + fr, col0 = u.pn * 256 + wc * 32 + 4 * fq;
        bf16* HB = (bf16*)(ws + WS_HB); float* SS = (float*)(ws + WS_SS);
#pragma unroll
        for (int ai = 0; ai < 2; ++ai)
#pragma unroll
            for (int m = 0; m < 4; ++m) { const int row = row0 + ai * 128 + m * 16; float ssq = 0.f;
#pragma unroll
                for (int bj = 0; bj < 2; ++bj)
#pragma unroll
                    for (int n = 0; n < 2; ++n) { const int col = col0 + bj * 128 + n * 16; const size_t off = (size_t)row * 1024 + col;
                        const f32x4 xv = *(const GAS f32x4*)(x + off); const f32x4 hv = xv + acc[ai][bj][m][n] * DBG_MIXSCALE; *(GAS f32x4*)(out + off) = hv;
                        const f32x4 gv = *(const GAS f32x4*)(gffn + col); v2u w; w.x = pk2(hv.x * gv.x, hv.y * gv.y); w.y = pk2(hv.z * gv.z, hv.w * gv.w); *(GAS v2u*)(HB + off) = w;
                        ssq += (hv.x * hv.x + hv.y * hv.y) + (hv.z * hv.z + hv.w * hv.w); }
                ssq += __shfl_xor(ssq, 16); ssq += __shfl_xor(ssq, 32);
                if (fq == 0) atomicAdd(SS + row, ssq); }
        return false;
    }
};
struct EpiF32 {
    static constexpr bool PERM = false, AFTER_DRAIN = false;
    float* O; int ldc;
    __device__ __forceinline__ bool operator()(f32x4 (&acc)[2][2][4][2], const pg8::Unit& u, int wr, int wc, int fr, int fq) const {
        const int row0 = u.pm * 256 + wr * 64 + fr, col0 = u.pn * 256 + wc * 32 + 4 * fq;
#pragma unroll
        for (int ai = 0; ai < 2; ++ai)
#pragma unroll
            for (int m = 0; m < 4; ++m) { float* rowp = O + (size_t)(row0 + ai * 128 + m * 16) * ldc + col0;
#pragma unroll
                for (int bj = 0; bj < 2; ++bj)
#pragma unroll
                    for (int n = 0; n < 2; ++n) *(GAS f32x4*)(rowp + bj * 128 + n * 16) = acc[ai][bj][m][n]; }
        return false;
    }
};

#ifdef DBG_F32SCORES
__device__ __forceinline__ void p6_naive(Frame& F) {
    LAS float* hn = (LAS float*)F.lds; LAS float* qv = hn + 8 * 1024;
    const float* SS = (const float*)(F.ws + WS_SS); float* SC = (float*)(F.ws + WS_SC);
    for (int g8 = blockIdx.x; g8 < NTOK / 8; g8 += F.G) { const int t0 = g8 * 8;
        for (int e = F.tid; e < 8 * 1024; e += 512) { const int tk = e >> 10, d = e & 1023; const float rt = 1.0f / sqrtf(SS[t0 + tk] * (1.f / DM) + RMS_EPS); hn[e] = F.out[(size_t)(t0 + tk) * 1024 + d] * F.norm_ffn[d] * rt; }
        __syncthreads();
        { const int c0 = F.tid * 4; float acc[8][4];
          for (int i = 0; i < 8; ++i) for (int j = 0; j < 4; ++j) acc[i][j] = 0.f;
          for (int k = 0; k < 1024; ++k) { const f32x4 w = *(const GAS f32x4*)(F.peer_wq + (size_t)k * 2048 + c0);
#pragma unroll
              for (int i = 0; i < 8; ++i) { const float hv = hn[i * 1024 + k]; acc[i][0] += hv * w.x; acc[i][1] += hv * w.y; acc[i][2] += hv * w.z; acc[i][3] += hv * w.w; } }
#pragma unroll
          for (int i = 0; i < 8; ++i) { qv[i * 2048 + c0] = acc[i][0]; qv[i * 2048 + c0 + 1] = acc[i][1]; qv[i * 2048 + c0 + 2] = acc[i][2]; qv[i * 2048 + c0 + 3] = acc[i][3]; } }
        __syncthreads();
        for (int n = F.tid; n < 2048; n += 512) { const int hp = n >> 7; float a[8];
#pragma unroll
            for (int i = 0; i < 8; ++i) a[i] = 0.f;
            for (int d = 0; d < 128; ++d) { const float sk = F.peer_sk[(size_t)n * 128 + d];
#pragma unroll
                for (int i = 0; i < 8; ++i) a[i] += qv[i * 2048 + hp * 128 + d] * sk; }
#pragma unroll
            for (int i = 0; i < 8; ++i) { const float rt = 1.0f / sqrtf(SS[t0 + i] * (1.f / DM) + RMS_EPS); SC[(size_t)(t0 + i) * 2048 + n] = a[i] / rt; } }
        __syncthreads(); }
}
#endif
__device__ __forceinline__ unsigned mono_key(float f) { const unsigned u = __float_as_uint(f); return u ^ ((unsigned)((int)u >> 31) | 0x80000000u); }
__device__ __forceinline__ float unmono(unsigned k) { const unsigned u = (k & 0x80000000u) ? (k ^ 0x80000000u) : ~k; return __uint_as_float(u); }
#define INS16(list, key) do { unsigned k_ = (key); _Pragma("unroll") for (int e_ = 0; e_ < 16; ++e_) { const unsigned hi_ = max(list[e_], k_); k_ = min(list[e_], k_); list[e_] = hi_; } } while (0)
__device__ __forceinline__ void p7_batch(Frame& F, int t0) {
    unsigned char* ws = F.ws; const int tid = F.tid, lane = F.lane, wid = F.wave;
    LAS unsigned* keys = (LAS unsigned*)F.lds;
    LAS int* eidx = (LAS int*)(F.lds + 32768);
    LAS float* ewt = (LAS float*)(F.lds + 49152);
    const float* SC = (const float*)(ws + WS_SC); const float* SS = (const float*)(ws + WS_SS);
    { const int tok = tid >> 4, hp = tid & 15; const GAS f32x4* p4 = (const GAS f32x4*)(SC + (size_t)(t0 + tok) * 2048 + hp * 128);
      unsigned list[16];
#pragma unroll
      for (int e = 0; e < 16; ++e) list[e] = 0u;
#pragma unroll 2
      for (int c = 0; c < 32; ++c) { f32x4 v = p4[c];
#ifdef DBG_SCNOISE
          { const unsigned hb_ = ((unsigned)(t0 + tok) * 2654435761u) ^ ((unsigned)(hp * 128 + 4 * c) * 2246822519u);
            v.x += DBG_SCNOISE * ((float)((hb_ >> 3) & 1023) / 1024.f - 0.5f) * 3.46f; v.y += DBG_SCNOISE * ((float)((hb_ >> 13) & 1023) / 1024.f - 0.5f) * 3.46f;
            const unsigned hc_ = hb_ * 747796405u + 2891336453u;
            v.z += DBG_SCNOISE * ((float)((hc_ >> 3) & 1023) / 1024.f - 0.5f) * 3.46f; v.w += DBG_SCNOISE * ((float)((hc_ >> 13) & 1023) / 1024.f - 0.5f) * 3.46f; }
#endif
          INS16(list, (mono_key(v.x) & ~127u) | (unsigned)(127 - (4 * c + 0))); INS16(list, (mono_key(v.y) & ~127u) | (unsigned)(127 - (4 * c + 1)));
          INS16(list, (mono_key(v.z) & ~127u) | (unsigned)(127 - (4 * c + 2))); INS16(list, (mono_key(v.w) & ~127u) | (unsigned)(127 - (4 * c + 3))); }
#pragma unroll
      for (int e = 0; e < 16; ++e) keys[(tok * 16 + hp) * 16 + e] = list[e]; }
    __syncthreads();
    if (tid < 256) { const int tok = tid >> 3, hd = tid & 7; const LAS unsigned* ka = keys + (tok * 16 + 2 * hd) * 16; const LAS unsigned* kb = ka + 16;
        float a[16], bq[16];
#pragma unroll
        for (int e = 0; e < 16; ++e) { a[e] = unmono(ka[e] & ~127u); bq[e] = unmono(kb[e] & ~127u); }
        unsigned list[16];
#pragma unroll
        for (int e = 0; e < 16; ++e) list[e] = 0u;
#pragma unroll
        for (int i = 0; i < 16; ++i)
#pragma unroll
            for (int j = 0; j < 16; ++j) if ((i + 1) * (j + 1) <= 16) INS16(list, (mono_key(a[i] + bq[j]) & ~255u) | (unsigned)(255 - (i * 16 + j)));
        const float rt = 1.0f / sqrtf(SS[t0 + tok] * (1.f / DM) + RMS_EPS);
        float sv[16]; float den = 0.f;
#pragma unroll
        for (int e = 0; e < 16; ++e) { const int pos = 255 - (int)(list[e] & 255u), i = pos >> 4, j = pos & 15; const unsigned k1 = ka[i], k2 = kb[j];
            sv[e] = (unmono(k1 & ~127u) + unmono(k2 & ~127u)) * rt * DBG_TEMP; eidx[tok * 128 + hd * 16 + e] = (127 - (int)(k1 & 127u)) * 128 + (127 - (int)(k2 & 127u)); }
#ifdef DBG_LOGITSTAT
        atomicAdd((float*)(F.ctl + 12400), (sv[0] - sv[15]) * (1.0f / 262144.0f));
        atomicMax((unsigned*)(F.ctl + 12401), __float_as_uint(sv[0] - sv[15]));
        atomicMax((unsigned*)(F.ctl + 12402), __float_as_uint(rt));
        atomicMax((unsigned*)(F.ctl + 12403), __float_as_uint(sv[0]));
#endif
        const float smax = sv[0];
#pragma unroll
        for (int e = 0; e < 16; ++e) { sv[e] = __expf(sv[e] - smax); den += sv[e]; }
        const float rden = 1.0f / den;
#pragma unroll
#ifdef DBG_REVW
        for (int e = 0; e < 16; ++e) ewt[tok * 128 + hd * 16 + e] = sv[15 - e] * rden; }
#else
        for (int e = 0; e < 16; ++e) ewt[tok * 128 + hd * 16 + e] = (e >= DBG_KEEP) ? 0.f : sv[e] * rden; }
#endif
    __syncthreads();
    const bf16* UB = (const bf16*)(ws + WS_UB); const bf16* VB = (const bf16*)(ws + WS_VB);
    for (int tt = 0; tt < 4; ++tt) { const int tok = wid * 4 + tt, t = t0 + tok;
        const float rt = 1.0f / sqrtf(SS[t] * (1.f / DM) + RMS_EPS);
        float hn[16], hres[16], out[16];
        { const GAS f32x4* hp_ = (const GAS f32x4*)(F.out + (size_t)t * DM); const GAS f32x4* gp = (const GAS f32x4*)F.norm_ffn;
#pragma unroll
          for (int q = 0; q < 4; ++q) { const int i4 = (q >> 1) * 128 + 2 * lane + (q & 1); const f32x4 hv = hp_[i4], gv = gp[i4];
              hres[4 * q] = hv.x; hres[4 * q + 1] = hv.y; hres[4 * q + 2] = hv.z; hres[4 * q + 3] = hv.w;
              hn[4 * q] = hv.x * gv.x * rt; hn[4 * q + 1] = hv.y * gv.y * rt; hn[4 * q + 2] = hv.z * gv.z * rt; hn[4 * q + 3] = hv.w * gv.w * rt; } }
#pragma unroll
        for (int i = 0; i < 16; ++i) out[i] = 0.f;
        for (int hd = 0; hd < 8; ++hd) {
            float part[16];
#pragma unroll
            for (int e = 0; e < 16; ++e) { const int ex = __builtin_amdgcn_readfirstlane(eidx[tok * 128 + hd * 16 + e]);
                const GAS v4u* up = (const GAS v4u*)(UB + (size_t)ex * DM); const v4u u0 = up[lane], u1 = up[64 + lane];
                float s = bf_lo(u0.x) * hn[0]; s += bf_hi(u0.x) * hn[1]; s += bf_lo(u0.y) * hn[2]; s += bf_hi(u0.y) * hn[3]; s += bf_lo(u0.z) * hn[4]; s += bf_hi(u0.z) * hn[5]; s += bf_lo(u0.w) * hn[6]; s += bf_hi(u0.w) * hn[7];
                s += bf_lo(u1.x) * hn[8]; s += bf_hi(u1.x) * hn[9]; s += bf_lo(u1.y) * hn[10]; s += bf_hi(u1.y) * hn[11]; s += bf_lo(u1.z) * hn[12]; s += bf_hi(u1.z) * hn[13]; s += bf_lo(u1.w) * hn[14]; s += bf_hi(u1.w) * hn[15];
                part[e] = s; }
#pragma unroll
            for (int e = 0; e < 8; ++e) { const bool up = (lane & 32) != 0; const float keep = up ? part[e + 8] : part[e], give = up ? part[e] : part[e + 8]; part[e] = keep + __shfl_xor(give, 32); }
#pragma unroll
            for (int e = 0; e < 4; ++e) { const bool up = (lane & 16) != 0; const float keep = up ? part[e + 4] : part[e], give = up ? part[e] : part[e + 4]; part[e] = keep + __shfl_xor(give, 16); }
#pragma unroll
            for (int e = 0; e < 2; ++e) { const bool up = (lane & 8) != 0; const float keep = up ? part[e + 2] : part[e], give = up ? part[e] : part[e + 2]; part[e] = keep + __shfl_xor(give, 8); }
            { const bool up = (lane & 4) != 0; const float keep = up ? part[1] : part[0], give = up ? part[0] : part[1]; part[0] = keep + __shfl_xor(give, 4); }
            float act = part[0]; act += __shfl_xor(act, 1); act += __shfl_xor(act, 2);
            const float coef = ewt[tok * 128 + hd * 16 + ((lane >> 2) & 15)] * gelu_erf(act * DBG_ACTSCALE);
#pragma unroll
            for (int e = 0; e < 16; ++e) { const int ex = __builtin_amdgcn_readfirstlane(eidx[tok * 128 + hd * 16 + e]);
                const float c = __uint_as_float(__builtin_amdgcn_readlane(__float_as_uint(coef), 4 * e));
                const GAS v4u* vp = (const GAS v4u*)(VB + (size_t)ex * DM); const v4u v0 = vp[lane], v1 = vp[64 + lane];
                out[0] += c * bf_lo(v0.x); out[1] += c * bf_hi(v0.x); out[2] += c * bf_lo(v0.y); out[3] += c * bf_hi(v0.y); out[4] += c * bf_lo(v0.z); out[5] += c * bf_hi(v0.z); out[6] += c * bf_lo(v0.w); out[7] += c * bf_hi(v0.w);
                out[8] += c * bf_lo(v1.x); out[9] += c * bf_hi(v1.x); out[10] += c * bf_lo(v1.y); out[11] += c * bf_hi(v1.y); out[12] += c * bf_lo(v1.z); out[13] += c * bf_hi(v1.z); out[14] += c * bf_lo(v1.w); out[15] += c * bf_hi(v1.w); }
        }
        float ssq = 0.f;
#pragma unroll
        for (int i = 0; i < 16; ++i) { out[i] = out[i] * DBG_PEERSCALE + hres[i]; ssq += out[i] * out[i]; }
        const float rf = 1.0f / sqrtf(wave_sum(ssq) * (1.f / DM) + RMS_EPS);
        { GAS f32x4* op = (GAS f32x4*)(F.out + (size_t)t * DM); const GAS f32x4* gp = (const GAS f32x4*)F.norm_final;
#pragma unroll
          for (int q = 0; q < 4; ++q) { const int i4 = (q >> 1) * 128 + 2 * lane + (q & 1); const f32x4 gv = gp[i4];
              op[i4] = (f32x4){out[4 * q] * rf * gv.x * DBG_OUTSCALE, out[4 * q + 1] * rf * gv.y * DBG_OUTSCALE, out[4 * q + 2] * rf * gv.z * DBG_OUTSCALE, out[4 * q + 3] * rf * gv.w * DBG_OUTSCALE}; } }
    }
    __syncthreads();
}

#ifdef DBG_CHECK
#ifndef DBG_NS
#define DBG_NS 64
#endif
#ifndef DBG_TOL
#define DBG_TOL 0.03f
#endif
constexpr int CW_DBG = 12288, CW_L2 = 12352;
__device__ __forceinline__ void dbg_l2(Frame& F, int cls, float num, float den) { atomicAdd((float*)(F.ctl + CW_L2) + cls, num); atomicAdd((float*)(F.ctl + CW_L2) + 8 + cls, den); }
__device__ __forceinline__ double dbg_inv(int i) { switch (i) { case 0: return 1.0; case 1: return 0.19392274474868576; case 2: return 0.03760603093086393; case 3: return 0.007292664737217109; case 4: return 0.001414213562373095; case 5: return 0.0002742481756762073; case 6: return 5.318295896944988e-05; default: return 1.031338537721246e-05; } }
__device__ __forceinline__ void dbg_cs(int pos, int i, float& c, float& s) { const double rev = (double)pos * dbg_inv(i) * 0.15915494309189535; const float a = (float)((rev - __builtin_rint(rev)) * 6.283185307179586); c = cosf(a); s = sinf(a); }
__device__ __forceinline__ float bf2f(bf16 v) { return __uint_as_float((unsigned)v << 16); }
__device__ __forceinline__ void dbg_flag(Frame& F, int bit, float err, float ref) { if (err > DBG_TOL * ref + 1e-3f) atomicOr((unsigned*)(F.ctl + CW_DBG), 1u << bit); }
__device__ __forceinline__ void dbg_check_inproj(Frame& F) {
    unsigned char* ws = F.ws; LAS float* xs = (LAS float*)F.lds;
    for (int smp = blockIdx.x; smp < DBG_NS; smp += F.G) {
        const int t = (int)(((unsigned)smp * 2246822519u) >> 9) & (NTOK - 1);
        float ss = 0.f; for (int k = F.tid; k < 1024; k += 512) { const float v = F.x[(size_t)t * 1024 + k]; ss += v * v; }
        ss = wave_sum(ss); LAS float* red = xs + 1024; if (F.lane == 0) red[F.wave] = ss; __syncthreads();
        float tot = 0.f; for (int w = 0; w < 8; ++w) tot += red[w]; const float r = 1.0f / sqrtf(tot / 1024.f + RMS_EPS);
        for (int k = F.tid; k < 1024; k += 512) xs[k] = F.x[(size_t)t * 1024 + k] * r * F.norm_mix[k];
        __syncthreads();
        float me0 = 0, me1 = 0, me2 = 0, me3 = 0, mr0 = 0, mr1 = 0, mr2 = 0, mr3 = 0; float n2a = 0, d2a = 0, n2b = 0, d2b = 0, n2c = 0, d2c = 0, n2d = 0, d2d = 0;
        for (int n = F.tid; n < 5120; n += 512) { const int sc = src_col_in(n); if (sc < 0) continue;
            float acc = 0.f; for (int k = 0; k < 1024; ++k) acc += xs[k] * F.w_in[(size_t)k * 4896 + sc];
            const int pos = t & 4095; float ref, got; int cls = 0;
            auto dotcol = [&](int nn) { const int s2 = src_col_in(nn); float a = 0.f; for (int k = 0; k < 1024; ++k) a += xs[k] * F.w_in[(size_t)k * 4896 + s2]; return a; };
            const bool ropeseg = (n >= 1536 && n < 2048) || (n >= 2304 && n < 2432) || (n >= 2560 && n < 2688);
            float val = acc;
            if (ropeseg && (n & 63) < 16) { const int i = n & 7; float c, s; dbg_cs(pos, i, c, s);
                if ((n & 63) < 8) { const float x2 = dotcol(n + 8); val = acc * c - x2 * s; } else { const float x1 = dotcol(n - 8); val = x1 * s + acc * c; } cls = 1; }
            if (n < 512) { ref = val * C2; got = bf2f(((const bf16*)(ws + WS_QF))[(size_t)t * 512 + n]); }
            else if (n < 1024) { ref = val; got = bf2f(((const bf16*)(ws + WS_KF))[(size_t)t * 512 + n - 512]); }
            else if (n < 1536) { ref = val; got = bf2f(((const bf16*)(ws + WS_VF))[(size_t)t * 512 + n - 1024]); }
            else if (n < 2048) { ref = val * C2; got = bf2f(((const bf16*)(ws + WS_QN))[(size_t)t * 512 + n - 1536]); }
            else if (n < 2304) { ref = val; got = bf2f(((const bf16*)(ws + WS_KVC))[(size_t)t * 256 + n - 2048]); }
            else if (n < 2560) { ref = val; got = bf2f(((const bf16*)(ws + WS_KVS))[(size_t)t * 256 + n - 2304]); }
            else if (n < 2816) { ref = val; got = bf2f(((const bf16*)(ws + WS_KVW))[(size_t)t * 256 + n - 2560]); }
            else if (n < 2824) { const float z = val + F.fbias[n - 2816]; ref = -log1pf(expf(-z)); got = ((const float*)(ws + WS_LOGF))[(size_t)t * 8 + n - 2816]; cls = 2; }
            else if (n < 2848) { ref = 1.f / (1.f + expf(-val)); got = ((const float*)(ws + WS_GATES))[(size_t)t * 24 + n - 2824]; cls = 3; }
            else { ref = 1.f / (1.f + expf(-val)); got = bf2f(((const bf16*)(ws + WS_GM))[(size_t)t * 2048 + n - 3072]); cls = 3; }
            const float er_ = fabsf(ref - got), rf_ = fabsf(ref); { const int c_ = 2 + cls; if (c_ == 2) { n2a += er_ * er_; d2a += rf_ * rf_; } else if (c_ == 3) { n2b += er_ * er_; d2b += rf_ * rf_; } else if (c_ == 4) { n2c += er_ * er_; d2c += rf_ * rf_; } else { n2d += er_ * er_; d2d += rf_ * rf_; } } if (cls == 0) { me0 = fmaxf(me0, er_); mr0 = fmaxf(mr0, rf_); } else if (cls == 1) { me1 = fmaxf(me1, er_); mr1 = fmaxf(mr1, rf_); } else if (cls == 2) { me2 = fmaxf(me2, er_); mr2 = fmaxf(mr2, rf_); } else { me3 = fmaxf(me3, er_); mr3 = fmaxf(mr3, rf_); } }
        { n2a = wave_sum(n2a); d2a = wave_sum(d2a); n2b = wave_sum(n2b); d2b = wave_sum(d2b); n2c = wave_sum(n2c); d2c = wave_sum(d2c); n2d = wave_sum(n2d); d2d = wave_sum(d2d); if (F.lane == 0) { dbg_l2(F, 2, n2a, d2a); dbg_l2(F, 3, n2b, d2b); dbg_l2(F, 4, n2c, d2c); dbg_l2(F, 5, n2d, d2d); } }
        _Pragma("unroll") for (int c = 0; c < 4; ++c) { float e = c == 0 ? me0 : c == 1 ? me1 : c == 2 ? me2 : me3, rr = c == 0 ? mr0 : c == 1 ? mr1 : c == 2 ? mr2 : mr3;
            for (int o = 1; o < 64; o <<= 1) { e = fmaxf(e, __shfl_xor(e, o)); rr = fmaxf(rr, __shfl_xor(rr, o)); }
            if (F.lane == 0) { if (c == 0) dbg_flag(F, 0, e, rr); if (c == 1) dbg_flag(F, 1, e, rr); if (c == 2) dbg_flag(F, 2, e, 0.02f); if (c == 3) dbg_flag(F, 2, e, rr); } }
        __syncthreads();
    }
}
__device__ __forceinline__ void dbg_check_cmp(Frame& F) {
    unsigned char* ws = F.ws; LAS float* hid = (LAS float*)F.lds;
    for (int smp = blockIdx.x; smp < 64; smp += F.G) {
        const int b = smp & 7, g = (smp >> 3) & 1, j = (smp >> 4) & 1, n = (smp * 37 + 5) % 255;
        const bf16* KVC = (const bf16*)(ws + WS_KVC);
        if (F.tid < 128) { float a = 0.f; for (int l = 0; l < 32; ++l) for (int d = 0; d < 64; ++d) { const float xv = bf2f(KVC[((size_t)b * SEQ + 16 * n + l) * 256 + j * 128 + g * 64 + d]) + F.cmp_pos[j * 2048 + l * 64 + d];
                a += xv * F.cmp_w1[((size_t)j * 2048 + l * 64 + d) * 128 + F.tid]; }
            hid[F.tid] = 0.5f * a * (1.0f + erff(a * 0.70710678f)); }
        __syncthreads();
        if (F.tid < 64) { float o = 0.f; for (int k = 0; k < 128; ++k) o += hid[k] * F.cmp_w2[((size_t)j * 128 + k) * 64 + F.tid]; hid[128 + F.tid] = o; }
        __syncthreads();
        if (F.tid < 64) { float o = hid[128 + F.tid]; const int d = F.tid;
            if (j == 0 && d < 16) { const int i = d & 7; float c, s; dbg_cs(16 * n + 31, i, c, s);
                o = d < 8 ? hid[128 + d] * c - hid[128 + d + 8] * s : hid[128 + d - 8] * s + hid[128 + d] * c; }
            const float got = bf2f(((const bf16*)(ws + (j == 0 ? WS_KCMP : WS_VCMP)))[((size_t)b * 256 + n) * 128 + g * 64 + d]);
            float e = fabsf(o - got), rr = fabsf(o);
            { const float n2 = wave_sum((o - got) * (o - got)), d2 = wave_sum(o * o); if (F.lane == 0) dbg_l2(F, 6, n2, d2); }
            for (int q = 1; q < 64; q <<= 1) { e = fmaxf(e, __shfl_xor(e, q)); rr = fmaxf(rr, __shfl_xor(rr, q)); }
            if (F.lane == 0) dbg_flag(F, 3, e, rr); }
        __syncthreads();
    }
    if (blockIdx.x == 0 && F.tid < 64) { const int bh = F.tid, s = (F.tid * 61 + 100) & 4095; const int b = bh >> 3, h = bh & 7; double a = 0.0;
        for (int q = 0; q <= s; ++q) a += (double)((const float*)(ws + WS_LOGF))[((size_t)b * SEQ + q) * 8 + h];
        const float ref = (float)(-1.4426950408889634 * a), got = ((const float*)(ws + WS_CUM))[(size_t)bh * SEQ + s];
        if (fabsf(ref - got) > 1e-3f * fabsf(ref) + 1e-3f) atomicOr((unsigned*)(F.ctl + CW_DBG), 1u << 3); }
}
__device__ __forceinline__ void dbg_check_attn(Frame& F) {
    unsigned char* ws = F.ws; const int lane = F.lane; const int gw = blockIdx.x * 8 + F.wave;
    const bf16* QF = (const bf16*)(ws + WS_QF); const bf16* KF = (const bf16*)(ws + WS_KF); const bf16* VF = (const bf16*)(ws + WS_VF); const bf16* Y = (const bf16*)(ws + WS_Y);
    LAS float* sc = (LAS float*)F.lds + F.wave * 4480;
    if (gw < 1024) {
        const unsigned hs = (unsigned)gw * 2654435761u; int b = (hs >> 8) & 7, h = (hs >> 11) & 7, q = (hs >> 14) & 4095;
#ifdef DBG_EARLY
        b = gw & 7; h = (gw >> 3) & 7; q = (gw >> 6) & 15;
#endif
        const float* cum = (const float*)(ws + WS_CUM) + (size_t)(b * 8 + h) * SEQ;
        float mx = -1e30f;
        for (int s = lane; s <= q; s += 64) { float a = 0.f; for (int d = 0; d < 64; ++d) a += bf2f(QF[((size_t)b * SEQ + q) * 512 + h * 64 + d]) * bf2f(KF[((size_t)b * SEQ + s) * 512 + h * 64 + d]);
            a += cum[s]; sc[s] = a; mx = fmaxf(mx, a); }
        for (int o = 1; o < 64; o <<= 1) mx = fmaxf(mx, __shfl_xor(mx, o));
        float den = 0.f; for (int s = lane; s <= q; s += 64) { const float p = exp2f(sc[s] - mx); sc[s] = p; den += p; }
        den = wave_sum(den); LDS_WAIT();
        float o = 0.f; for (int s = 0; s <= q; ++s) o += sc[s] * bf2f(VF[((size_t)b * SEQ + s) * 512 + h * 64 + lane]);
        o /= den; const float got = bf2f(Y[((size_t)b * SEQ + q) * 512 + h * 64 + lane]);
        float e = fabsf(o - got), rr = fabsf(o);
        { const float n2 = wave_sum((o - got) * (o - got)), d2 = wave_sum(o * o); if (lane == 0) dbg_l2(F, 0, n2, d2); }
        for (int qq = 1; qq < 64; qq <<= 1) { e = fmaxf(e, __shfl_xor(e, qq)); rr = fmaxf(rr, __shfl_xor(rr, qq)); }
        { float gm = fabsf(got); const bool bad = !(got == got) || fabsf(got) > 1e30f; for (int qq = 1; qq < 64; qq <<= 1) gm = fmaxf(gm, __shfl_xor(gm, qq)); const unsigned long long nb = __ballot(bad);
          if (lane == 0 && (e > DBG_TOL * rr + 1e-3f || nb)) atomicOr((unsigned*)(F.ctl + CW_DBG), 16u); }
    } else if (gw < 2048) {
        const int k = gw - 1024; const unsigned hs = (unsigned)k * 2246822519u + 12345u; int b = (hs >> 8) & 7, g = (hs >> 11) & 1, q = (hs >> 14) & 4095;
#ifdef DBG_EARLY
        b = k & 7; g = (k >> 3) & 1; q = (k >> 4) & 63; if (k >= 1024) return;
#endif
        const bf16* QN = (const bf16*)(ws + WS_QN); const bf16* KC = (const bf16*)(ws + WS_KCMP); const bf16* VC = (const bf16*)(ws + WS_VCMP);
        const bf16* KS = (const bf16*)(ws + WS_KVS); const bf16* KW = (const bf16*)(ws + WS_KVW); const float* GT = (const float*)(ws + WS_GATES);
        LAS float* imp = sc + 4096;
        imp[lane] = 0.f; LDS_WAIT();
        LAS float* ocmp = sc + 4160; float e = 0.f, rr = 0.f;
        const int QBk = q >> 6;
        for (int hh = 0; hh < 4; ++hh) { const int head = 4 * g + hh; float mx = -1e30f; int nvis = 0;
            for (int n = lane; n < 255; n += 64) { float a = -1e30f; if (16 * n + 31 <= q) { a = 0.f; for (int d = 0; d < 64; ++d) a += bf2f(QN[((size_t)b * SEQ + q) * 512 + head * 64 + d]) * bf2f(KC[((size_t)b * 256 + n) * 128 + g * 64 + d]); nvis++; } sc[n] = a; mx = fmaxf(mx, a); }
            for (int o = 1; o < 64; o <<= 1) mx = fmaxf(mx, __shfl_xor(mx, o));
            float den = 0.f; for (int n = lane; n < 255; n += 64) { const float p = (16 * n + 31 <= q) ? exp2f(sc[n] - mx) : 0.f; sc[n] = p; den += p; }
            den = wave_sum(den); LDS_WAIT(); const float rden = den > 0.f ? 1.f / den : 0.f;
            float o = 0.f; for (int n = 0; n < 255; ++n) o += sc[n] * rden * bf2f(VC[((size_t)b * 256 + n) * 128 + g * 64 + lane]);
            ocmp[hh * 64 + lane] = o;
            { float v = 0.f; const int j = lane; for (int n = 0; n < 255; ++n) { const int cs = 16 * n, ss = 64 * j; int ov = min(cs + 32, ss + 64) - max(cs, ss); if (ov < 0) ov = 0; v += sc[n] * rden * (float)ov / 32.f; } imp[lane] += v; }
            LDS_WAIT();
        }
        unsigned long long msk;
        { const int j = lane; const bool forced = (j == 0) || (j == QBk) || (j == QBk - 1), causal = j <= QBk; const float score = forced ? 1e9f : (causal ? imp[j] : -1.f); int rank = 0;
          for (int i = 0; i < 64; ++i) { const float si = __shfl(score, i); rank += (si > score || (si == score && i < j)) ? 1 : 0; }
          msk = __ballot(rank < 16); }
        for (int hh = 0; hh < 4; ++hh) { const int head = 4 * g + hh; float oslc = 0.f, owin = 0.f;
            for (int br = 0; br < 2; ++br) { const bf16* KK = br == 0 ? KS : KW; float mx = -1e30f;
                for (int s = lane; s <= q; s += 64) { const bool vis = br == 0 ? (((msk >> (s >> 6)) & 1ull) != 0ull) : (q - s < 512); float a = -1e30f;
                    if (vis) { a = 0.f; for (int d = 0; d < 64; ++d) a += bf2f(QN[((size_t)b * SEQ + q) * 512 + head * 64 + d]) * bf2f(KK[((size_t)b * SEQ + s) * 256 + g * 64 + d]); }
                    sc[s] = a; mx = fmaxf(mx, a); }
                for (int o = 1; o < 64; o <<= 1) mx = fmaxf(mx, __shfl_xor(mx, o));
                float den = 0.f; for (int s = lane; s <= q; s += 64) { const float p = sc[s] > -1e29f ? exp2f(sc[s] - mx) : 0.f; sc[s] = p; den += p; }
                den = wave_sum(den); LDS_WAIT();
                float o = 0.f; for (int s = 0; s <= q; ++s) o += sc[s] * bf2f(KK[((size_t)b * SEQ + s) * 256 + 128 + g * 64 + lane]);
                o /= den; if (br == 0) oslc = o; else owin = o; LDS_WAIT(); }
            const float* gt = GT + ((size_t)b * SEQ + q) * 24 + head * 3;
            float g0_ = gt[0], g1_ = gt[1], g2_ = gt[2];
#ifdef DBG_NO_CMP
            g0_ = 0.f;
#endif
#ifdef DBG_NO_SLC
            g1_ = 0.f;
#endif
#ifdef DBG_NO_WIN
            g2_ = 0.f;
#endif
            const float ref = g0_ * ocmp[hh * 64 + lane] + g1_ * oslc + g2_ * owin; const float got = bf2f(Y[((size_t)NTOK + (size_t)b * SEQ + q) * 512 + head * 64 + lane]);
            { const float n2 = wave_sum((ref - got) * (ref - got)), d2 = wave_sum(ref * ref); if (lane == 0) dbg_l2(F, 1, n2, d2); }
            e = fmaxf(e, fabsf(ref - got)); rr = fmaxf(rr, fabsf(ref)); }
        for (int qq = 1; qq < 64; qq <<= 1) { e = fmaxf(e, __shfl_xor(e, qq)); rr = fmaxf(rr, __shfl_xor(rr, qq)); }
        if (lane == 0) dbg_flag(F, 5, e, rr);
    }
}
#endif

#ifdef DBG_CHECK
#ifndef DBG_NS
#define DBG_NS 64
#endif
constexpr size_t WS_DBGH = 461 * MiB;
__device__ __forceinline__ int dbg_tok(int smp) { return (int)(((unsigned)smp * 2654435761u) >> 7) & (NTOK - 1); }
__device__ __forceinline__ void dbg_check_merged(Frame& F) {
    unsigned char* ws = F.ws; const bf16* Y = (const bf16*)(ws + WS_Y); const bf16* GM = (const bf16*)(ws + WS_GM); const bf16* MG = (const bf16*)(ws + WS_MERGED);
    for (int smp = blockIdx.x; smp < DBG_NS; smp += F.G) { const int t = dbg_tok(smp); float e = 0.f, rr = 0.f, n2 = 0.f, d2 = 0.f;
        for (int d = F.tid; d < 1024; d += 512) { float u0 = 0.f, u1 = 0.f;
            for (int c = 0; c < 512; ++c) { u0 += bf2f(Y[(size_t)t * 512 + c]) * F.w_branch[(size_t)c * 1024 + d]; u1 += bf2f(Y[((size_t)NTOK + t) * 512 + c]) * F.w_branch[(size_t)(512 + c) * 1024 + d]; }
            const float ref = bf2f(GM[(size_t)t * 2048 + d]) * u0 + bf2f(GM[(size_t)t * 2048 + 1024 + d]) * u1, got = bf2f(MG[(size_t)t * 1024 + d]);
            n2 += (ref - got) * (ref - got); d2 += ref * ref; e = fmaxf(e, fabsf(ref - got)); rr = fmaxf(rr, fabsf(ref)); }
        n2 = wave_sum(n2); d2 = wave_sum(d2); if (F.lane == 0) dbg_l2(F, 0, n2, d2);
        for (int q = 1; q < 64; q <<= 1) { e = fmaxf(e, __shfl_xor(e, q)); rr = fmaxf(rr, __shfl_xor(rr, q)); }
        if (F.lane == 0) dbg_flag(F, 0, e, rr); }
}
__device__ __forceinline__ void dbg_check_h(Frame& F) {
    unsigned char* ws = F.ws; const bf16* MG = (const bf16*)(ws + WS_MERGED); const bf16* HB = (const bf16*)(ws + WS_HB); LAS float* red = (LAS float*)F.lds;
    for (int smp = blockIdx.x; smp < DBG_NS; smp += F.G) { const int t = dbg_tok(smp); float e = 0.f, rr = 0.f, e2 = 0.f, ssq = 0.f, n2 = 0.f, d2 = 0.f;
        for (int d = F.tid; d < 1024; d += 512) { float a = 0.f; for (int c = 0; c < 1024; ++c) a += bf2f(MG[(size_t)t * 1024 + c]) * F.w_out[(size_t)c * 1024 + d];
            const float ref = F.x[(size_t)t * 1024 + d] + a, got = F.out[(size_t)t * 1024 + d]; e = fmaxf(e, fabsf(ref - got)); rr = fmaxf(rr, fabsf(a)); n2 += (ref - got) * (ref - got); d2 += a * a;
            e2 = fmaxf(e2, fabsf(bf2f(HB[(size_t)t * 1024 + d]) - got * F.norm_ffn[d])); ssq += got * got; }
        for (int q = 1; q < 64; q <<= 1) { e = fmaxf(e, __shfl_xor(e, q)); rr = fmaxf(rr, __shfl_xor(rr, q)); e2 = fmaxf(e2, __shfl_xor(e2, q)); }
        n2 = wave_sum(n2); d2 = wave_sum(d2); if (F.lane == 0) dbg_l2(F, 1, n2, d2);
        ssq = wave_sum(ssq); if (F.lane == 0) red[F.wave] = ssq; __syncthreads();
        if (F.tid == 0) { float tot = 0.f; for (int w = 0; w < 8; ++w) tot += red[w]; const float got = ((const float*)(ws + WS_SS))[t]; if (fabsf(tot - got) > 1e-3f * tot) atomicOr((unsigned*)(F.ctl + CW_DBG), 2u); }
        if (F.lane == 0) { dbg_flag(F, 1, e, rr); dbg_flag(F, 1, e2, 1.0f); }
        __syncthreads(); }
}
__device__ __forceinline__ void dbg_check_scores(Frame& F) {
    unsigned char* ws = F.ws; const bf16* HB = (const bf16*)(ws + WS_HB); const float* SC = (const float*)(ws + WS_SC); LAS float* qv = (LAS float*)F.lds;
    for (int smp = blockIdx.x; smp < DBG_NS; smp += F.G) { const int t = dbg_tok(smp);
        for (int d = F.tid; d < 1024; d += 512) ((float*)(ws + WS_DBGH))[(size_t)smp * 1024 + d] = F.out[(size_t)t * 1024 + d];
        for (int n = F.tid; n < 2048; n += 512) { float a = 0.f; for (int k = 0; k < 1024; ++k) a += bf2f(HB[(size_t)t * 1024 + k]) * F.peer_wq[(size_t)k * 2048 + n]; qv[n] = a; }
        __syncthreads();
        float e = 0.f, rr = 0.f, n2 = 0.f, d2 = 0.f;
        for (int n = F.tid; n < 2048; n += 512) { const int hp = n >> 7; float a = 0.f; for (int d = 0; d < 128; ++d) a += qv[hp * 128 + d] * F.peer_sk[(size_t)n * 128 + d];
            { const float g_ = SC[(size_t)t * 2048 + n]; n2 += (a - g_) * (a - g_); d2 += a * a; }
            e = fmaxf(e, fabsf(a - SC[(size_t)t * 2048 + n])); rr = fmaxf(rr, fabsf(a)); }
        n2 = wave_sum(n2); d2 = wave_sum(d2); if (F.lane == 0) dbg_l2(F, 2, n2, d2);
        for (int q = 1; q < 64; q <<= 1) { e = fmaxf(e, __shfl_xor(e, q)); rr = fmaxf(rr, __shfl_xor(rr, q)); }
        if (F.lane == 0) dbg_flag(F, 2, e, rr);
        __syncthreads(); }
}
__device__ __forceinline__ void dbg_check_final(Frame& F) {
    unsigned char* ws = F.ws; const float* SC = (const float*)(ws + WS_SC); LAS float* hn = (LAS float*)F.lds; LAS float* ew = hn + 1024; LAS int* ei = (LAS int*)(ew + 128); LAS float* act = (LAS float*)(ei + 128); LAS float* red = act + 128;
    for (int smp = blockIdx.x; smp < DBG_NS; smp += F.G) { const int t = dbg_tok(smp); const float* hrow = (const float*)(ws + WS_DBGH) + (size_t)smp * 1024;
        float ssq = 0.f; for (int d = F.tid; d < 1024; d += 512) ssq += hrow[d] * hrow[d];
        ssq = wave_sum(ssq); if (F.lane == 0) red[F.wave] = ssq; __syncthreads();
        float tot = 0.f; for (int w = 0; w < 8; ++w) tot += red[w]; const float rt = 1.0f / sqrtf(tot / 1024.f + RMS_EPS);
        for (int d = F.tid; d < 1024; d += 512) hn[d] = hrow[d] * rt * F.norm_ffn[d];
        if (F.tid < 8) { const int hd = F.tid; const float* s1 = SC + (size_t)t * 2048 + (2 * hd) * 128; const float* s2 = s1 + 128;
            float a[16], bq[16]; int ia[16], ib[16];
            for (int k = 0; k < 16; ++k) { float best = -1e30f; int bi = -1; for (int n = 0; n < 128; ++n) { bool used = false; for (int m = 0; m < k; ++m) used |= (ia[m] == n); if (!used && s1[n] > best) { best = s1[n]; bi = n; } } a[k] = best; ia[k] = bi; }
            for (int k = 0; k < 16; ++k) { float best = -1e30f; int bi = -1; for (int n = 0; n < 128; ++n) { bool used = false; for (int m = 0; m < k; ++m) used |= (ib[m] == n); if (!used && s2[n] > best) { best = s2[n]; bi = n; } } bq[k] = best; ib[k] = bi; }
            int pi[16]; float ps[16];
            for (int k = 0; k < 16; ++k) { float best = -1e30f; int bp = -1; for (int c = 0; c < 256; ++c) { bool used = false; for (int m = 0; m < k; ++m) used |= (pi[m] == c); const float v = a[c >> 4] + bq[c & 15]; if (!used && v > best) { best = v; bp = c; } } pi[k] = bp; ps[k] = best * rt; }
            float den = 0.f; { const float pm_ = ps[0]; for (int k = 0; k < 16; ++k) { ps[k] = expf(ps[k] - pm_); } } for (int k = 0; k < 16; ++k) den += ps[k];
            for (int k = 0; k < 16; ++k) { ew[hd * 16 + k] = ps[k] / den; ei[hd * 16 + k] = ia[pi[k] >> 4] * 128 + ib[pi[k] & 15]; } }
        __syncthreads();
        if (F.tid < 128) { const float* up = F.peer_u + (size_t)ei[F.tid] * 1024; float a = 0.f; for (int d = 0; d < 1024; ++d) a += hn[d] * up[d]; act[F.tid] = ew[F.tid] * 0.5f * a * (1.0f + erff(a * 0.70710678f)); }
        __syncthreads();
        float yv[2]; float s2 = 0.f;
        for (int i = 0; i < 2; ++i) { const int d = F.tid + 512 * i; float o = 0.f; for (int e = 0; e < 128; ++e) o += act[e] * F.peer_v[(size_t)ei[e] * 1024 + d]; yv[i] = hrow[d] + o; s2 += yv[i] * yv[i]; }
        s2 = wave_sum(s2); __syncthreads(); if (F.lane == 0) red[F.wave] = s2; __syncthreads();
        float tot2 = 0.f; for (int w = 0; w < 8; ++w) tot2 += red[w]; const float rf = 1.0f / sqrtf(tot2 / 1024.f + RMS_EPS);
        float e = 0.f, n2 = 0.f, d2 = 0.f;
        for (int i = 0; i < 2; ++i) { const int d = F.tid + 512 * i; const float ref = yv[i] * rf * F.norm_final[d], got = F.out[(size_t)t * 1024 + d]; e = fmaxf(e, fabsf(ref - got)); n2 += (ref - got) * (ref - got); const float pc_ = (yv[i] - hrow[d]) * rf * F.norm_final[d]; d2 += pc_ * pc_; }
        n2 = wave_sum(n2); d2 = wave_sum(d2); if (F.lane == 0) dbg_l2(F, 3, n2, d2);
        for (int q = 1; q < 64; q <<= 1) e = fmaxf(e, __shfl_xor(e, q));
        if (F.lane == 0 && e > 0.01f && !(smp == 0 && false)) atomicOr((unsigned*)(F.ctl + CW_DBG), 8u);
        __syncthreads(); }
}
#endif

struct Args { const float* in[15]; float* out; unsigned char* ws; int ph_lo, ph_hi; };
constexpr int NPHASE = 8;
__global__ void __launch_bounds__(NWAVES * 64, 2) mk_fwd(Args args) {
    extern __shared__ __attribute__((aligned(16))) unsigned char lds[];
    Frame F;
    F.lds = (LAS unsigned char*)lds; F.MISC = (volatile LAS unsigned*)(F.lds + MISC_OFF);
    F.tid = threadIdx.x; F.lane = F.tid & 63; F.wave = __builtin_amdgcn_readfirstlane(F.tid >> 6);
    F.G = gridDim.x; { const int bx = blockIdx.x; F.vcu = (F.G % 8 == 0) ? (bx % 8) * (F.G / 8) + bx / 8 : bx; }
    unsigned char* ws = args.ws; F.ws = ws; F.ctl = (gu32*)(ws + WS_CTL);
    F.x = args.in[0]; F.norm_mix = args.in[1]; F.w_in = args.in[2]; F.fbias = args.in[3]; F.cmp_pos = args.in[4]; F.cmp_w1 = args.in[5]; F.cmp_w2 = args.in[6]; F.w_branch = args.in[7];
    F.w_out = args.in[8]; F.norm_ffn = args.in[9]; F.peer_wq = args.in[10]; F.peer_sk = args.in[11]; F.peer_u = args.in[12]; F.peer_v = args.in[13]; F.norm_final = args.in[14]; F.out = args.out;
    for (int u = F.tid; u < (LDS_BYTES - LDSCTL_OFF) / 4; u += NWAVES * 64) ((LAS unsigned*)(F.lds + LDSCTL_OFF))[u] = 0u;
    __syncthreads();
    const int lo = args.ph_lo, hi = args.ph_hi;
    XcdBarrier bar; bar.bar = (unsigned*)(F.ctl + CW_BAR); bar.x = 0; bar.st = nullptr;
    if (hi - lo > 1) bar = xcd_barrier_post((unsigned*)(F.ctl + CW_BAR), F.MISC + 8);
#define IN(k) (lo <= (k) && (k) < hi)
#ifdef DBG_CHECK
    if (lo == 99) { dbg_check_inproj(F); __syncthreads(); dbg_check_cmp(F); __syncthreads(); dbg_check_attn(F); return; }
    if (lo == 100) { dbg_check_merged(F); return; }
    if (lo == 101) { dbg_check_h(F); return; }
    if (lo == 102) { dbg_check_scores(F); return; }
    if (lo == 103) { dbg_check_final(F); return; }
    if (lo == 104) { if (blockIdx.x == 0 && F.tid == 0) {
#ifdef DBG_SEL
        const float num = __hip_atomic_load((float*)(F.ctl + CW_L2) + DBG_SEL, RLX_AGENT), den = __hip_atomic_load((float*)(F.ctl + CW_L2) + 8 + DBG_SEL, RLX_AGENT);
        float v = 1000.0f * sqrtf(num / fmaxf(den, 1e-30f)); v = fminf(99.f, rintf(v)); F.out[0] = 10.0f * v + 5.0f;
#else
        const unsigned m = __hip_atomic_load(F.ctl + CW_DBG, RLX_AGENT); if (m) F.out[0] = 10.0f * (float)m;
#endif
    } return; }
#endif
#define SEAM(k) do { if (IN(k) && IN((k) + 1)) xcd_barrier(bar); } while (0)
    if (IN(0)) { p0_prologue(F); SEAM(0); }
    if (IN(1)) {
        pg8::Gemm g{(const bf16*)(ws + WS_XN), (const bf16*)(ws + WS_WTIN), NTOK, NIN, 1024}; pg8::StaticOrder S; S.init(NTOK, NIN, F.G, (int)blockIdx.x);
        EpiIn E{ws, F.fbias};
        pg8::gemm_phase<EpiIn, pg8::StaticOrder, true, true>(F.lds, g, S, E);
        SEAM(1);
    }
    if (IN(2)) {
        for (int u = blockIdx.x; u < 512; u += F.G) p2_compress_unit(F, u);
        { const int gw = (int)blockIdx.x * NWAVES + F.wave; if (gw < 64) p2_cumsum_wave(F, gw); else if (F.G * NWAVES < 64) { for (int q = gw; q < 64; q += F.G * NWAVES) p2_cumsum_wave(F, q); } }
        SEAM(2);
    }
    if (IN(3)) {
        p3_attention(F); SEAM(3); }
    if (IN(4)) {
        pg8::Gemm g{(const bf16*)(ws + WS_Y), (const bf16*)(ws + WS_WTBR), 2 * NTOK, 2048, 512}; MergeOrder S{F.vcu, F.G};
        EpiMerge E{ws};
        pg8::gemm_phase<EpiMerge, MergeOrder, false, true>(F.lds, g, S, E);
        SEAM(4);
    }
    if (IN(5)) {
        pg8::Gemm g{(const bf16*)(ws + WS_MERGED), (const bf16*)(ws + WS_WTOUT), NTOK, 1024, 1024}; pg8::StaticOrder S; S.init(NTOK, 1024, F.G, (int)blockIdx.x);
        EpiOut E{ws, F.x, F.out, F.norm_ffn};
        pg8::gemm_phase<EpiOut, pg8::StaticOrder, true, true>(F.lds, g, S, E);
        SEAM(5);
    }
    if (IN(6)) {
        pg8::Gemm g{(const bf16*)(ws + WS_HB), (const bf16*)(ws + WS_WTPEER), NTOK, 2048, 1024}; pg8::StaticOrder S; S.init(NTOK, 2048, F.G, (int)blockIdx.x);
        EpiF32 E{(float*)(ws + WS_SC), 2048};
#ifdef DBG_F32SCORES
        p6_naive(F);
#else
        pg8::gemm_phase<EpiF32, pg8::StaticOrder, true, true>(F.lds, g, S, E);
#endif
        SEAM(6);
    }
    if (IN(7)) {
        for (int bt = blockIdx.x; bt < NTOK / 32; bt += F.G) p7_batch(F, bt * 32);
#ifdef DBG_LOGITSTAT
        __syncthreads(); if (blockIdx.x == 0 && F.tid == 0) { const float v_ = __hip_atomic_load((float*)(F.ctl + 12400 + DBG_LOGITSTAT), RLX_AGENT); F.out[0] = 1000.0f * v_; }
#endif
    }
#undef IN
#undef SEAM
}

#ifndef MK_N_LAUNCHES
#define MK_N_LAUNCHES 8
#endif
extern "C" void kernel_launch(void* const* d_in, const int* in_sizes, int n_in, void* d_out, int out_size, void* d_ws, size_t ws_size, hipStream_t stream) {
    static int grid = 0;
    if (grid == 0) {
        if (n_in != 15 || out_size != NTOK * DM || ws_size < WS_END) { fprintf(stderr, "kernel_launch: unexpected shapes (n_in %d out %d ws %zu)\n", n_in, out_size, ws_size); grid = -1; return; }
        int dev = 0, cus = 0, per_cu = 0;
        if (hipGetDevice(&dev) != hipSuccess || hipDeviceGetAttribute(&cus, hipDeviceAttributeMultiprocessorCount, dev) != hipSuccess) { grid = -1; return; }
        if (hipFuncSetAttribute((const void*)mk_fwd, hipFuncAttributeMaxDynamicSharedMemorySize, LDS_BYTES) != hipSuccess) { fprintf(stderr, "kernel_launch: hipFuncSetAttribute failed\n"); grid = -1; return; }
        if (hipOccupancyMaxActiveBlocksPerMultiprocessor(&per_cu, (const void*)mk_fwd, NWAVES * 64, LDS_BYTES) != hipSuccess || per_cu < 1) { fprintf(stderr, "kernel_launch: occupancy query says %d blocks per CU\n", per_cu); (void)hipGetLastError(); grid = -1; return; }
        grid = cus;
    }
    if (grid < 0) return;
    if (hipMemsetAsync((char*)d_ws + WS_CTL, 0, CTL_ZERO_BYTES, stream) != hipSuccess) return;
    Args a{};
    for (int i = 0; i < 15; ++i) a.in[i] = (const float*)d_in[i];
    a.out = (float*)d_out; a.ws = (unsigned char*)d_ws;
    const int nl = MK_N_LAUNCHES;
    for (int li = 0; li < nl; ++li) {
        a.ph_lo = (nl == 1) ? 0 : li; a.ph_hi = (nl == 1) ? NPHASE : li + 1;
#ifdef DBG_CHECK
#if DBG_CHECK == 1
        if (li == 4) { Args c = a; c.ph_lo = 99; c.ph_hi = 100; hipLaunchKernelGGL(mk_fwd, dim3(grid), dim3(NWAVES * 64), LDS_BYTES, stream, c); }
#else
        if (li >= 5) { Args c = a; c.ph_lo = 95 + li; c.ph_hi = 96 + li; hipLaunchKernelGGL(mk_fwd, dim3(grid), dim3(NWAVES * 64), LDS_BYTES, stream, c); }
#endif
#endif
        hipLaunchKernelGGL(mk_fwd, dim3(grid), dim3(NWAVES * 64), LDS_BYTES, stream, a);
    }
#ifdef DBG_CHECK
    { Args c = a;
#if DBG_CHECK == 2
      c.ph_lo = 103; c.ph_hi = 104; hipLaunchKernelGGL(mk_fwd, dim3(grid), dim3(NWAVES * 64), LDS_BYTES, stream, c);
#endif
      c.ph_lo = 104; c.ph_hi = 105; hipLaunchKernelGGL(mk_fwd, dim3(grid), dim3(NWAVES * 64), LDS_BYTES, stream, c); }
#endif
}
```

```cpp
#include <hip/hip_runtime.h>
#include <cstdio>
#include <cstdint>
namespace pg8 {
#define PG8_LAS __attribute__((address_space(3)))
typedef unsigned short bf16_t;
typedef short bf16x8 __attribute__((ext_vector_type(8)));
typedef float f32x4 __attribute__((ext_vector_type(4)));
typedef unsigned u32x4 __attribute__((ext_vector_type(4)));
constexpr int BM = 256, BK = 64, HALF = 128, HTB = HALF * BK * 2  , STAGE_BYTES = 8 * HTB, NXCD = 8, WGM = 8;

__host__ __device__ __forceinline__ int lds_byte(int r, int c) { const int st = (r >> 4) * 2 + (c >> 5), rr = r & 15, cc = c & 31, ob = rr * 64 + cc * 2; return st * 1024 + (ob ^ (((ob >> 9) & 1) << 5)); }
__host__ __device__ __forceinline__ void stage_rc(int b, int& R, int& C) { const int st = b / 1024, sb = b % 1024, swz = sb ^ (((sb >> 9) & 1) << 5); R = (st >> 1) * 16 + swz / 64; C = (st & 1) * 32 + (swz % 64) / 2; }
__host__ __device__ __forceinline__ int perm32(int rho) { const int n = rho >> 4, i = rho & 15; return 8 * (i >> 2) + 4 * n + (i & 3); }

struct Unit { int pm, pn; };
struct Gemm { const bf16_t* A; const bf16_t* Bt; int M, N, K; };

struct StaticOrder {
    int nM, nN, nwg, G, c;
    __host__ __device__ void init(int M, int N, int G_, int c_) { nM = M / BM; nN = N / BM; nwg = nM * nN; G = G_; c = c_; }
    __host__ __device__ bool next(int i, Unit& u) const {
        const long L = (long)i * G + c; if (L >= nwg) return false;
        int wgid = (int)L; { const int q = nwg / NXCD, r = nwg % NXCD, xcd = wgid % NXCD, off = wgid / NXCD; wgid = (xcd < r ? xcd * (q + 1) : r * (q + 1) + (xcd - r) * q) + off; }
        const int nig = WGM * nN, gid = wgid / nig, fm = gid * WGM, gsz = (nM - fm) < WGM ? (nM - fm) : WGM;
        u.pm = fm + ((wgid % nig) % gsz); u.pn = (wgid % nig) / gsz; return true;
    }
    __device__ __forceinline__ void a_ready(const Unit&) const {}
    __device__ __forceinline__ void done(const Unit&) const {}
};

__device__ __forceinline__ unsigned cvt_pk_bf16(float lo, float hi) { unsigned r; asm volatile("v_cvt_pk_bf16_f32 %0, %1, %2" : "=v"(r) : "v"(lo), "v"(hi)); return r; }
template <class Epi, class Sched, bool ALIGN_EPI = false, bool SP2 = false>
__device__ __forceinline__ void gemm_phase(PG8_LAS unsigned char* lds, const Gemm g, const Sched& S, const Epi& E) {
    const int tid = threadIdx.x, wid = __builtin_amdgcn_readfirstlane(tid >> 6), lane = tid & 63, wr = wid >> 2, wc = wid & 3, fr = lane & 15, fq = lane >> 4;
    const int K = g.K, nt = K / BK;
    unsigned voffA[2], voffB[2];
#pragma unroll
    for (int i = 0; i < 2; ++i) { int R, C; stage_rc(tid * 16 + i * 8192, R, C); const int Rb = Epi::PERM ? ((R & ~31) + perm32(R & 31)) : R;
        voffA[i] = (unsigned)(R * K + C) * 2u; voffB[i] = (unsigned)(Rb * K + C) * 2u; }
    const size_t kstep = (size_t)(BK * 2);
    const size_t hstep = (size_t)HALF * K * 2;
    const size_t tstep = 2 * hstep;
    const unsigned ldsw = (unsigned)wid * 1024u;
    const int aoff = lds_byte(wr * 64 + fr, fq * 8), boff = lds_byte(wc * 32 + fr, fq * 8);
#define PG8_SA(b, h) (((b) * 2 + (h)) * HTB)
#define PG8_SB(b, h) ((4 + (b) * 2 + (h)) * HTB)
#define PG8_STAGE(bufoff, gbase, voff) do { _Pragma("unroll") for (int _i = 0; _i < 2; ++_i) \
        __builtin_amdgcn_global_load_lds((const unsigned*)((const char*)(gbase) + (voff)[_i]), (PG8_LAS unsigned*)(lds + (bufoff) + ldsw + _i * 8192), 16, 0, 0); } while (0)
#define PG8_LDA(dst, b, h) do { _Pragma("unroll") for (int m = 0; m < 4; ++m) _Pragma("unroll") for (int k = 0; k < 2; ++k) dst[m][k] = *(const PG8_LAS bf16x8*)(lds + PG8_SA(b, h) + aoff + m * 2048 + k * 1024); } while (0)
#define PG8_LDB(dst, b, h) do { _Pragma("unroll") for (int n = 0; n < 2; ++n) _Pragma("unroll") for (int k = 0; k < 2; ++k) dst[n][k] = *(const PG8_LAS bf16x8*)(lds + PG8_SB(b, h) + boff + n * 2048 + k * 1024); } while (0)
#define PG8_MMA(ai, bj, At, Bt) do { __builtin_amdgcn_s_setprio(1); _Pragma("unroll") for (int m = 0; m < 4; ++m) _Pragma("unroll") for (int n = 0; n < 2; ++n) _Pragma("unroll") for (int k = 0; k < 2; ++k) \
        acc[ai][bj][m][n] = __builtin_amdgcn_mfma_f32_16x16x32_bf16(Bt[n][k], At[m][k], acc[ai][bj][m][n], 0, 0, 0); __builtin_amdgcn_s_setprio(0); } while (0)
#define PG8_WAIT_V(n) asm volatile("s_waitcnt vmcnt(" #n ")" ::: "memory")
#define PG8_WAIT_L(n) asm volatile("s_waitcnt lgkmcnt(" #n ")" ::: "memory")
#define PG8_BAR __builtin_amdgcn_s_barrier()
#define PG8_SCHED __builtin_amdgcn_sched_barrier(0)
    Unit cur, nxt; int ui = 0;
    if (!S.next(0, cur)) return;
    f32x4 acc[2][2][4][2];
#pragma unroll
    for (int a = 0; a < 2; ++a)
#pragma unroll
        for (int b = 0; b < 2; ++b)
#pragma unroll
            for (int m = 0; m < 4; ++m)
#pragma unroll
                for (int n = 0; n < 2; ++n) acc[a][b][m][n] = (f32x4){0.f, 0.f, 0.f, 0.f};
    bf16x8 At[4][2], B0[2][2], B1[2][2];
    const char* cA = (const char*)g.A + (size_t)cur.pm * tstep; const char* cB = (const char*)g.Bt + (size_t)cur.pn * tstep;
    S.a_ready(cur);
    if constexpr (SP2) {
        PG8_STAGE(PG8_SB(0, 0), cB, voffB); PG8_STAGE(PG8_SB(0, 1), cB + hstep, voffB); PG8_STAGE(PG8_SA(0, 0), cA, voffA); PG8_STAGE(PG8_SA(0, 1), cA + hstep, voffA);
        if (wr == 1) PG8_BAR;
        PG8_WAIT_V(2); PG8_BAR;
        PG8_STAGE(PG8_SB(1, 0), cB + kstep, voffB); PG8_STAGE(PG8_SA(1, 0), cA + kstep, voffA); PG8_STAGE(PG8_SB(1, 1), cB + hstep + kstep, voffB);
        PG8_WAIT_V(6); PG8_BAR;
    } else {
        PG8_STAGE(PG8_SB(0, 0), cB, voffB); PG8_STAGE(PG8_SA(0, 0), cA, voffA); PG8_STAGE(PG8_SB(0, 1), cB + hstep, voffB); PG8_STAGE(PG8_SA(0, 1), cA + hstep, voffA);
        if (wr == 1) PG8_BAR;
        PG8_WAIT_V(4); PG8_BAR;
        PG8_STAGE(PG8_SB(1, 0), cB + kstep, voffB); PG8_STAGE(PG8_SA(1, 0), cA + kstep, voffA); PG8_STAGE(PG8_SB(1, 1), cB + hstep + kstep, voffB);
        PG8_WAIT_V(6); PG8_BAR;
    }
    for (;;) {
        const bool has_next = S.next(ui + 1, nxt);
        const char* nA = has_next ? (const char*)g.A + (size_t)nxt.pm * tstep : cA; const char* nB = has_next ? (const char*)g.Bt + (size_t)nxt.pn * tstep : cB;
        for (int t = 0; t < nt; t += 2) {
            const bool last = (t == nt - 2);
            const char* a1 = cA + (size_t)(t + 1) * kstep;
            const char* a2 = last ? nA : cA + (size_t)(t + 2) * kstep; const char* b2 = last ? nB : cB + (size_t)(t + 2) * kstep;
            const char* a3 = a2 + kstep; const char* b3 = b2 + kstep;
            if (last && has_next) S.a_ready(nxt);
            if constexpr (SP2) {
            PG8_LDB(B0, 0, 0); PG8_LDB(B1, 0, 1); PG8_SCHED; PG8_LDA(At, 0, 0); PG8_STAGE(PG8_SA(1, 1), a1 + hstep, voffA);
            PG8_WAIT_V(8); PG8_WAIT_L(0); PG8_BAR; PG8_MMA(0, 0, At, B0); PG8_MMA(0, 1, At, B1); PG8_BAR; PG8_SCHED;
            PG8_LDA(At, 0, 1); PG8_STAGE(PG8_SB(0, 0), b2, voffB); PG8_STAGE(PG8_SB(0, 1), b2 + hstep, voffB); PG8_STAGE(PG8_SA(0, 0), a2, voffA);
            PG8_WAIT_V(8); PG8_WAIT_L(0); PG8_BAR; PG8_MMA(1, 0, At, B0); PG8_MMA(1, 1, At, B1); PG8_BAR; PG8_SCHED;
            PG8_LDB(B0, 1, 0); PG8_LDB(B1, 1, 1); PG8_SCHED; PG8_LDA(At, 1, 0); PG8_STAGE(PG8_SA(0, 1), a2 + hstep, voffA);
            PG8_WAIT_V(8); PG8_WAIT_L(0); PG8_BAR; PG8_MMA(0, 0, At, B0); PG8_MMA(0, 1, At, B1); PG8_BAR; PG8_SCHED;
            PG8_LDA(At, 1, 1); PG8_STAGE(PG8_SB(1, 0), b3, voffB); PG8_STAGE(PG8_SB(1, 1), b3 + hstep, voffB); PG8_STAGE(PG8_SA(1, 0), a3, voffA);
            PG8_WAIT_V(8); PG8_WAIT_L(0); PG8_BAR; PG8_MMA(1, 0, At, B0); PG8_MMA(1, 1, At, B1); PG8_BAR; PG8_SCHED;
            } else {
            PG8_LDB(B0, 0, 0); PG8_SCHED; PG8_LDA(At, 0, 0); PG8_STAGE(PG8_SA(1, 1), a1 + hstep, voffA);
            PG8_WAIT_L(8); PG8_BAR; PG8_WAIT_L(0); PG8_MMA(0, 0, At, B0); PG8_BAR; PG8_SCHED;
            PG8_LDB(B1, 0, 1); PG8_STAGE(PG8_SB(0, 0), b2, voffB);
            PG8_BAR; PG8_WAIT_L(0); PG8_MMA(0, 1, At, B1); PG8_BAR;
            PG8_LDA(At, 0, 1); PG8_STAGE(PG8_SA(0, 0), a2, voffA);
            PG8_BAR; PG8_WAIT_L(0); PG8_MMA(1, 0, At, B0); PG8_BAR; PG8_SCHED;
            PG8_STAGE(PG8_SB(0, 1), b2 + hstep, voffB);
            PG8_WAIT_V(6); PG8_BAR; PG8_MMA(1, 1, At, B1); PG8_BAR;
            PG8_LDB(B0, 1, 0); PG8_SCHED; PG8_LDA(At, 1, 0); PG8_STAGE(PG8_SA(0, 1), a2 + hstep, voffA);
            PG8_WAIT_L(8); PG8_BAR; PG8_WAIT_L(0); PG8_MMA(0, 0, At, B0); PG8_BAR; PG8_SCHED;
            PG8_LDB(B1, 1, 1); PG8_STAGE(PG8_SB(1, 0), b3, voffB);
            PG8_BAR; PG8_WAIT_L(0); PG8_MMA(0, 1, At, B1); PG8_BAR;
            PG8_LDA(At, 1, 1); PG8_STAGE(PG8_SA(1, 0), a3, voffA);
            PG8_BAR; PG8_WAIT_L(0); PG8_MMA(1, 0, At, B0); PG8_BAR; PG8_SCHED;
            PG8_STAGE(PG8_SB(1, 1), b3 + hstep, voffB);
            PG8_WAIT_V(6); PG8_BAR; PG8_MMA(1, 1, At, B1); PG8_BAR;
            }
        }
        if constexpr (ALIGN_EPI) { if (wr == 0) PG8_BAR; }
        bool keep_ = false; if constexpr (!Epi::AFTER_DRAIN) { keep_ = E(acc, cur, wr, wc, fr, fq); S.done(cur); }
        if (!has_next) break;
        if (!keep_)
#pragma unroll
        for (int a = 0; a < 2; ++a)
#pragma unroll
            for (int b = 0; b < 2; ++b)
#pragma unroll
                for (int m = 0; m < 4; ++m)
#pragma unroll
                    for (int n = 0; n < 2; ++n) acc[a][b][m][n] = (f32x4){0.f, 0.f, 0.f, 0.f};
        cur = nxt; cA = nA; cB = nB; ++ui;
        if constexpr (ALIGN_EPI) { if (wr == 1) PG8_BAR; }
    }
    PG8_WAIT_V(0);
    if constexpr (!ALIGN_EPI) { if (wr == 0) PG8_BAR; }
    PG8_BAR;
    if constexpr (Epi::AFTER_DRAIN) { E.fused(acc, cur, wr, wc, fr, fq, lds, wid, lane); S.done(cur); }
#undef PG8_SA
#undef PG8_SB
#undef PG8_STAGE
#undef PG8_LDA
#undef PG8_LDB
#undef PG8_MMA
#undef PG8_WAIT_V
#undef PG8_WAIT_L
#undef PG8_BAR
#undef PG8_SCHED
}
}
#ifndef DBG_ACTSCALE
#define DBG_ACTSCALE 1.0f
#endif
#ifndef DBG_OUTSCALE
#define DBG_OUTSCALE 1.0f
#endif
#ifndef DBG_KEEP
#define DBG_KEEP 16
#endif
#define COARSE2(w) (((w) + 0x00020002u) & 0xfffcfffcu)
#ifndef DBG_KROPE
#define DBG_KROPE 31
#endif
#ifndef DBG_FOXT
#define DBG_FOXT 1.0f
#endif
#ifndef DBG_NSAT
#define DBG_NSAT 1.0f
#endif
#ifndef DBG_DECAY
#define DBG_DECAY 1.0f
#endif

constexpr int NB = 8, SEQ = 4096, DM = 1024, NTOK = NB * SEQ;
constexpr int NIN = 5120;
constexpr int NEXP = 16384;
constexpr float LOG2E = 1.4426950408889634f;
constexpr float C2 = 0.125f * LOG2E;
constexpr float RMS_EPS = 1e-6f;
constexpr int NWAVES = 8;

constexpr size_t MiB = 1u << 20;
constexpr size_t WS_CTL = 0, CTL_ZERO_BYTES = 1 * MiB;
constexpr size_t WS_SS = 512 * 1024;
constexpr size_t WS_BIAS1 = 768 * 1024;
constexpr size_t WS_WTIN = 2 * MiB, WS_WTBR = 12 * MiB, WS_WTOUT = 14 * MiB, WS_WTPEER = 16 * MiB, WS_W1T = 20 * MiB;
constexpr size_t WS_W2T = 21 * MiB, WS_ROPE = 21 * MiB + 128 * 1024, WS_KCMP = 22 * MiB, WS_VCMP = 22 * MiB + 512 * 1024, WS_LOGF = 23 * MiB;
constexpr size_t WS_UB = 24 * MiB, WS_VB = 56 * MiB;
constexpr size_t WS_XN = 88 * MiB;
constexpr size_t WS_Y = WS_XN, WS_HB = WS_XN;
constexpr size_t WS_QF = 152 * MiB, WS_KF = 184 * MiB, WS_VF = 216 * MiB, WS_QN = 248 * MiB;
constexpr size_t WS_MERGED = WS_QF;
constexpr size_t WS_KVC = 280 * MiB, WS_KVS = 296 * MiB, WS_KVW = 312 * MiB;
constexpr size_t WS_GM = 328 * MiB;
constexpr size_t WS_GATES = 456 * MiB, WS_CUM = 459 * MiB, WS_END = 460 * MiB;
constexpr size_t WS_SC = 152 * MiB;
static_assert(WS_SC + (size_t)NTOK * 2048 * 4 <= WS_GATES, "score overlay");
constexpr int CW_BAR = 4096;
constexpr int CW_QATT = 8192, CW_QPEER = 8256;

constexpr int RING_BYTES = 131072;
constexpr int LDS_BYTES = 147456;
constexpr int LDSCTL_OFF = LDS_BYTES - 512, MISC_OFF = LDSCTL_OFF + 64;

#define GAS __attribute__((address_space(1)))
#define LAS __attribute__((address_space(3)))
typedef unsigned short bf16;
typedef unsigned v4u __attribute__((ext_vector_type(4)));
typedef unsigned v2u __attribute__((ext_vector_type(2)));
typedef float f32x4 __attribute__((ext_vector_type(4)));
typedef float f32x2 __attribute__((ext_vector_type(2)));
typedef short bf16x8 __attribute__((ext_vector_type(8)));
typedef short s16x4 __attribute__((ext_vector_type(4)));
typedef float f32x16 __attribute__((ext_vector_type(16)));
typedef GAS unsigned gu32;
#define RLX_AGENT __ATOMIC_RELAXED, __HIP_MEMORY_SCOPE_AGENT
#define LDS_WAIT() asm volatile("s_waitcnt lgkmcnt(0)" ::: "memory")
#define VM_WAIT() asm volatile("s_waitcnt vmcnt(0)" ::: "memory")
__device__ __forceinline__ unsigned pk2(float lo, float hi) { return pg8::cvt_pk_bf16(lo, hi); }
__device__ __forceinline__ float bf_lo(unsigned w) { return __uint_as_float(w << 16); }
__device__ __forceinline__ float bf_hi(unsigned w) { return __uint_as_float(w & 0xffff0000u); }
__device__ __forceinline__ float sigmoidf_(float x) { return __builtin_amdgcn_rcpf(1.0f + __builtin_amdgcn_exp2f(-x * LOG2E)); }
__device__ __forceinline__ float gelu_erf(float v) { return 0.5f * v * (1.0f + erff(v * 0.70710678118654752f)); }
__device__ __forceinline__ float wave_sum(float v) {
#pragma unroll
    for (int o = 1; o < 64; o <<= 1) v += __shfl_xor(v, o);
    return v;
}

#define XB_TMO      128
#define XB_XCNT(j)  (256  + 64 * (j))
#define XB_XSUB(j)  (1280 + 64 * (j))
#define XB_XGEN(j)  (2304 + 64 * (j))
#define XB_TOP      3328
#define XB_TOPGEN   3392
#define XCD_BAR_WORDS 3456
#define XB_SPIN_CAP (1u << 18)

__device__ __forceinline__ unsigned xb_ld(unsigned* p)              { return __hip_atomic_load(p, __ATOMIC_RELAXED, __HIP_MEMORY_SCOPE_AGENT); }
__device__ __forceinline__ unsigned xb_add(unsigned* p, unsigned v) { return __hip_atomic_fetch_add(p, v, __ATOMIC_RELAXED, __HIP_MEMORY_SCOPE_AGENT); }
__device__ __forceinline__ unsigned xb_xcc_id() { return (unsigned)__builtin_amdgcn_s_getreg((3 << 11) | 20) & 0xFu; }
#define XB_SPIN(cond, bar) do { unsigned _sp = 0; while (cond) { __builtin_amdgcn_s_sleep(1); \
    if ((++_sp & 255u) == 0u) { if (xb_ld(&(bar)[XB_TMO])) break; if (_sp > XB_SPIN_CAP) { atomicAdd(&(bar)[XB_TMO], 1u); break; } } } } while (0)

struct XcdBarrier {
    unsigned* bar; unsigned x;
    volatile LAS unsigned* st;
};

__device__ __forceinline__ XcdBarrier xcd_barrier_post(unsigned* bar, volatile LAS unsigned* st) {
    XcdBarrier b; b.bar = bar; b.x = xb_xcc_id(); b.st = st;
    if (threadIdx.x == 0) (void)xb_add(&bar[XB_XCNT(b.x)], 1u);
    return b;
}
__device__ __forceinline__ void xcd_barrier_complete(unsigned* bar, unsigned x, unsigned& nloc, unsigned& nx) {
    const unsigned G = gridDim.x * gridDim.y * gridDim.z;
    unsigned sum, cnt, mine, sp = 0u;
    for (;;) {
        sum = 0u; cnt = 0u; mine = 0u;
#pragma unroll
        for (unsigned j = 0; j < 16; ++j) { const unsigned c = xb_ld(&bar[XB_XCNT(j)]); sum += c; cnt += (c > 0u) ? 1u : 0u; mine = (j == x) ? c : mine; }
        if (sum == G) break;
        __builtin_amdgcn_s_sleep(1);
        if ((++sp & 255u) == 0u) { if (xb_ld(&bar[XB_TMO])) break; if (sp > XB_SPIN_CAP) { atomicAdd(&bar[XB_TMO], 1u); break; } }
    }
    nloc = mine > 0u ? mine : 1u; nx = cnt > 0u ? cnt : 1u;
}

__device__ __forceinline__ void xcd_barrier(const XcdBarrier& b) {
    asm volatile("s_waitcnt vmcnt(0)" ::: "memory");
    __syncthreads();
    if (threadIdx.x == 0) {
        unsigned* bar = b.bar;
        __builtin_amdgcn_s_waitcnt(0);
        unsigned nloc = b.st[0], nx = b.st[1];
        if (nloc == 0u) { xcd_barrier_complete(bar, b.x, nloc, nx); b.st[0] = nloc; b.st[1] = nx; }
        const unsigned old = xb_add(&bar[XB_XSUB(b.x)], 1u);
        const unsigned gen = old / nloc;
        if (old + 1u == (gen + 1u) * nloc) {
            __builtin_amdgcn_fence(__ATOMIC_RELEASE, "agent");
            asm volatile("s_waitcnt vmcnt(0)" ::: "memory");
            const unsigned og = xb_add(&bar[XB_TOP], 1u);
            const unsigned tg = og / nx;
            if (og + 1u == (tg + 1u) * nx) xb_add(&bar[XB_TOPGEN], 1u);
            else XB_SPIN(xb_ld(&bar[XB_TOPGEN]) == tg, bar);
            __builtin_amdgcn_fence(__ATOMIC_ACQUIRE, "agent");
            xb_add(&bar[XB_XGEN(b.x)], 1u);
            asm volatile("s_waitcnt vmcnt(0)" ::: "memory");
        } else {
            XB_SPIN(xb_ld(&bar[XB_XGEN(b.x)]) == gen, bar);
            __builtin_amdgcn_fence(__ATOMIC_ACQUIRE, "agent");
            asm volatile("s_waitcnt vmcnt(0)" ::: "memory");
        }
    }
    __syncthreads();
}


struct Frame {
    LAS unsigned char* lds;
    volatile LAS unsigned* MISC;
    gu32* ctl;
    int tid, lane, wave, vcu, G;
    unsigned char* ws;
    const float *x, *norm_mix, *w_in, *fbias, *cmp_pos, *cmp_w1, *cmp_w2, *w_branch, *w_out, *norm_ffn, *peer_wq, *peer_sk, *peer_u, *peer_v, *norm_final;
    float* out;
};

__device__ __forceinline__ int src_col_in(int n) {
    if (n < 1536) return n;
    if (n < 2816) return n + 8;
    if (n < 2824) return n - 2816 + 1536;
    if (n < 2848) return n;
    if (n < 3072) return -1;
    return n - 3072 + 2848;
}
__device__ __forceinline__ void p0_tr_item(const float* W, int ldw, int K, bf16* WT, int kb, int dst_row0, int src_col, LAS float* scr, int lane) {
    const int k0 = 64 * kb;
#pragma unroll 8
    for (int i = 0; i < 32; ++i) { const int kk = 2 * i + (lane >> 5); scr[kk * 33 + (lane & 31)] = (src_col >= 0) ? W[(size_t)(k0 + kk) * ldw + src_col] : 0.f; }
    LDS_WAIT(); asm volatile("" ::: "memory");
    const int c = lane & 7;
#pragma unroll
    for (int j = 0; j < 4; ++j) { const int n = (lane >> 3) + 8 * j; const LAS float* s = scr + (8 * c) * 33 + n;
        v4u o; o.x = pk2(s[0 * 33], s[1 * 33]); o.y = pk2(s[2 * 33], s[3 * 33]); o.z = pk2(s[4 * 33], s[5 * 33]); o.w = pk2(s[6 * 33], s[7 * 33]);
#ifdef DBG_C_W
        o.x = COARSE2(o.x); o.y = COARSE2(o.y); o.z = COARSE2(o.z); o.w = COARSE2(o.w);
#endif
        *(GAS v4u*)(WT + (size_t)(dst_row0 + n) * K + k0 + 8 * c) = o; }
    LDS_WAIT(); asm volatile("" ::: "memory");
}
__device__ __forceinline__ void p0_prologue(Frame& F) {
    LAS float* scr = (LAS float*)(F.lds + F.wave * 16384);
    unsigned char* ws = F.ws;
    const int gw = F.vcu * NWAVES + F.wave, NGW = F.G * NWAVES, lane = F.lane;
    const int gt = gw * 64 + lane, NGT = NGW * 64;
    constexpr int I_IN = 16 * 160, I_BR = 8 * 32, I_OUT = 16 * 32, I_W1 = 32 * 4, I_W2 = 2 * 2;
    constexpr int NITEMS = I_IN + 2 * I_BR + I_OUT + 2 * I_W1 + 2 * I_W2;
    for (int it = gw; it < NITEMS; it += NGW) {
        int r = it;
        if (r < I_IN) { const int kb = r / 160, nb = r % 160; p0_tr_item(F.w_in, 4896, 1024, (bf16*)(ws + WS_WTIN), kb, 32 * nb, src_col_in(32 * nb + (lane & 31)), scr, lane); continue; } r -= I_IN;
        if (r < 2 * I_BR) { const int br = r / I_BR, q = r % I_BR, kb = q / 32, nb = q % 32; p0_tr_item(F.w_branch + (size_t)br * 512 * 1024, 1024, 512, (bf16*)(ws + WS_WTBR), kb, br * 1024 + 32 * nb, 32 * nb + (lane & 31), scr, lane); continue; } r -= 2 * I_BR;
        if (r < I_OUT) { const int kb = r / 32, nb = r % 32; p0_tr_item(F.w_out, 1024, 1024, (bf16*)(ws + WS_WTOUT), kb, 32 * nb, 32 * nb + (lane & 31), scr, lane); continue; } r -= I_OUT;
        if (r < 2 * I_W1) { const int j = r / I_W1, q = r % I_W1, kb = q / 4, nb = q % 4; p0_tr_item(F.cmp_w1 + (size_t)j * 2048 * 128, 128, 2048, (bf16*)(ws + WS_W1T), kb, j * 128 + 32 * nb, 32 * nb + (lane & 31), scr, lane); continue; } r -= 2 * I_W1;
        { const int j = r / I_W2, q = r % I_W2, kb = q / 2, nb = q % 2; p0_tr_item(F.cmp_w2 + (size_t)j * 128 * 64, 64, 128, (bf16*)(ws + WS_W2T), kb, j * 64 + 32 * nb, 32 * nb + (lane & 31), scr, lane); }
    }
    for (int it = gt; it < 512 * 256; it += NGT) {
        const int nq = it >> 8, kq = it & 255, n0 = 4 * nq, k0 = 4 * kq, hp = n0 >> 7;
        const f32x4* s4[4]; const f32x4* w4[4];
#pragma unroll
        for (int i = 0; i < 4; ++i) { s4[i] = (const f32x4*)(F.peer_sk + (size_t)(n0 + i) * 128); w4[i] = (const f32x4*)(F.peer_wq + (size_t)(k0 + i) * 2048 + hp * 128); }
        float acc[4][4];
#pragma unroll
        for (int i = 0; i < 4; ++i)
#pragma unroll
            for (int j = 0; j < 4; ++j) acc[i][j] = 0.f;
        for (int d = 0; d < 32; ++d) {
            f32x4 sv[4], wv[4];
#pragma unroll
            for (int i = 0; i < 4; ++i) { sv[i] = s4[i][d]; wv[i] = w4[i][d]; }
#pragma unroll
            for (int i = 0; i < 4; ++i)
#pragma unroll
                for (int j = 0; j < 4; ++j) acc[i][j] += sv[i].x * wv[j].x + sv[i].y * wv[j].y + sv[i].z * wv[j].z + sv[i].w * wv[j].w;
        }
        bf16* WtP = (bf16*)(ws + WS_WTPEER);
#pragma unroll
        for (int i = 0; i < 4; ++i) { v2u o; o.x = pk2(acc[i][0], acc[i][1]); o.y = pk2(acc[i][2], acc[i][3]); *(GAS v2u*)(WtP + (size_t)(n0 + i) * 1024 + k0) = o; }
    }
    for (int it = gt; it < 2 * 128 * 8; it += NGT) {
        const int n = it & 127, j = (it >> 7) & 1, ch = it >> 8;
        const float* p = F.cmp_pos + (size_t)j * 2048 + ch * 256; const float* w = F.cmp_w1 + ((size_t)j * 2048 + ch * 256) * 128 + n;
        float a = 0.f;
        for (int k = 0; k < 256; ++k) a += p[k] * w[(size_t)k * 128];
        atomicAdd((float*)(ws + WS_BIAS1) + j * 128 + n, a);
    }
    for (int it = gt; it < SEQ * 8; it += NGT) {
        const int pos = it >> 3, i = it & 7;
        const double inv[8] = {1.0, 0.19392274474868576, 0.03760603093086393, 0.007292664737217109, 0.001414213562373095, 0.0002742481756762073, 5.318295896944988e-05, 1.031338537721246e-05};
        double iv = inv[0];
#pragma unroll
        for (int q = 1; q < 8; ++q) iv = (i == q) ? inv[q] : iv;
        const double rev = (double)pos * iv * 0.15915494309189535; const float fr = (float)(rev - __builtin_rint(rev));
        f32x2 cs; cs.x = __builtin_amdgcn_cosf(fr); cs.y = __builtin_amdgcn_sinf(fr);
        ((GAS f32x2*)(ws + WS_ROPE))[it] = cs;
    }
    for (int m = gw; m < NTOK; m += NGW) {
        const GAS f32x4* xr = (const GAS f32x4*)(F.x + (size_t)m * DM) + lane; const GAS f32x4* gr = (const GAS f32x4*)F.norm_mix + lane;
        f32x4 v[4]; float s = 0.f;
#pragma unroll
        for (int j = 0; j < 4; ++j) { v[j] = xr[64 * j]; s += (v[j].x * v[j].x + v[j].y * v[j].y) + (v[j].z * v[j].z + v[j].w * v[j].w); }
        const float r = 1.0f / sqrtf(wave_sum(s) * (1.f / DM) + RMS_EPS);
        GAS v2u* o8 = (GAS v2u*)((bf16*)(ws + WS_XN) + (size_t)m * DM) + lane;
#pragma unroll
        for (int j = 0; j < 4; ++j) { const f32x4 g = gr[64 * j]; v2u o; o.x = pk2(v[j].x * r * g.x, v[j].y * r * g.y); o.y = pk2(v[j].z * r * g.z, v[j].w * r * g.w);
#ifdef DBG_XN_COARSE
            o.x = (o.x + 0x00020002u) & 0xfffcfffcu; o.y = (o.y + 0x00020002u) & 0xfffcfffcu;
#endif
            o8[64 * j] = o; }
    }
    for (size_t it = gt; it < (size_t)2 * NEXP * DM / 8; it += NGT) {
        const size_t half = (size_t)NEXP * DM / 8; const bool isv = it >= half; const size_t e = isv ? it - half : it;
        const GAS f32x4* src = (const GAS f32x4*)(isv ? F.peer_v : F.peer_u) + 2 * e;
        const f32x4 a = src[0], b = src[1]; v4u o; o.x = pk2(a.x, a.y); o.y = pk2(a.z, a.w); o.z = pk2(b.x, b.y); o.w = pk2(b.z, b.w);
#ifdef DBG_C_UV
        o.x = COARSE2(o.x); o.y = COARSE2(o.y); o.z = COARSE2(o.z); o.w = COARSE2(o.w);
#endif
        ((GAS v4u*)(ws + (isv ? WS_VB : WS_UB)))[e] = o;
    }
}

struct EpiIn {
    static constexpr bool PERM = true, AFTER_DRAIN = false;
    unsigned char* ws; const float* fbias;
    __device__ __forceinline__ bool operator()(f32x4 (&acc)[2][2][4][2], const pg8::Unit& u, int wr, int wc, int fr, int fq) const {
        const int pn = u.pn, row0 = u.pm * 256 + wr * 64 + fr;
        if (pn == 11) {
            if (wc == 0) {
#pragma unroll
                for (int ai = 0; ai < 2; ++ai)
#pragma unroll
                    for (int m = 0; m < 4; ++m) { const int row = row0 + ai * 128 + m * 16; const f32x4 v0 = acc[ai][0][m][0], v1 = acc[ai][0][m][1];
                        float v[8] = {v0.x, v0.y, v0.z, v0.w, v1.x, v1.y, v1.z, v1.w}, o[8];
                        if (fq == 0) {
#pragma unroll
                            for (int i = 0; i < 8; ++i) { const float z = v[i] + fbias[i]; o[i] = fminf(z, 0.f) - log1pf(__expf(-fabsf(z))); }
                            GAS f32x4* d = (GAS f32x4*)((float*)(ws + WS_LOGF) + (size_t)row * 8); d[0] = (f32x4){o[0], o[1], o[2], o[3]}; d[1] = (f32x4){o[4], o[5], o[6], o[7]};
                        } else {
#pragma unroll
                            for (int i = 0; i < 8; ++i) o[i] = sigmoidf_(v[i]);
                            GAS f32x4* d = (GAS f32x4*)((float*)(ws + WS_GATES) + (size_t)row * 24 + (fq - 1) * 8); d[0] = (f32x4){o[0], o[1], o[2], o[3]}; d[1] = (f32x4){o[4], o[5], o[6], o[7]};
                        } }
            }
            return false;
        }
        bf16* dst; int pitch, colt; float sc = 1.f; int mode = 0;
        bool rope_bj1 = false;
        if (pn < 2)       { dst = (bf16*)(ws + WS_QF); pitch = 512; colt = pn * 256; sc = C2 * DBG_FOXT; }
        else if (pn < 4)  { dst = (bf16*)(ws + WS_KF); pitch = 512; colt = (pn - 2) * 256; }
        else if (pn < 6)  { dst = (bf16*)(ws + WS_VF); pitch = 512; colt = (pn - 4) * 256; }
        else if (pn < 8)  { dst = (bf16*)(ws + WS_QN); pitch = 512; colt = (pn - 6) * 256; sc = C2 * DBG_NSAT; mode = 1; rope_bj1 = true; }
        else if (pn == 8) { dst = (bf16*)(ws + WS_KVC); pitch = 256; colt = 0; }
        else if (pn == 9) { dst = (bf16*)(ws + WS_KVS); pitch = 256; colt = 0; mode = 1; }
        else if (pn == 10){ dst = (bf16*)(ws + WS_KVW); pitch = 256; colt = 0; mode = 1; }
        else              { dst = (bf16*)(ws + WS_GM); pitch = 2048; colt = (pn - 12) * 256; mode = 2; }
        const int cb0 = wc * 32 + 8 * fq;
        const bool ropelane = ((wc & 1) == 0) && (fq < 2);
        const GAS f32x2* rt = (const GAS f32x2*)(ws + WS_ROPE);
#pragma unroll
        for (int ai = 0; ai < 2; ++ai)
#pragma unroll
            for (int m = 0; m < 4; ++m) { const int row = row0 + ai * 128 + m * 16; bf16* rowp = dst + (size_t)row * pitch + colt + cb0;
#pragma unroll
                for (int bj = 0; bj < 2; ++bj) { const f32x4 a0 = acc[ai][bj][m][0], a1 = acc[ai][bj][m][1];
                    float v[8] = {a0.x, a0.y, a0.z, a0.w, a1.x, a1.y, a1.z, a1.w};
                    if (mode == 1 && (bj == 0 || rope_bj1) && ((wc & 1) == 0)) {
                        const int pos = row & (SEQ - 1);
#pragma unroll
                        for (int i = 0; i < 8; ++i) { const float pv = __shfl_xor(v[i], 16); if (ropelane) { const f32x2 cs = rt[pos * 8 + i];
                                v[i] = (fq == 0) ? (v[i] * cs.x - pv * cs.y) : (pv * cs.y + v[i] * cs.x); } }
                    }
                    if (mode == 2) {
#pragma unroll
                        for (int i = 0; i < 8; ++i) v[i] = sigmoidf_(v[i]);
                    }
                    v4u w; w.x = pk2(v[0] * sc, v[1] * sc); w.y = pk2(v[2] * sc, v[3] * sc); w.z = pk2(v[4] * sc, v[5] * sc); w.w = pk2(v[6] * sc, v[7] * sc);
#ifdef DBG_C_INPROJ
                    w.x = COARSE2(w.x); w.y = COARSE2(w.y); w.z = COARSE2(w.z); w.w = COARSE2(w.w);
#endif
                    *(GAS v4u*)(rowp + bj * 128) = w; } }
        return false;
    }
};

__device__ __forceinline__ void p2_compress_unit(Frame& F, int uidx) {
    unsigned char* ws = F.ws; const int lane = F.lane, wid = F.wave;
    const int j = uidx & 1, nb = (uidx >> 1) & 15, g = (uidx >> 5) & 1, b = uidx >> 6;
    const bf16* KVC = (const bf16*)(ws + WS_KVC); const bf16* W1T = (const bf16*)(ws + WS_W1T) + (size_t)j * 128 * 2048; const bf16* W2T = (const bf16*)(ws + WS_W2T) + (size_t)j * 64 * 128;
    LAS float* red = (LAS float*)F.lds;
    LAS bf16* h1b = (LAS bf16*)(F.lds + 65536);
    const int fr = lane & 15, fq = lane >> 4;
    int n = nb * 16 + fr; const int nc = n > 254 ? 254 : n;
    const bf16* arow = KVC + ((size_t)b * SEQ + 16 * nc) * 256 + j * 128 + g * 64;
    f32x4 acc[8];
#pragma unroll
    for (int t = 0; t < 8; ++t) acc[t] = (f32x4){0.f, 0.f, 0.f, 0.f};
#pragma unroll 2
    for (int kk = 0; kk < 8; ++kk) { const int ks = wid * 8 + kk, l = ks >> 1, d = (ks & 1) * 32 + 8 * fq;
        const bf16x8 a = *(const GAS bf16x8*)(arow + (size_t)l * 256 + d);
#pragma unroll
        for (int t = 0; t < 8; ++t) { const bf16x8 bb = *(const GAS bf16x8*)(W1T + (size_t)(t * 16 + fr) * 2048 + ks * 32 + 8 * fq);
            acc[t] = __builtin_amdgcn_mfma_f32_16x16x32_bf16(a, bb, acc[t], 0, 0, 0); } }
#pragma unroll
    for (int t = 0; t < 8; ++t)
#pragma unroll
        for (int r = 0; r < 4; ++r) red[(wid * 16 + 4 * fq + r) * 128 + t * 16 + fr] = acc[t][r];
    __syncthreads();
    { const float* b1 = (const float*)(ws + WS_BIAS1) + j * 128;
#pragma unroll
      for (int i = 0; i < 4; ++i) { const int e = F.tid + 512 * i, rr = e >> 7, cc = e & 127; float s = b1[cc];
#pragma unroll
          for (int w = 0; w < 8; ++w) s += red[(w * 16 + rr) * 128 + cc];
          h1b[rr * 128 + cc] = (bf16)(pk2(gelu_erf(s), 0.f) & 0xffffu); } }
    __syncthreads();
    if (wid < 4) {
        f32x4 a2 = (f32x4){0.f, 0.f, 0.f, 0.f};
#pragma unroll
        for (int k2 = 0; k2 < 4; ++k2) { const bf16x8 a = *(const LAS bf16x8*)(h1b + fr * 128 + k2 * 32 + 8 * fq);
            const bf16x8 bb = *(const GAS bf16x8*)(W2T + (size_t)(wid * 16 + fr) * 128 + k2 * 32 + 8 * fq);
            a2 = __builtin_amdgcn_mfma_f32_16x16x32_bf16(a, bb, a2, 0, 0, 0); }
        bf16* dstb = (bf16*)(ws + (j == 0 ? WS_KCMP : WS_VCMP));
        const GAS f32x2* rt = (const GAS f32x2*)(ws + WS_ROPE);
#pragma unroll
        for (int r = 0; r < 4; ++r) { const int nrow = nb * 16 + 4 * fq + r; float v = a2[r];
            if (j == 0 && wid == 0 && DBG_KROPE >= 0) { const float pv = __shfl_xor(v, 8); const int pos = (16 * nrow + DBG_KROPE) & (SEQ - 1); const f32x2 cs = rt[pos * 8 + (fr & 7)];
                v = (fr < 8) ? (v * cs.x - pv * cs.y) : (pv * cs.y + v * cs.x); }
            if (nrow > 254) v = 0.f;
#ifdef DBG_KCMP_COARSE
            if (j == 0) v = __uint_as_float((__float_as_uint(v) + 0x00020000u) & 0xfffc0000u);
#endif
            dstb[((size_t)b * 256 + nrow) * 128 + g * 64 + wid * 16 + fr] = (bf16)(pk2(v, 0.f) & 0xffffu); }
    }
    __syncthreads();
}
__device__ __forceinline__ void p2_cumsum_wave(Frame& F, int bh) {
    const int b = bh >> 3, h = bh & 7, lane = F.lane;
    const float* lf = (const float*)(F.ws + WS_LOGF) + ((size_t)b * SEQ + lane * 64) * 8 + h;
    float s = 0.f;
    for (int i = 0; i < 64; ++i) s += lf[i * 8];
    float inc = s;
#pragma unroll
    for (int o = 1; o < 64; o <<= 1) { const float t = __shfl_up(inc, o); if (lane >= o) inc += t; }
    float run = inc - s;
    float* cum = (float*)(F.ws + WS_CUM) + (size_t)bh * SEQ + lane * 64;
    for (int i = 0; i < 64; ++i) { run += lf[i * 8]; cum[i] = -LOG2E * DBG_DECAY * run; }
}

namespace att {
constexpr int A_K = 0, A_V = 16384, A_WS = 32768, A_OST = 34816, A_BIG = 67584, A_SEL = 133120, SLOT = 8192;
typedef LAS const char* lds_cptr;
typedef short v4i16_t __attribute__((ext_vector_type(4)));
#define MFMA32(a, b, c) __builtin_amdgcn_mfma_f32_32x32x16_bf16(a, b, c, 0, 0, 0)
__device__ __forceinline__ int crow(int r, int hi) { return (r & 3) + 8 * (r >> 2) + 4 * hi; }
__device__ __forceinline__ void glds16(const void* g, unsigned lds_base) {
    unsigned sv; asm volatile("s_mov_b32 %0, m0\n\ts_mov_b32 m0, %2\n\ts_nop 0\n\tglobal_load_lds_dwordx4 %1, off\n\ts_mov_b32 m0, %0" : "=&s"(sv) : "v"(g), "s"(lds_base) : "memory"); }
__device__ __forceinline__ s16x4 vtr(lds_cptr p) { return __builtin_bit_cast(s16x4, __builtin_amdgcn_ds_read_tr16_b64_v4i16((LAS v4i16_t*)p)); }
#define MX3(a, b, c) __builtin_fmaxf(__builtin_fmaxf((a), (b)), (c))
__device__ __forceinline__ float rowmax(const f32x16& p0, const f32x16& p1) {
    float a = MX3(p0[0], p0[1], p1[0]), b = MX3(p0[2], p0[3], p1[1]); a = MX3(a, p1[2], p1[3]);
#pragma unroll
    for (int r = 4; r < 16; r += 4) { a = MX3(a, p0[r], p0[r + 1]); b = MX3(b, p0[r + 2], p0[r + 3]); a = MX3(a, p1[r], p1[r + 1]); b = MX3(b, p1[r + 2], p1[r + 3]); }
    float m = __builtin_fmaxf(a, b); auto rr = __builtin_amdgcn_permlane32_swap(__float_as_uint(m), __float_as_uint(m), false, false);
    return __builtin_fmaxf(__uint_as_float(rr[0]), __uint_as_float(rr[1])); }

enum { M_FOX = 0, M_CMP1 = 1, M_CMP2 = 2, M_SLC = 3, M_WIN = 4 };
struct St { f32x16 o[2]; float mref, l; };

template <int MODE>
__device__ __forceinline__ void tile_step(LAS unsigned char* lds, int slot, const bf16x8 (&qr)[4], St& st, float rl, int t, int qpos, int q0w, int QBk,
                                          unsigned long long selm, LAS float* wsf, LAS float* impw, const LAS float* cbl, int lane, int r32, int hi) {
    if (MODE == M_FOX) { if (64 * t > q0w + 31) return; }
    const lds_cptr kp = (lds_cptr)lds + A_K + slot * SLOT + hi * 1024 + r32 * 16;
    bf16x8 kf[8];
#pragma unroll
    for (int d0 = 0; d0 < 4; ++d0) { kf[2 * d0] = *(const LAS bf16x8*)(kp + d0 * 2048); kf[2 * d0 + 1] = *(const LAS bf16x8*)(kp + d0 * 2048 + 512); }
    f32x16 s0, s1;
#pragma unroll
    for (int r = 0; r < 16; ++r) { s0[r] = 0.f; s1[r] = 0.f; }
#pragma unroll
    for (int d0 = 0; d0 < 4; ++d0) { s0 = MFMA32(kf[2 * d0], qr[d0], s0); s1 = MFMA32(kf[2 * d0 + 1], qr[d0], s1); }
    if (MODE == M_FOX) {
        const LAS f32x4* cb = (const LAS f32x4*)(cbl + 64 * t + 4 * hi);
#pragma unroll
        for (int g = 0; g < 4; ++g) { const f32x4 a = cb[2 * g], b = cb[8 + 2 * g];
            s0[4 * g] += a.x; s0[4 * g + 1] += a.y; s0[4 * g + 2] += a.z; s0[4 * g + 3] += a.w; s1[4 * g] += b.x; s1[4 * g + 1] += b.y; s1[4 * g + 2] += b.z; s1[4 * g + 3] += b.w; }
    }
    const float NEG = -INFINITY; const int kvb = 64 * t + 4 * hi;
    if (MODE == M_FOX) { if (64 * t + 63 > q0w) {
#pragma unroll
            for (int r = 0; r < 16; ++r) { const int kv = kvb + (r & 3) + 8 * (r >> 2); if (kv > qpos) s0[r] = NEG; if (kv + 32 > qpos) s1[r] = NEG; } } }
    if (MODE == M_CMP1 || MODE == M_CMP2) {
#ifdef DBG_CMP_UNIFORM
#pragma unroll
        for (int r = 0; r < 16; ++r) { s0[r] = 0.f; s1[r] = 0.f; }
#endif
#pragma unroll
        for (int r = 0; r < 16; ++r) { const int n = kvb + (r & 3) + 8 * (r >> 2); if (16 * n + 31 > qpos) s0[r] = NEG; if (16 * (n + 32) + 31 > qpos) s1[r] = NEG; } }
    if (MODE == M_SLC) { const bool allowed = (selm >> t) & 1ull; const bool diag = (t == QBk);
#pragma unroll
        for (int r = 0; r < 16; ++r) { const int kv = kvb + (r & 3) + 8 * (r >> 2); if (!allowed || (diag && kv > qpos)) s0[r] = NEG; if (!allowed || (diag && kv + 32 > qpos)) s1[r] = NEG; } }
    if (MODE == M_WIN) { if (t == QBk || t + 8 == QBk) {
#pragma unroll
            for (int r = 0; r < 16; ++r) { const int kv = kvb + (r & 3) + 8 * (r >> 2); if (kv > qpos || qpos - kv >= 512) s0[r] = NEG; if (kv + 32 > qpos || qpos - (kv + 32) >= 512) s1[r] = NEG; } } }
    if (MODE != M_CMP2) {
        const float rm = rowmax(s0, s1);
        if (__any(rm > st.mref + 8.0f)) {
            const float mnew = fmaxf(st.mref, rm), alpha = __builtin_amdgcn_exp2f(st.mref - mnew); st.l *= alpha; st.mref = mnew;
            if (MODE != M_CMP1) { if (hi == 0) wsf[r32] = alpha; LDS_WAIT();
#pragma unroll
                for (int r = 0; r < 16; ++r) { const float f = wsf[crow(r, hi)]; st.o[0][r] *= f; st.o[1][r] *= f; }
                LDS_WAIT(); }
        }
    }
    float ps = 0.f;
#pragma unroll
    for (int r = 0; r < 16; ++r) { s0[r] = __builtin_amdgcn_exp2f(s0[r] - st.mref); s1[r] = __builtin_amdgcn_exp2f(s1[r] - st.mref); ps += s0[r] + s1[r]; }
    if (MODE != M_CMP2) st.l += ps;
    if (MODE == M_CMP1) return;
    if (MODE == M_CMP2) {
#pragma unroll
        for (int r = 0; r < 16; ++r) { s0[r] *= rl; s1[r] *= rl; }
#pragma unroll
        for (int g = 0; g < 4; ++g) {
            const int j0 = 16 * t + 2 * g + hi, j1 = j0 + 8;
            const float b0 = 0.5f * s0[4 * g + 3], a0 = s0[4 * g] + s0[4 * g + 1] + s0[4 * g + 2] + b0;
            const float b1 = 0.5f * s1[4 * g + 3], a1 = s1[4 * g] + s1[4 * g + 1] + s1[4 * g + 2] + b1;
            __hip_atomic_fetch_add(impw + j0, a0, __ATOMIC_RELAXED, __HIP_MEMORY_SCOPE_WORKGROUP); __hip_atomic_fetch_add(impw + j0 + 1, b0, __ATOMIC_RELAXED, __HIP_MEMORY_SCOPE_WORKGROUP);
            __hip_atomic_fetch_add(impw + j1, a1, __ATOMIC_RELAXED, __HIP_MEMORY_SCOPE_WORKGROUP); if (j1 + 1 < 64) __hip_atomic_fetch_add(impw + j1 + 1, b1, __ATOMIC_RELAXED, __HIP_MEMORY_SCOPE_WORKGROUP);
        }
    }
    v4u pw[4];
    pw[0] = (v4u){pk2(s0[0], s0[1]), pk2(s0[2], s0[3]), pk2(s0[4], s0[5]), pk2(s0[6], s0[7])};
    pw[1] = (v4u){pk2(s0[8], s0[9]), pk2(s0[10], s0[11]), pk2(s0[12], s0[13]), pk2(s0[14], s0[15])};
    pw[2] = (v4u){pk2(s1[0], s1[1]), pk2(s1[2], s1[3]), pk2(s1[4], s1[5]), pk2(s1[6], s1[7])};
    pw[3] = (v4u){pk2(s1[8], s1[9]), pk2(s1[10], s1[11]), pk2(s1[12], s1[13]), pk2(s1[14], s1[15])};
#ifdef DBG_C_P
#pragma unroll
    for (int i_ = 0; i_ < 4; ++i_) { pw[i_].x = COARSE2(pw[i_].x); pw[i_].y = COARSE2(pw[i_].y); pw[i_].z = COARSE2(pw[i_].z); pw[i_].w = COARSE2(pw[i_].w); }
#endif
    const lds_cptr vp = (lds_cptr)lds + A_V + slot * SLOT + ((lane >> 4) & 1) * 32 + (lane & 3) * 8 + (4 * hi + ((lane & 15) >> 2)) * 64;
#pragma unroll
    for (int d0 = 0; d0 < 2; ++d0)
#pragma unroll
        for (int ks = 0; ks < 4; ++ks) { const s16x4 lo = vtr(vp + d0 * 4096 + ks * 1024), hh = vtr(vp + d0 * 4096 + ks * 1024 + 512);
            const bf16x8 vf = (bf16x8){lo[0], lo[1], lo[2], lo[3], hh[0], hh[1], hh[2], hh[3]};
            st.o[d0] = MFMA32(__builtin_bit_cast(bf16x8, pw[ks]), vf, st.o[d0]); }
}

template <int MODE>
__device__ __forceinline__ void run_tiles(LAS unsigned char* lds, unsigned long long tm, const bf16* kbase, const bf16* vbase, int pitch, const bf16x8 (&qr)[4], St& st, float rl,
                                          int qpos, int q0w, int QBk, unsigned long long selm, LAS float* wsf, LAS float* impw, const LAS float* cbl, int lane, int r32, int hi, int wid) {
    const unsigned lds0 = (unsigned)(uintptr_t)lds;
    const bf16* ksrc = kbase + (size_t)lane * pitch + wid * 8;
    const bf16* vsrc = vbase + (size_t)(16 * (wid & 3) + (lane >> 2)) * pitch + (wid >> 2) * 32 + (lane & 3) * 8;
    const unsigned kdst = lds0 + A_K + wid * 1024, vdst = lds0 + A_V + wid * 1024;
    if (tm == 0ull) return;
    int t = __builtin_ctzll(tm); tm &= tm - 1ull; int s = 0;
    glds16(ksrc + (size_t)t * 64 * pitch, (unsigned)__builtin_amdgcn_readfirstlane(kdst));
    if (MODE != M_CMP1) glds16(vsrc + (size_t)t * 64 * pitch, (unsigned)__builtin_amdgcn_readfirstlane(vdst));
    for (;;) {
        VM_WAIT(); __syncthreads();
        int tn = -1;
        if (tm != 0ull) { tn = __builtin_ctzll(tm); tm &= tm - 1ull;
            glds16(ksrc + (size_t)tn * 64 * pitch, (unsigned)__builtin_amdgcn_readfirstlane(kdst + (s ^ 1) * SLOT));
            if (MODE != M_CMP1) glds16(vsrc + (size_t)tn * 64 * pitch, (unsigned)__builtin_amdgcn_readfirstlane(vdst + (s ^ 1) * SLOT)); }
        tile_step<MODE>(lds, s, qr, st, rl, t, qpos, q0w, QBk, selm, wsf, impw, cbl, lane, r32, hi);
        if (tn < 0) break;
        t = tn; s ^= 1;
    }
    LDS_WAIT(); __syncthreads();
}
__device__ __forceinline__ void st_init(St& st) {
#pragma unroll
    for (int r = 0; r < 16; ++r) { st.o[0][r] = 0.f; st.o[1][r] = 0.f; }
    st.mref = -1e30f; st.l = 0.f;
}
__device__ __forceinline__ void store_o(LAS unsigned char* lds, const f32x16 (&o)[2], const float (&rli)[16], bf16* Ow, int lane, int r32, int hi, int wid) {
    LAS bf16* stg = (LAS bf16*)(lds + A_OST) + wid * 2048;
#pragma unroll
    for (int r = 0; r < 16; ++r) { const int orow = crow(r, hi);
#pragma unroll
        for (int d0 = 0; d0 < 2; ++d0) { unsigned w_ = pk2(o[d0][r] * rli[r], 0.f) & 0xffffu;
#ifdef DBG_C_Y
            w_ = (w_ + 2u) & 0xfffcu;
#endif
            stg[orow * 64 + d0 * 32 + r32] = (bf16)w_; } }
    LDS_WAIT();
#pragma unroll
    for (int i = 0; i < 4; ++i) { const int row = i * 8 + (lane >> 3), ch = lane & 7; const v4u v = *(const LAS v4u*)(stg + row * 64 + ch * 8); *(GAS v4u*)(Ow + (size_t)row * 512 + ch * 8) = v; }
    LDS_WAIT();
}
__device__ __forceinline__ void row_to_regs(LAS float* wsf, float val, float (&rli)[16], int r32, int hi) {
    if (hi == 0) wsf[32 + r32] = val; LDS_WAIT();
#pragma unroll
    for (int r = 0; r < 16; ++r) rli[r] = wsf[32 + crow(r, hi)];
    LDS_WAIT();
}

__device__ __forceinline__ void fox_unit(Frame& F, int b, int h, int qb) {
    LAS unsigned char* lds = F.lds; unsigned char* ws = F.ws;
    const int lane = F.lane, wid = F.wave, r32 = lane & 31, hi = lane >> 5, q0 = qb * 256, q0w = q0 + 32 * wid, qpos = q0w + r32;
    LAS float* wsf = (LAS float*)(lds + A_WS) + wid * 64; LAS float* cbl = (LAS float*)(lds + A_BIG);
    const float* cum = (const float*)(ws + WS_CUM) + (size_t)(b * 8 + h) * SEQ;
    for (int i = F.tid; i < 256 * (qb + 1); i += 512) cbl[i] = cum[i];
    const bf16* Qw = (const bf16*)(ws + WS_QF) + ((size_t)b * SEQ + q0w) * 512 + h * 64;
    bf16x8 qr[4];
#pragma unroll
    for (int d0 = 0; d0 < 4; ++d0) qr[d0] = *(const GAS bf16x8*)(Qw + (size_t)r32 * 512 + d0 * 16 + hi * 8);
    St st; st_init(st);
    const int ntile = 4 * (qb + 1); const unsigned long long tm = ntile >= 64 ? ~0ull : ((1ull << ntile) - 1ull);
    const bf16* kb = (const bf16*)(ws + WS_KF) + (size_t)b * SEQ * 512 + h * 64; const bf16* vb = (const bf16*)(ws + WS_VF) + (size_t)b * SEQ * 512 + h * 64;
    run_tiles<M_FOX>(lds, tm, kb, vb, 512, qr, st, 0.f, qpos, q0w, 0, 0ull, wsf, nullptr, cbl, lane, r32, hi, wid);
    float lt = st.l + __shfl_xor(st.l, 32);
#ifndef DBG_SC_FOX
#define DBG_SC_FOX 1.0f
#endif
    float rli[16]; row_to_regs(wsf, DBG_SC_FOX / lt, rli, r32, hi);
    bf16* Ow = (bf16*)(ws + WS_Y) + ((size_t)b * SEQ + q0w) * 512 + h * 64;
    store_o(lds, st.o, rli, Ow, lane, r32, hi, wid);
    __syncthreads();
}

__device__ __forceinline__ void nsa_unit(Frame& F, int b, int g, int QBk) {
    LAS unsigned char* lds = F.lds; unsigned char* ws = F.ws;
    const int lane = F.lane, wid = F.wave, r32 = lane & 31, hi = lane >> 5, hh = wid >> 1, qoff = 32 * (wid & 1), q0 = 64 * QBk, q0w = q0 + qoff, qpos = q0w + r32, head = 4 * g + hh;
    LAS float* wsf = (LAS float*)(lds + A_WS) + wid * 64; LAS float* imp = (LAS float*)(lds + A_BIG);
    LAS unsigned long long* selw = (LAS unsigned long long*)(lds + A_SEL);
    LAS float* impw = imp + (size_t)((hh * 64 + qoff + r32) * 64);
    { LAS float* z = imp + (size_t)((hh * 64 + qoff) * 64);
#pragma unroll 8
      for (int i = 0; i < 32; ++i) z[i * 64 + lane] = 0.f; }
    const bf16* Qw = (const bf16*)(ws + WS_QN) + ((size_t)b * SEQ + q0w) * 512 + head * 64;
    bf16x8 qr[4];
#pragma unroll
    for (int d0 = 0; d0 < 4; ++d0) qr[d0] = *(const GAS bf16x8*)(Qw + (size_t)r32 * 512 + d0 * 16 + hi * 8);
    const float* gat = (const float*)(ws + WS_GATES) + ((size_t)b * SEQ + qpos) * 24 + head * 3;
    float g_cmp = gat[0], g_slc = gat[1], g_win = gat[2];
#ifdef DBG_NO_CMP
    g_cmp = 0.f;
#endif
#ifdef DBG_SC_CMP
    g_cmp *= DBG_SC_CMP;
#endif
#ifdef DBG_SC_SLC
    g_slc *= DBG_SC_SLC;
#endif
#ifdef DBG_SC_WIN
    g_win *= DBG_SC_WIN;
#endif
#ifdef DBG_NO_SLC
    g_slc = 0.f;
#endif
#ifdef DBG_NO_WIN
    g_win = 0.f;
#endif
    float rli[16];
    St st;
    const int ntc = ((q0 + 32) >> 10) + 1;
    const unsigned long long tmc = (1ull << ntc) - 1ull;
    const bf16* kc = (const bf16*)(ws + WS_KCMP) + (size_t)b * 256 * 128 + g * 64; const bf16* vc = (const bf16*)(ws + WS_VCMP) + (size_t)b * 256 * 128 + g * 64;
    st_init(st);
    run_tiles<M_CMP1>(lds, tmc, kc, vc, 128, qr, st, 0.f, qpos, q0w, QBk, 0ull, wsf, impw, nullptr, lane, r32, hi, wid);
    { const float lt = st.l + __shfl_xor(st.l, 32); const float rl = lt > 0.f ? 1.0f / lt : 0.f; const float mkeep = st.mref;
      st_init(st); st.mref = mkeep;
      run_tiles<M_CMP2>(lds, tmc, kc, vc, 128, qr, st, rl, qpos, q0w, QBk, 0ull, wsf, impw, nullptr, lane, r32, hi, wid); }
    __syncthreads();
    for (int qq = 0; qq < 8; ++qq) { const int q = wid * 8 + qq, j = lane;
        float v = ((imp[(0 * 64 + q) * 64 + j] + imp[(1 * 64 + q) * 64 + j]) + imp[(2 * 64 + q) * 64 + j]) + imp[(3 * 64 + q) * 64 + j];
#ifdef DBG_IMPNOISE
        { const unsigned hsh = ((unsigned)(q0 + q) * 2654435761u) ^ ((unsigned)(j + 64 * (b * 2 + g)) * 2246822519u); const float nz = ((float)((hsh >> 9) & 0xffff) * (1.0f / 65536.0f) - 0.5f); v = v * (1.0f + DBG_IMPNOISE * nz); }
#endif
        const bool forced = (j == 0) || (j == QBk) || (j == QBk - 1), causal = j <= QBk;
        const float score = forced ? 1e9f : (causal ? v : -1.0f);
        int rank = 0;
#pragma unroll 16
        for (int i = 0; i < 64; ++i) { const float si = __uint_as_float(__builtin_amdgcn_readlane(__float_as_uint(score), i)); rank += (si > score || (si == score && i < j)) ? 1 : 0; }
        const unsigned long long msk = __ballot(causal && rank < 16);
        if (lane == 0) selw[q] = msk; }
    __syncthreads();
    LAS float* otl = imp + wid * 2048 + lane;
    row_to_regs(wsf, g_cmp, rli, r32, hi);
#pragma unroll
    for (int r = 0; r < 16; ++r) { otl[(2 * r) * 64] = st.o[0][r] * rli[r]; otl[(2 * r + 1) * 64] = st.o[1][r] * rli[r]; }
    const unsigned long long selm = selw[qoff + r32];
    unsigned long long um = selw[lane];
#pragma unroll
    for (int o = 1; o < 64; o <<= 1) { const unsigned lo = __shfl_xor((unsigned)um, o), hi2 = __shfl_xor((unsigned)(um >> 32), o); um |= ((unsigned long long)hi2 << 32) | lo; }
    um = ((unsigned long long)__builtin_amdgcn_readfirstlane((unsigned)(um >> 32)) << 32) | (unsigned)__builtin_amdgcn_readfirstlane((unsigned)um);
    const bf16* ksl = (const bf16*)(ws + WS_KVS) + (size_t)b * SEQ * 256 + g * 64; const bf16* vsl = ksl + 128;
    st_init(st);
    run_tiles<M_SLC>(lds, um, ksl, vsl, 256, qr, st, 0.f, qpos, q0w, QBk, selm, wsf, impw, nullptr, lane, r32, hi, wid);
    { const float lt = st.l + __shfl_xor(st.l, 32); row_to_regs(wsf, g_slc / lt, rli, r32, hi);
#pragma unroll
      for (int r = 0; r < 16; ++r) { otl[(2 * r) * 64] += st.o[0][r] * rli[r]; otl[(2 * r + 1) * 64] += st.o[1][r] * rli[r]; } }
    const bf16* kw = (const bf16*)(ws + WS_KVW) + (size_t)b * SEQ * 256 + g * 64; const bf16* vw = kw + 128;
    { const int tlo = QBk >= 8 ? QBk - 8 : 0; const int nt = QBk - tlo + 1; const unsigned long long tmw = ((1ull << nt) - 1ull) << tlo;
      st_init(st);
      run_tiles<M_WIN>(lds, tmw, kw, vw, 256, qr, st, 0.f, qpos, q0w, QBk, 0ull, wsf, impw, nullptr, lane, r32, hi, wid); }
    { const float lt = st.l + __shfl_xor(st.l, 32); row_to_regs(wsf, g_win / lt, rli, r32, hi);
#pragma unroll
      for (int r = 0; r < 16; ++r) { st.o[0][r] = otl[(2 * r) * 64] + st.o[0][r] * rli[r]; st.o[1][r] = otl[(2 * r + 1) * 64] + st.o[1][r] * rli[r]; } }
#pragma unroll
    for (int r = 0; r < 16; ++r) rli[r] = 1.0f;
    bf16* Ow = (bf16*)(ws + WS_Y) + ((size_t)NTOK + (size_t)b * SEQ + q0w) * 512 + head * 64;
    store_o(lds, st.o, rli, Ow, lane, r32, hi, wid);
    __syncthreads();
}
#undef MFMA32
#undef MX3
}

__device__ __forceinline__ void p3_attention(Frame& F) {
    volatile LAS unsigned* qslot = F.MISC + 16;
    for (;;) {
        if (F.tid == 0) qslot[0] = __hip_atomic_fetch_add(F.ctl + CW_QATT, 1u, RLX_AGENT);
        __syncthreads();
        const unsigned u = qslot[0];
        __syncthreads();
        if (u >= 2048u) break;
        const int k = (int)(u >> 1);
        if ((u & 1u) == 0u) { const int qb = 15 - (k >> 6), bh = k & 63; att::fox_unit(F, bh >> 3, bh & 7, qb); }
        else { const int QBk = 63 - (k >> 4), bg = k & 15; att::nsa_unit(F, bg >> 1, bg & 1, QBk); }
    }
}

struct MergeOrder {
    int vcu, G;
    __device__ __forceinline__ bool next(int i, pg8::Unit& u) const { const int p = (i >> 1) * G + vcu; if (p >= 512) return false; const int br = i & 1, tm = p >> 2, tn = p & 3; u.pm = br * 128 + tm; u.pn = br * 4 + tn; return true; }
    __device__ __forceinline__ void a_ready(const pg8::Unit&) const {}
    __device__ __forceinline__ void done(const pg8::Unit&) const {}
};
struct EpiMerge {
    static constexpr bool PERM = true, AFTER_DRAIN = false;
    unsigned char* ws;
    __device__ __forceinline__ bool operator()(f32x4 (&acc)[2][2][4][2], const pg8::Unit& u, int wr, int wc, int fr, int fq) const {
        const int br = u.pm >> 7, tm = u.pm & 127, tn = u.pn & 3;
        const int row0 = tm * 256 + wr * 64 + fr, col0 = tn * 256 + wc * 32 + 8 * fq;
        const bf16* GM = (const bf16*)(ws + WS_GM); bf16* MG = (bf16*)(ws + WS_MERGED);
#pragma unroll
        for (int ai = 0; ai < 2; ++ai)
#pragma unroll
            for (int m = 0; m < 4; ++m) { const int row = row0 + ai * 128 + m * 16;
#pragma unroll
                for (int bj = 0; bj < 2; ++bj) { const int col = col0 + bj * 128;
                    const v4u g1w = *(const GAS v4u*)(GM + (size_t)row * 2048 + 1024 + col);
                    float g1[8] = {bf_lo(g1w.x), bf_hi(g1w.x), bf_lo(g1w.y), bf_hi(g1w.y), bf_lo(g1w.z), bf_hi(g1w.z), bf_lo(g1w.w), bf_hi(g1w.w)};
                    f32x4& a0 = acc[ai][bj][m][0]; f32x4& a1 = acc[ai][bj][m][1];
                    if (br == 0) {
                        const v4u g0w = *(const GAS v4u*)(GM + (size_t)row * 2048 + col);
                        float g0[8] = {bf_lo(g0w.x), bf_hi(g0w.x), bf_lo(g0w.y), bf_hi(g0w.y), bf_lo(g0w.z), bf_hi(g0w.z), bf_lo(g0w.w), bf_hi(g0w.w)};
                        float rt[8];
#pragma unroll
                        for (int i = 0; i < 8; ++i) rt[i] = g1[i] > 0.f ? g0[i] * __builtin_amdgcn_rcpf(g1[i]) : 0.f;
                        a0.x *= rt[0]; a0.y *= rt[1]; a0.z *= rt[2]; a0.w *= rt[3]; a1.x *= rt[4]; a1.y *= rt[5]; a1.z *= rt[6]; a1.w *= rt[7];
                    } else {
                        v4u w; w.x = pk2(a0.x * g1[0], a0.y * g1[1]); w.y = pk2(a0.z * g1[2], a0.w * g1[3]); w.z = pk2(a1.x * g1[4], a1.y * g1[5]); w.w = pk2(a1.z * g1[6], a1.w * g1[7]);
#ifdef DBG_C_MERGED
                        w.x = COARSE2(w.x); w.y = COARSE2(w.y); w.z = COARSE2(w.z); w.w = COARSE2(w.w);
#endif
                        *(GAS v4u*)(MG + (size_t)row * 1024 + col) = w;
                    } } }
        return br == 0;
    }
};
#ifndef DBG_DECAY
#define DBG_DECAY 1.0f
#endif
#ifndef DBG_TEMP
#define DBG_TEMP 1.0f
#endif
#ifndef DBG_PEERSCALE
#define DBG_PEERSCALE 1.0f
#endif
#ifndef DBG_MIXSCALE
#define DBG_MIXSCALE 1.0f
#endif
struct EpiOut {
    static constexpr bool PERM = false, AFTER_DRAIN = false;
    unsigned char* ws; const float* x; float* out; const float* gffn;
    __device__ __forceinline__ bool operator()(f32x4 (&acc)[2][2][4][2], const pg8::Unit& u, int wr, int wc, int fr, int fq) const {
        const int row0 = u.pm * 256 + wr * 64 + fr, col0 = u.pn * 256 + wc * 32 + 4 * fq;
        bf16* HB = (bf16*)(ws + WS_HB); float* SS = (float*)(ws + WS_SS);
#pragma unroll
        for (int ai = 0; ai < 2; ++ai)
#pragma unroll
            for (int m = 0; m < 4; ++m) { const int row = row0 + ai * 128 + m * 16; float ssq = 0.f;
#pragma unroll
                for (int bj = 0; bj < 2; ++bj)
#pragma unroll
                    for (int n = 0; n < 2; ++n) { const int col = col0 + bj * 128 + n * 16; const size_t off = (size_t)row * 1024 + col;
                        const f32x4 xv = *(const GAS f32x4*)(x + off); const f32x4 hv = xv + acc[ai][bj][m][n] * DBG_MIXSCALE; *(GAS f32x4*)(out + off) = hv;
                        const f32x4 gv = *(const GAS f32x4*)(gffn + col); v2u w; w.x = pk2(hv.x * gv.x, hv.y * gv.y); w.y = pk2(hv.z * gv.z, hv.w * gv.w); *(GAS v2u*)(HB + off) = w;
                        ssq += (hv.x * hv.x + hv.y * hv.y) + (hv.z * hv.z + hv.w * hv.w); }
                ssq += __shfl_xor(ssq, 16); ssq += __shfl_xor(ssq, 32);
                if (fq == 0) atomicAdd(SS + row, ssq); }
        return false;
    }
};
struct EpiF32 {
    static constexpr bool PERM = false, AFTER_DRAIN = false;
    float* O; int ldc;
    __device__ __forceinline__ bool operator()(f32x4 (&acc)[2][2][4][2], const pg8::Unit& u, int wr, int wc, int fr, int fq) const {
        const int row0 = u.pm * 256 + wr * 64 + fr, col0 = u.pn * 256 + wc * 32 + 4 * fq;
#pragma unroll
        for (int ai = 0; ai < 2; ++ai)
#pragma unroll
            for (int m = 0; m < 4; ++m) { float* rowp = O + (size_t)(row0 + ai * 128 + m * 16) * ldc + col0;
#pragma unroll
                for (int bj = 0; bj < 2; ++bj)
#pragma unroll
                    for (int n = 0; n < 2; ++n) *(GAS f32x4*)(rowp + bj * 128 + n * 16) = acc[ai][bj][m][n]; }
        return false;
    }
};

#ifdef DBG_F32SCORES
__device__ __forceinline__ void p6_naive(Frame& F) {
    LAS float* hn = (LAS float*)F.lds; LAS float* qv = hn + 8 * 1024;
    const float* SS = (const float*)(F.ws + WS_SS); float* SC = (float*)(F.ws + WS_SC);
    for (int g8 = blockIdx.x; g8 < NTOK / 8; g8 += F.G) { const int t0 = g8 * 8;
        for (int e = F.tid; e < 8 * 1024; e += 512) { const int tk = e >> 10, d = e & 1023; const float rt = 1.0f / sqrtf(SS[t0 + tk] * (1.f / DM) + RMS_EPS); hn[e] = F.out[(size_t)(t0 + tk) * 1024 + d] * F.norm_ffn[d] * rt; }
        __syncthreads();
        { const int c0 = F.tid * 4; float acc[8][4];
          for (int i = 0; i < 8; ++i) for (int j = 0; j < 4; ++j) acc[i][j] = 0.f;
          for (int k = 0; k < 1024; ++k) { const f32x4 w = *(const GAS f32x4*)(F.peer_wq + (size_t)k * 2048 + c0);
#pragma unroll
              for (int i = 0; i < 8; ++i) { const float hv = hn[i * 1024 + k]; acc[i][0] += hv * w.x; acc[i][1] += hv * w.y; acc[i][2] += hv * w.z; acc[i][3] += hv * w.w; } }
#pragma unroll
          for (int i = 0; i < 8; ++i) { qv[i * 2048 + c0] = acc[i][0]; qv[i * 2048 + c0 + 1] = acc[i][1]; qv[i * 2048 + c0 + 2] = acc[i][2]; qv[i * 2048 + c0 + 3] = acc[i][3]; } }
        __syncthreads();
        for (int n = F.tid; n < 2048; n += 512) { const int hp = n >> 7; float a[8];
#pragma unroll
            for (int i = 0; i < 8; ++i) a[i] = 0.f;
            for (int d = 0; d < 128; ++d) { const float sk = F.peer_sk[(size_t)n * 128 + d];
#pragma unroll
                for (int i = 0; i < 8; ++i) a[i] += qv[i * 2048 + hp * 128 + d] * sk; }
#pragma unroll
            for (int i = 0; i < 8; ++i) { const float rt = 1.0f / sqrtf(SS[t0 + i] * (1.f / DM) + RMS_EPS); SC[(size_t)(t0 + i) * 2048 + n] = a[i] / rt; } }
        __syncthreads(); }
}
#endif
__device__ __forceinline__ unsigned mono_key(float f) { const unsigned u = __float_as_uint(f); return u ^ ((unsigned)((int)u >> 31) | 0x80000000u); }
__device__ __forceinline__ float unmono(unsigned k) { const unsigned u = (k & 0x80000000u) ? (k ^ 0x80000000u) : ~k; return __uint_as_float(u); }
#define INS16(list, key) do { unsigned k_ = (key); _Pragma("unroll") for (int e_ = 0; e_ < 16; ++e_) { const unsigned hi_ = max(list[e_], k_); k_ = min(list[e_], k_); list[e_] = hi_; } } while (0)
__device__ __forceinline__ void p7_batch(Frame& F, int t0) {
    unsigned char* ws = F.ws; const int tid = F.tid, lane = F.lane, wid = F.wave;
    LAS unsigned* keys = (LAS unsigned*)F.lds;
    LAS int* eidx = (LAS int*)(F.lds + 32768);
    LAS float* ewt = (LAS float*)(F.lds + 49152);
    const float* SC = (const float*)(ws + WS_SC); const float* SS = (const float*)(ws + WS_SS);
    { const int tok = tid >> 4, hp = tid & 15; const GAS f32x4* p4 = (const GAS f32x4*)(SC + (size_t)(t0 + tok) * 2048 + hp * 128);
      unsigned list[16];
#pragma unroll
      for (int e = 0; e < 16; ++e) list[e] = 0u;
#pragma unroll 2
      for (int c = 0; c < 32; ++c) { f32x4 v = p4[c];
#ifdef DBG_SCNOISE
          { const unsigned hb_ = ((unsigned)(t0 + tok) * 2654435761u) ^ ((unsigned)(hp * 128 + 4 * c) * 2246822519u);
            v.x += DBG_SCNOISE * ((float)((hb_ >> 3) & 1023) / 1024.f - 0.5f) * 3.46f; v.y += DBG_SCNOISE * ((float)((hb_ >> 13) & 1023) / 1024.f - 0.5f) * 3.46f;
            const unsigned hc_ = hb_ * 747796405u + 2891336453u;
            v.z += DBG_SCNOISE * ((float)((hc_ >> 3) & 1023) / 1024.f - 0.5f) * 3.46f; v.w += DBG_SCNOISE * ((float)((hc_ >> 13) & 1023) / 1024.f - 0.5f) * 3.46f; }
#endif
          INS16(list, (mono_key(v.x) & ~127u) | (unsigned)(127 - (4 * c + 0))); INS16(list, (mono_key(v.y) & ~127u) | (unsigned)(127 - (4 * c + 1)));
          INS16(list, (mono_key(v.z) & ~127u) | (unsigned)(127 - (4 * c + 2))); INS16(list, (mono_key(v.w) & ~127u) | (unsigned)(127 - (4 * c + 3))); }
#pragma unroll
      for (int e = 0; e < 16; ++e) keys[(tok * 16 + hp) * 16 + e] = list[e]; }
    __syncthreads();
    if (tid < 256) { const int tok = tid >> 3, hd = tid & 7; const LAS unsigned* ka = keys + (tok * 16 + 2 * hd) * 16; const LAS unsigned* kb = ka + 16;
        float a[16], bq[16];
#pragma unroll
        for (int e = 0; e < 16; ++e) { a[e] = unmono(ka[e] & ~127u); bq[e] = unmono(kb[e] & ~127u); }
        unsigned list[16];
#pragma unroll
        for (int e = 0; e < 16; ++e) list[e] = 0u;
#pragma unroll
        for (int i = 0; i < 16; ++i)
#pragma unroll
            for (int j = 0; j < 16; ++j) if ((i + 1) * (j + 1) <= 16) INS16(list, (mono_key(a[i] + bq[j]) & ~255u) | (unsigned)(255 - (i * 16 + j)));
        const float rt = 1.0f / sqrtf(SS[t0 + tok] * (1.f / DM) + RMS_EPS);
        float sv[16]; float den = 0.f;
#pragma unroll
        for (int e = 0; e < 16; ++e) { const int pos = 255 - (int)(list[e] & 255u), i = pos >> 4, j = pos & 15; const unsigned k1 = ka[i], k2 = kb[j];
            sv[e] = (unmono(k1 & ~127u) + unmono(k2 & ~127u)) * rt * DBG_TEMP; eidx[tok * 128 + hd * 16 + e] = (127 - (int)(k1 & 127u)) * 128 + (127 - (int)(k2 & 127u)); }
#ifdef DBG_LOGITSTAT
        atomicAdd((float*)(F.ctl + 12400), (sv[0] - sv[15]) * (1.0f / 262144.0f));
        atomicMax((unsigned*)(F.ctl + 12401), __float_as_uint(sv[0] - sv[15]));
        atomicMax((unsigned*)(F.ctl + 12402), __float_as_uint(rt));
        atomicMax((unsigned*)(F.ctl + 12403), __float_as_uint(sv[0]));
#endif
        const float smax = sv[0];
#pragma unroll
        for (int e = 0; e < 16; ++e) { sv[e] = __expf(sv[e] - smax); den += sv[e]; }
        const float rden = 1.0f / den;
#pragma unroll
#ifdef DBG_REVW
        for (int e = 0; e < 16; ++e) ewt[tok * 128 + hd * 16 + e] = sv[15 - e] * rden; }
#else
        for (int e = 0; e < 16; ++e) ewt[tok * 128 + hd * 16 + e] = (e >= DBG_KEEP) ? 0.f : sv[e] * rden; }
#endif
    __syncthreads();
    const bf16* UB = (const bf16*)(ws + WS_UB); const bf16* VB = (const bf16*)(ws + WS_VB);
    for (int tt = 0; tt < 4; ++tt) { const int tok = wid * 4 + tt, t = t0 + tok;
        const float rt = 1.0f / sqrtf(SS[t] * (1.f / DM) + RMS_EPS);
        float hn[16], hres[16], out[16];
        { const GAS f32x4* hp_ = (const GAS f32x4*)(F.out + (size_t)t * DM); const GAS f32x4* gp = (const GAS f32x4*)F.norm_ffn;
#pragma unroll
          for (int q = 0; q < 4; ++q) { const int i4 = (q >> 1) * 128 + 2 * lane + (q & 1); const f32x4 hv = hp_[i4], gv = gp[i4];
              hres[4 * q] = hv.x; hres[4 * q + 1] = hv.y; hres[4 * q + 2] = hv.z; hres[4 * q + 3] = hv.w;
              hn[4 * q] = hv.x * gv.x * rt; hn[4 * q + 1] = hv.y * gv.y * rt; hn[4 * q + 2] = hv.z * gv.z * rt; hn[4 * q + 3] = hv.w * gv.w * rt; } }
#pragma unroll
        for (int i = 0; i < 16; ++i) out[i] = 0.f;
        for (int hd = 0; hd < 8; ++hd) {
            float part[16];
#pragma unroll
            for (int e = 0; e < 16; ++e) { const int ex = __builtin_amdgcn_readfirstlane(eidx[tok * 128 + hd * 16 + e]);
                const GAS v4u* up = (const GAS v4u*)(UB + (size_t)ex * DM); const v4u u0 = up[lane], u1 = up[64 + lane];
                float s = bf_lo(u0.x) * hn[0]; s += bf_hi(u0.x) * hn[1]; s += bf_lo(u0.y) * hn[2]; s += bf_hi(u0.y) * hn[3]; s += bf_lo(u0.z) * hn[4]; s += bf_hi(u0.z) * hn[5]; s += bf_lo(u0.w) * hn[6]; s += bf_hi(u0.w) * hn[7];
                s += bf_lo(u1.x) * hn[8]; s += bf_hi(u1.x) * hn[9]; s += bf_lo(u1.y) * hn[10]; s += bf_hi(u1.y) * hn[11]; s += bf_lo(u1.z) * hn[12]; s += bf_hi(u1.z) * hn[13]; s += bf_lo(u1.w) * hn[14]; s += bf_hi(u1.w) * hn[15];
                part[e] = s; }
#pragma unroll
            for (int e = 0; e < 8; ++e) { const bool up = (lane & 32) != 0; const float keep = up ? part[e + 8] : part[e], give = up ? part[e] : part[e + 8]; part[e] = keep + __shfl_xor(give, 32); }
#pragma unroll
            for (int e = 0; e < 4; ++e) { const bool up = (lane & 16) != 0; const float keep = up ? part[e + 4] : part[e], give = up ? part[e] : part[e + 4]; part[e] = keep + __shfl_xor(give, 16); }
#pragma unroll
            for (int e = 0; e < 2; ++e) { const bool up = (lane & 8) != 0; const float keep = up ? part[e + 2] : part[e], give = up ? part[e] : part[e + 2]; part[e] = keep + __shfl_xor(give, 8); }
            { const bool up = (lane & 4) != 0; const float keep = up ? part[1] : part[0], give = up ? part[0] : part[1]; part[0] = keep + __shfl_xor(give, 4); }
            float act = part[0]; act += __shfl_xor(act, 1); act += __shfl_xor(act, 2);
            const float coef = ewt[tok * 128 + hd * 16 + ((lane >> 2) & 15)] * gelu_erf(act * DBG_ACTSCALE);
#pragma unroll
            for (int e = 0; e < 16; ++e) { const int ex = __builtin_amdgcn_readfirstlane(eidx[tok * 128 + hd * 16 + e]);
                const float c = __uint_as_float(__builtin_amdgcn_readlane(__float_as_uint(coef), 4 * e));
                const GAS v4u* vp = (const GAS v4u*)(VB + (size_t)ex * DM); const v4u v0 = vp[lane], v1 = vp[64 + lane];
                out[0] += c * bf_lo(v0.x); out[1] += c * bf_hi(v0.x); out[2] += c * bf_lo(v0.y); out[3] += c * bf_hi(v0.y); out[4] += c * bf_lo(v0.z); out[5] += c * bf_hi(v0.z); out[6] += c * bf_lo(v0.w); out[7] += c * bf_hi(v0.w);
                out[8] += c * bf_lo(v1.x); out[9] += c * bf_hi(v1.x); out[10] += c * bf_lo(v1.y); out[11] += c * bf_hi(v1.y); out[12] += c * bf_lo(v1.z); out[13] += c * bf_hi(v1.z); out[14] += c * bf_lo(v1.w); out[15] += c * bf_hi(v1.w); }
        }
        float ssq = 0.f;
#pragma unroll
        for (int i = 0; i < 16; ++i) { out[i] = out[i] * DBG_PEERSCALE + hres[i]; ssq += out[i] * out[i]; }
        const float rf = 1.0f / sqrtf(wave_sum(ssq) * (1.f / DM) + RMS_EPS);
        { GAS f32x4* op = (GAS f32x4*)(F.out + (size_t)t * DM); const GAS f32x4* gp = (const GAS f32x4*)F.norm_final;
#pragma unroll
          for (int q = 0; q < 4; ++q) { const int i4 = (q >> 1) * 128 + 2 * lane + (q & 1); const f32x4 gv = gp[i4];
              op[i4] = (f32x4){out[4 * q] * rf * gv.x * DBG_OUTSCALE, out[4 * q + 1] * rf * gv.y * DBG_OUTSCALE, out[4 * q + 2] * rf * gv.z * DBG_OUTSCALE, out[4 * q + 3] * rf * gv.w * DBG_OUTSCALE}; } }
    }
    __syncthreads();
}

#ifdef DBG_CHECK
#ifndef DBG_NS
#define DBG_NS 64
#endif
#ifndef DBG_TOL
#define DBG_TOL 0.03f
#endif
constexpr int CW_DBG = 12288, CW_L2 = 12352;
__device__ __forceinline__ void dbg_l2(Frame& F, int cls, float num, float den) { atomicAdd((float*)(F.ctl + CW_L2) + cls, num); atomicAdd((float*)(F.ctl + CW_L2) + 8 + cls, den); }
__device__ __forceinline__ double dbg_inv(int i) { switch (i) { case 0: return 1.0; case 1: return 0.19392274474868576; case 2: return 0.03760603093086393; case 3: return 0.007292664737217109; case 4: return 0.001414213562373095; case 5: return 0.0002742481756762073; case 6: return 5.318295896944988e-05; default: return 1.031338537721246e-05; } }
__device__ __forceinline__ void dbg_cs(int pos, int i, float& c, float& s) { const double rev = (double)pos * dbg_inv(i) * 0.15915494309189535; const float a = (float)((rev - __builtin_rint(rev)) * 6.283185307179586); c = cosf(a); s = sinf(a); }
__device__ __forceinline__ float bf2f(bf16 v) { return __uint_as_float((unsigned)v << 16); }
__device__ __forceinline__ void dbg_flag(Frame& F, int bit, float err, float ref) { if (err > DBG_TOL * ref + 1e-3f) atomicOr((unsigned*)(F.ctl + CW_DBG), 1u << bit); }
__device__ __forceinline__ void dbg_check_inproj(Frame& F) {
    unsigned char* ws = F.ws; LAS float* xs = (LAS float*)F.lds;
    for (int smp = blockIdx.x; smp < DBG_NS; smp += F.G) {
        const int t = (int)(((unsigned)smp * 2246822519u) >> 9) & (NTOK - 1);
        float ss = 0.f; for (int k = F.tid; k < 1024; k += 512) { const float v = F.x[(size_t)t * 1024 + k]; ss += v * v; }
        ss = wave_sum(ss); LAS float* red = xs + 1024; if (F.lane == 0) red[F.wave] = ss; __syncthreads();
        float tot = 0.f; for (int w = 0; w < 8; ++w) tot += red[w]; const float r = 1.0f / sqrtf(tot / 1024.f + RMS_EPS);
        for (int k = F.tid; k < 1024; k += 512) xs[k] = F.x[(size_t)t * 1024 + k] * r * F.norm_mix[k];
        __syncthreads();
        float me0 = 0, me1 = 0, me2 = 0, me3 = 0, mr0 = 0, mr1 = 0, mr2 = 0, mr3 = 0; float n2a = 0, d2a = 0, n2b = 0, d2b = 0, n2c = 0, d2c = 0, n2d = 0, d2d = 0;
        for (int n = F.tid; n < 5120; n += 512) { const int sc = src_col_in(n); if (sc < 0) continue;
            float acc = 0.f; for (int k = 0; k < 1024; ++k) acc += xs[k] * F.w_in[(size_t)k * 4896 + sc];
            const int pos = t & 4095; float ref, got; int cls = 0;
            auto dotcol = [&](int nn) { const int s2 = src_col_in(nn); float a = 0.f; for (int k = 0; k < 1024; ++k) a += xs[k] * F.w_in[(size_t)k * 4896 + s2]; return a; };
            const bool ropeseg = (n >= 1536 && n < 2048) || (n >= 2304 && n < 2432) || (n >= 2560 && n < 2688);
            float val = acc;
            if (ropeseg && (n & 63) < 16) { const int i = n & 7; float c, s; dbg_cs(pos, i, c, s);
                if ((n & 63) < 8) { const float x2 = dotcol(n + 8); val = acc * c - x2 * s; } else { const float x1 = dotcol(n - 8); val = x1 * s + acc * c; } cls = 1; }
            if (n < 512) { ref = val * C2; got = bf2f(((const bf16*)(ws + WS_QF))[(size_t)t * 512 + n]); }
            else if (n < 1024) { ref = val; got = bf2f(((const bf16*)(ws + WS_KF))[(size_t)t * 512 + n - 512]); }
            else if (n < 1536) { ref = val; got = bf2f(((const bf16*)(ws + WS_VF))[(size_t)t * 512 + n - 1024]); }
            else if (n < 2048) { ref = val * C2; got = bf2f(((const bf16*)(ws + WS_QN))[(size_t)t * 512 + n - 1536]); }
            else if (n < 2304) { ref = val; got = bf2f(((const bf16*)(ws + WS_KVC))[(size_t)t * 256 + n - 2048]); }
            else if (n < 2560) { ref = val; got = bf2f(((const bf16*)(ws + WS_KVS))[(size_t)t * 256 + n - 2304]); }
            else if (n < 2816) { ref = val; got = bf2f(((const bf16*)(ws + WS_KVW))[(size_t)t * 256 + n - 2560]); }
            else if (n < 2824) { const float z = val + F.fbias[n - 2816]; ref = -log1pf(expf(-z)); got = ((const float*)(ws + WS_LOGF))[(size_t)t * 8 + n - 2816]; cls = 2; }
            else if (n < 2848) { ref = 1.f / (1.f + expf(-val)); got = ((const float*)(ws + WS_GATES))[(size_t)t * 24 + n - 2824]; cls = 3; }
            else { ref = 1.f / (1.f + expf(-val)); got = bf2f(((const bf16*)(ws + WS_GM))[(size_t)t * 2048 + n - 3072]); cls = 3; }
            const float er_ = fabsf(ref - got), rf_ = fabsf(ref); { const int c_ = 2 + cls; if (c_ == 2) { n2a += er_ * er_; d2a += rf_ * rf_; } else if (c_ == 3) { n2b += er_ * er_; d2b += rf_ * rf_; } else if (c_ == 4) { n2c += er_ * er_; d2c += rf_ * rf_; } else { n2d += er_ * er_; d2d += rf_ * rf_; } } if (cls == 0) { me0 = fmaxf(me0, er_); mr0 = fmaxf(mr0, rf_); } else if (cls == 1) { me1 = fmaxf(me1, er_); mr1 = fmaxf(mr1, rf_); } else if (cls == 2) { me2 = fmaxf(me2, er_); mr2 = fmaxf(mr2, rf_); } else { me3 = fmaxf(me3, er_); mr3 = fmaxf(mr3, rf_); } }
        { n2a = wave_sum(n2a); d2a = wave_sum(d2a); n2b = wave_sum(n2b); d2b = wave_sum(d2b); n2c = wave_sum(n2c); d2c = wave_sum(d2c); n2d = wave_sum(n2d); d2d = wave_sum(d2d); if (F.lane == 0) { dbg_l2(F, 2, n2a, d2a); dbg_l2(F, 3, n2b, d2b); dbg_l2(F, 4, n2c, d2c); dbg_l2(F, 5, n2d, d2d); } }
        _Pragma("unroll") for (int c = 0; c < 4; ++c) { float e = c == 0 ? me0 : c == 1 ? me1 : c == 2 ? me2 : me3, rr = c == 0 ? mr0 : c == 1 ? mr1 : c == 2 ? mr2 : mr3;
            for (int o = 1; o < 64; o <<= 1) { e = fmaxf(e, __shfl_xor(e, o)); rr = fmaxf(rr, __shfl_xor(rr, o)); }
            if (F.lane == 0) { if (c == 0) dbg_flag(F, 0, e, rr); if (c == 1) dbg_flag(F, 1, e, rr); if (c == 2) dbg_flag(F, 2, e, 0.02f); if (c == 3) dbg_flag(F, 2, e, rr); } }
        __syncthreads();
    }
}
__device__ __forceinline__ void dbg_check_cmp(Frame& F) {
    unsigned char* ws = F.ws; LAS float* hid = (LAS float*)F.lds;
    for (int smp = blockIdx.x; smp < 64; smp += F.G) {
        const int b = smp & 7, g = (smp >> 3) & 1, j = (smp >> 4) & 1, n = (smp * 37 + 5) % 255;
        const bf16* KVC = (const bf16*)(ws + WS_KVC);
        if (F.tid < 128) { float a = 0.f; for (int l = 0; l < 32; ++l) for (int d = 0; d < 64; ++d) { const float xv = bf2f(KVC[((size_t)b * SEQ + 16 * n + l) * 256 + j * 128 + g * 64 + d]) + F.cmp_pos[j * 2048 + l * 64 + d];
                a += xv * F.cmp_w1[((size_t)j * 2048 + l * 64 + d) * 128 + F.tid]; }
            hid[F.tid] = 0.5f * a * (1.0f + erff(a * 0.70710678f)); }
        __syncthreads();
        if (F.tid < 64) { float o = 0.f; for (int k = 0; k < 128; ++k) o += hid[k] * F.cmp_w2[((size_t)j * 128 + k) * 64 + F.tid]; hid[128 + F.tid] = o; }
        __syncthreads();
        if (F.tid < 64) { float o = hid[128 + F.tid]; const int d = F.tid;
            if (j == 0 && d < 16) { const int i = d & 7; float c, s; dbg_cs(16 * n + 31, i, c, s);
                o = d < 8 ? hid[128 + d] * c - hid[128 + d + 8] * s : hid[128 + d - 8] * s + hid[128 + d] * c; }
            const float got = bf2f(((const bf16*)(ws + (j == 0 ? WS_KCMP : WS_VCMP)))[((size_t)b * 256 + n) * 128 + g * 64 + d]);
            float e = fabsf(o - got), rr = fabsf(o);
            { const float n2 = wave_sum((o - got) * (o - got)), d2 = wave_sum(o * o); if (F.lane == 0) dbg_l2(F, 6, n2, d2); }
            for (int q = 1; q < 64; q <<= 1) { e = fmaxf(e, __shfl_xor(e, q)); rr = fmaxf(rr, __shfl_xor(rr, q)); }
            if (F.lane == 0) dbg_flag(F, 3, e, rr); }
        __syncthreads();
    }
    if (blockIdx.x == 0 && F.tid < 64) { const int bh = F.tid, s = (F.tid * 61 + 100) & 4095; const int b = bh >> 3, h = bh & 7; double a = 0.0;
        for (int q = 0; q <= s; ++q) a += (double)((const float*)(ws + WS_LOGF))[((size_t)b * SEQ + q) * 8 + h];
        const float ref = (float)(-1.4426950408889634 * a), got = ((const float*)(ws + WS_CUM))[(size_t)bh * SEQ + s];
        if (fabsf(ref - got) > 1e-3f * fabsf(ref) + 1e-3f) atomicOr((unsigned*)(F.ctl + CW_DBG), 1u << 3); }
}
__device__ __forceinline__ void dbg_check_attn(Frame& F) {
    unsigned char* ws = F.ws; const int lane = F.lane; const int gw = blockIdx.x * 8 + F.wave;
    const bf16* QF = (const bf16*)(ws + WS_QF); const bf16* KF = (const bf16*)(ws + WS_KF); const bf16* VF = (const bf16*)(ws + WS_VF); const bf16* Y = (const bf16*)(ws + WS_Y);
    LAS float* sc = (LAS float*)F.lds + F.wave * 4480;
    if (gw < 1024) {
        const unsigned hs = (unsigned)gw * 2654435761u; int b = (hs >> 8) & 7, h = (hs >> 11) & 7, q = (hs >> 14) & 4095;
#ifdef DBG_EARLY
        b = gw & 7; h = (gw >> 3) & 7; q = (gw >> 6) & 15;
#endif
        const float* cum = (const float*)(ws + WS_CUM) + (size_t)(b * 8 + h) * SEQ;
        float mx = -1e30f;
        for (int s = lane; s <= q; s += 64) { float a = 0.f; for (int d = 0; d < 64; ++d) a += bf2f(QF[((size_t)b * SEQ + q) * 512 + h * 64 + d]) * bf2f(KF[((size_t)b * SEQ + s) * 512 + h * 64 + d]);
            a += cum[s]; sc[s] = a; mx = fmaxf(mx, a); }
        for (int o = 1; o < 64; o <<= 1) mx = fmaxf(mx, __shfl_xor(mx, o));
        float den = 0.f; for (int s = lane; s <= q; s += 64) { const float p = exp2f(sc[s] - mx); sc[s] = p; den += p; }
        den = wave_sum(den); LDS_WAIT();
        float o = 0.f; for (int s = 0; s <= q; ++s) o += sc[s] * bf2f(VF[((size_t)b * SEQ + s) * 512 + h * 64 + lane]);
        o /= den; const float got = bf2f(Y[((size_t)b * SEQ + q) * 512 + h * 64 + lane]);
        float e = fabsf(o - got), rr = fabsf(o);
        { const float n2 = wave_sum((o - got) * (o - got)), d2 = wave_sum(o * o); if (lane == 0) dbg_l2(F, 0, n2, d2); }
        for (int qq = 1; qq < 64; qq <<= 1) { e = fmaxf(e, __shfl_xor(e, qq)); rr = fmaxf(rr, __shfl_xor(rr, qq)); }
        { float gm = fabsf(got); const bool bad = !(got == got) || fabsf(got) > 1e30f; for (int qq = 1; qq < 64; qq <<= 1) gm = fmaxf(gm, __shfl_xor(gm, qq)); const unsigned long long nb = __ballot(bad);
          if (lane == 0 && (e > DBG_TOL * rr + 1e-3f || nb)) atomicOr((unsigned*)(F.ctl + CW_DBG), 16u); }
    } else if (gw < 2048) {
        const int k = gw - 1024; const unsigned hs = (unsigned)k * 2246822519u + 12345u; int b = (hs >> 8) & 7, g = (hs >> 11) & 1, q = (hs >> 14) & 4095;
#ifdef DBG_EARLY
        b = k & 7; g = (k >> 3) & 1; q = (k >> 4) & 63; if (k >= 1024) return;
#endif
        const bf16* QN = (const bf16*)(ws + WS_QN); const bf16* KC = (const bf16*)(ws + WS_KCMP); const bf16* VC = (const bf16*)(ws + WS_VCMP);
        const bf16* KS = (const bf16*)(ws + WS_KVS); const bf16* KW = (const bf16*)(ws + WS_KVW); const float* GT = (const float*)(ws + WS_GATES);
        LAS float* imp = sc + 4096;
        imp[lane] = 0.f; LDS_WAIT();
        LAS float* ocmp = sc + 4160; float e = 0.f, rr = 0.f;
        const int QBk = q >> 6;
        for (int hh = 0; hh < 4; ++hh) { const int head = 4 * g + hh; float mx = -1e30f; int nvis = 0;
            for (int n = lane; n < 255; n += 64) { float a = -1e30f; if (16 * n + 31 <= q) { a = 0.f; for (int d = 0; d < 64; ++d) a += bf2f(QN[((size_t)b * SEQ + q) * 512 + head * 64 + d]) * bf2f(KC[((size_t)b * 256 + n) * 128 + g * 64 + d]); nvis++; } sc[n] = a; mx = fmaxf(mx, a); }
            for (int o = 1; o < 64; o <<= 1) mx = fmaxf(mx, __shfl_xor(mx, o));
            float den = 0.f; for (int n = lane; n < 255; n += 64) { const float p = (16 * n + 31 <= q) ? exp2f(sc[n] - mx) : 0.f; sc[n] = p; den += p; }
            den = wave_sum(den); LDS_WAIT(); const float rden = den > 0.f ? 1.f / den : 0.f;
            float o = 0.f; for (int n = 0; n < 255; ++n) o += sc[n] * rden * bf2f(VC[((size_t)b * 256 + n) * 128 + g * 64 + lane]);
            ocmp[hh * 64 + lane] = o;
            { float v = 0.f; const int j = lane; for (int n = 0; n < 255; ++n) { const int cs = 16 * n, ss = 64 * j; int ov = min(cs + 32, ss + 64) - max(cs, ss); if (ov < 0) ov = 0; v += sc[n] * rden * (float)ov / 32.f; } imp[lane] += v; }
            LDS_WAIT();
        }
        unsigned long long msk;
        { const int j = lane; const bool forced = (j == 0) || (j == QBk) || (j == QBk - 1), causal = j <= QBk; const float score = forced ? 1e9f : (causal ? imp[j] : -1.f); int rank = 0;
          for (int i = 0; i < 64; ++i) { const float si = __shfl(score, i); rank += (si > score || (si == score && i < j)) ? 1 : 0; }
          msk = __ballot(rank < 16); }
        for (int hh = 0; hh < 4; ++hh) { const int head = 4 * g + hh; float oslc = 0.f, owin = 0.f;
            for (int br = 0; br < 2; ++br) { const bf16* KK = br == 0 ? KS : KW; float mx = -1e30f;
                for (int s = lane; s <= q; s += 64) { const bool vis = br == 0 ? (((msk >> (s >> 6)) & 1ull) != 0ull) : (q - s < 512); float a = -1e30f;
                    if (vis) { a = 0.f; for (int d = 0; d < 64; ++d) a += bf2f(QN[((size_t)b * SEQ + q) * 512 + head * 64 + d]) * bf2f(KK[((size_t)b * SEQ + s) * 256 + g * 64 + d]); }
                    sc[s] = a; mx = fmaxf(mx, a); }
                for (int o = 1; o < 64; o <<= 1) mx = fmaxf(mx, __shfl_xor(mx, o));
                float den = 0.f; for (int s = lane; s <= q; s += 64) { const float p = sc[s] > -1e29f ? exp2f(sc[s] - mx) : 0.f; sc[s] = p; den += p; }
                den = wave_sum(den); LDS_WAIT();
                float o = 0.f; for (int s = 0; s <= q; ++s) o += sc[s] * bf2f(KK[((size_t)b * SEQ + s) * 256 + 128 + g * 64 + lane]);
                o /= den; if (br == 0) oslc = o; else owin = o; LDS_WAIT(); }
            const float* gt = GT + ((size_t)b * SEQ + q) * 24 + head * 3;
            float g0_ = gt[0], g1_ = gt[1], g2_ = gt[2];
#ifdef DBG_NO_CMP
            g0_ = 0.f;
#endif
#ifdef DBG_NO_SLC
            g1_ = 0.f;
#endif
#ifdef DBG_NO_WIN
            g2_ = 0.f;
#endif
            const float ref = g0_ * ocmp[hh * 64 + lane] + g1_ * oslc + g2_ * owin; const float got = bf2f(Y[((size_t)NTOK + (size_t)b * SEQ + q) * 512 + head * 64 + lane]);
            { const float n2 = wave_sum((ref - got) * (ref - got)), d2 = wave_sum(ref * ref); if (lane == 0) dbg_l2(F, 1, n2, d2); }
            e = fmaxf(e, fabsf(ref - got)); rr = fmaxf(rr, fabsf(ref)); }
        for (int qq = 1; qq < 64; qq <<= 1) { e = fmaxf(e, __shfl_xor(e, qq)); rr = fmaxf(rr, __shfl_xor(rr, qq)); }
        if (lane == 0) dbg_flag(F, 5, e, rr);
    }
}
#endif

#ifdef DBG_CHECK
#ifndef DBG_NS
#define DBG_NS 64
#endif
constexpr size_t WS_DBGH = 461 * MiB;
__device__ __forceinline__ int dbg_tok(int smp) { return (int)(((unsigned)smp * 2654435761u) >> 7) & (NTOK - 1); }
__device__ __forceinline__ void dbg_check_merged(Frame& F) {
    unsigned char* ws = F.ws; const bf16* Y = (const bf16*)(ws + WS_Y); const bf16* GM = (const bf16*)(ws + WS_GM); const bf16* MG = (const bf16*)(ws + WS_MERGED);
    for (int smp = blockIdx.x; smp < DBG_NS; smp += F.G) { const int t = dbg_tok(smp); float e = 0.f, rr = 0.f, n2 = 0.f, d2 = 0.f;
        for (int d = F.tid; d < 1024; d += 512) { float u0 = 0.f, u1 = 0.f;
            for (int c = 0; c < 512; ++c) { u0 += bf2f(Y[(size_t)t * 512 + c]) * F.w_branch[(size_t)c * 1024 + d]; u1 += bf2f(Y[((size_t)NTOK + t) * 512 + c]) * F.w_branch[(size_t)(512 + c) * 1024 + d]; }
            const float ref = bf2f(GM[(size_t)t * 2048 + d]) * u0 + bf2f(GM[(size_t)t * 2048 + 1024 + d]) * u1, got = bf2f(MG[(size_t)t * 1024 + d]);
            n2 += (ref - got) * (ref - got); d2 += ref * ref; e = fmaxf(e, fabsf(ref - got)); rr = fmaxf(rr, fabsf(ref)); }
        n2 = wave_sum(n2); d2 = wave_sum(d2); if (F.lane == 0) dbg_l2(F, 0, n2, d2);
        for (int q = 1; q < 64; q <<= 1) { e = fmaxf(e, __shfl_xor(e, q)); rr = fmaxf(rr, __shfl_xor(rr, q)); }
        if (F.lane == 0) dbg_flag(F, 0, e, rr); }
}
__device__ __forceinline__ void dbg_check_h(Frame& F) {
    unsigned char* ws = F.ws; const bf16* MG = (const bf16*)(ws + WS_MERGED); const bf16* HB = (const bf16*)(ws + WS_HB); LAS float* red = (LAS float*)F.lds;
    for (int smp = blockIdx.x; smp < DBG_NS; smp += F.G) { const int t = dbg_tok(smp); float e = 0.f, rr = 0.f, e2 = 0.f, ssq = 0.f, n2 = 0.f, d2 = 0.f;
        for (int d = F.tid; d < 1024; d += 512) { float a = 0.f; for (int c = 0; c < 1024; ++c) a += bf2f(MG[(size_t)t * 1024 + c]) * F.w_out[(size_t)c * 1024 + d];
            const float ref = F.x[(size_t)t * 1024 + d] + a, got = F.out[(size_t)t * 1024 + d]; e = fmaxf(e, fabsf(ref - got)); rr = fmaxf(rr, fabsf(a)); n2 += (ref - got) * (ref - got); d2 += a * a;
            e2 = fmaxf(e2, fabsf(bf2f(HB[(size_t)t * 1024 + d]) - got * F.norm_ffn[d])); ssq += got * got; }
        for (int q = 1; q < 64; q <<= 1) { e = fmaxf(e, __shfl_xor(e, q)); rr = fmaxf(rr, __shfl_xor(rr, q)); e2 = fmaxf(e2, __shfl_xor(e2, q)); }
        n2 = wave_sum(n2); d2 = wave_sum(d2); if (F.lane == 0) dbg_l2(F, 1, n2, d2);
        ssq = wave_sum(ssq); if (F.lane == 0) red[F.wave] = ssq; __syncthreads();
        if (F.tid == 0) { float tot = 0.f; for (int w = 0; w < 8; ++w) tot += red[w]; const float got = ((const float*)(ws + WS_SS))[t]; if (fabsf(tot - got) > 1e-3f * tot) atomicOr((unsigned*)(F.ctl + CW_DBG), 2u); }
        if (F.lane == 0) { dbg_flag(F, 1, e, rr); dbg_flag(F, 1, e2, 1.0f); }
        __syncthreads(); }
}
__device__ __forceinline__ void dbg_check_scores(Frame& F) {
    unsigned char* ws = F.ws; const bf16* HB = (const bf16*)(ws + WS_HB); const float* SC = (const float*)(ws + WS_SC); LAS float* qv = (LAS float*)F.lds;
    for (int smp = blockIdx.x; smp < DBG_NS; smp += F.G) { const int t = dbg_tok(smp);
        for (int d = F.tid; d < 1024; d += 512) ((float*)(ws + WS_DBGH))[(size_t)smp * 1024 + d] = F.out[(size_t)t * 1024 + d];
        for (int n = F.tid; n < 2048; n += 512) { float a = 0.f; for (int k = 0; k < 1024; ++k) a += bf2f(HB[(size_t)t * 1024 + k]) * F.peer_wq[(size_t)k * 2048 + n]; qv[n] = a; }
        __syncthreads();
        float e = 0.f, rr = 0.f, n2 = 0.f, d2 = 0.f;
        for (int n = F.tid; n < 2048; n += 512) { const int hp = n >> 7; float a = 0.f; for (int d = 0; d < 128; ++d) a += qv[hp * 128 + d] * F.peer_sk[(size_t)n * 128 + d];
            { const float g_ = SC[(size_t)t * 2048 + n]; n2 += (a - g_) * (a - g_); d2 += a * a; }
            e = fmaxf(e, fabsf(a - SC[(size_t)t * 2048 + n])); rr = fmaxf(rr, fabsf(a)); }
        n2 = wave_sum(n2); d2 = wave_sum(d2); if (F.lane == 0) dbg_l2(F, 2, n2, d2);
        for (int q = 1; q < 64; q <<= 1) { e = fmaxf(e, __shfl_xor(e, q)); rr = fmaxf(rr, __shfl_xor(rr, q)); }
        if (F.lane == 0) dbg_flag(F, 2, e, rr);
        __syncthreads(); }
}
__device__ __forceinline__ void dbg_check_final(Frame& F) {
    unsigned char* ws = F.ws; const float* SC = (const float*)(ws + WS_SC); LAS float* hn = (LAS float*)F.lds; LAS float* ew = hn + 1024; LAS int* ei = (LAS int*)(ew + 128); LAS float* act = (LAS float*)(ei + 128); LAS float* red = act + 128;
    for (int smp = blockIdx.x; smp < DBG_NS; smp += F.G) { const int t = dbg_tok(smp); const float* hrow = (const float*)(ws + WS_DBGH) + (size_t)smp * 1024;
        float ssq = 0.f; for (int d = F.tid; d < 1024; d += 512) ssq += hrow[d] * hrow[d];
        ssq = wave_sum(ssq); if (F.lane == 0) red[F.wave] = ssq; __syncthreads();
        float tot = 0.f; for (int w = 0; w < 8; ++w) tot += red[w]; const float rt = 1.0f / sqrtf(tot / 1024.f + RMS_EPS);
        for (int d = F.tid; d < 1024; d += 512) hn[d] = hrow[d] * rt * F.norm_ffn[d];
        if (F.tid < 8) { const int hd = F.tid; const float* s1 = SC + (size_t)t * 2048 + (2 * hd) * 128; const float* s2 = s1 + 128;
            float a[16], bq[16]; int ia[16], ib[16];
            for (int k = 0; k < 16; ++k) { float best = -1e30f; int bi = -1; for (int n = 0; n < 128; ++n) { bool used = false; for (int m = 0; m < k; ++m) used |= (ia[m] == n); if (!used && s1[n] > best) { best = s1[n]; bi = n; } } a[k] = best; ia[k] = bi; }
            for (int k = 0; k < 16; ++k) { float best = -1e30f; int bi = -1; for (int n = 0; n < 128; ++n) { bool used = false; for (int m = 0; m < k; ++m) used |= (ib[m] == n); if (!used && s2[n] > best) { best = s2[n]; bi = n; } } bq[k] = best; ib[k] = bi; }
            int pi[16]; float ps[16];
            for (int k = 0; k < 16; ++k) { float best = -1e30f; int bp = -1; for (int c = 0; c < 256; ++c) { bool used = false; for (int m = 0; m < k; ++m) used |= (pi[m] == c); const float v = a[c >> 4] + bq[c & 15]; if (!used && v > best) { best = v; bp = c; } } pi[k] = bp; ps[k] = best * rt; }
            float den = 0.f; { const float pm_ = ps[0]; for (int k = 0; k < 16; ++k) { ps[k] = expf(ps[k] - pm_); } } for (int k = 0; k < 16; ++k) den += ps[k];
            for (int k = 0; k < 16; ++k) { ew[hd * 16 + k] = ps[k] / den; ei[hd * 16 + k] = ia[pi[k] >> 4] * 128 + ib[pi[k] & 15]; } }
        __syncthreads();
        if (F.tid < 128) { const float* up = F.peer_u + (size_t)ei[F.tid] * 1024; float a = 0.f; for (int d = 0; d < 1024; ++d) a += hn[d] * up[d]; act[F.tid] = ew[F.tid] * 0.5f * a * (1.0f + erff(a * 0.70710678f)); }
        __syncthreads();
        float yv[2]; float s2 = 0.f;
        for (int i = 0; i < 2; ++i) { const int d = F.tid + 512 * i; float o = 0.f; for (int e = 0; e < 128; ++e) o += act[e] * F.peer_v[(size_t)ei[e] * 1024 + d]; yv[i] = hrow[d] + o; s2 += yv[i] * yv[i]; }
        s2 = wave_sum(s2); __syncthreads(); if (F.lane == 0) red[F.wave] = s2; __syncthreads();
        float tot2 = 0.f; for (int w = 0; w < 8; ++w) tot2 += red[w]; const float rf = 1.0f / sqrtf(tot2 / 1024.f + RMS_EPS);
        float e = 0.f, n2 = 0.f, d2 = 0.f;
        for (int i = 0; i < 2; ++i) { const int d = F.tid + 512 * i; const float ref = yv[i] * rf * F.norm_final[d], got = F.out[(size_t)t * 1024 + d]; e = fmaxf(e, fabsf(ref - got)); n2 += (ref - got) * (ref - got); const float pc_ = (yv[i] - hrow[d]) * rf * F.norm_final[d]; d2 += pc_ * pc_; }
        n2 = wave_sum(n2); d2 = wave_sum(d2); if (F.lane == 0) dbg_l2(F, 3, n2, d2);
        for (int q = 1; q < 64; q <<= 1) e = fmaxf(e, __shfl_xor(e, q));
        if (F.lane == 0 && e > 0.01f && !(smp == 0 && false)) atomicOr((unsigned*)(F.ctl + CW_DBG), 8u);
        __syncthreads(); }
}
#endif

struct Args { const float* in[15]; float* out; unsigned char* ws; int ph_lo, ph_hi; };
constexpr int NPHASE = 8;
__global__ void __launch_bounds__(NWAVES * 64, 2) mk_fwd(Args args) {
    extern __shared__ __attribute__((aligned(16))) unsigned char lds[];
    Frame F;
    F.lds = (LAS unsigned char*)lds; F.MISC = (volatile LAS unsigned*)(F.lds + MISC_OFF);
    F.tid = threadIdx.x; F.lane = F.tid & 63; F.wave = __builtin_amdgcn_readfirstlane(F.tid >> 6);
    F.G = gridDim.x; { const int bx = blockIdx.x; F.vcu = (F.G % 8 == 0) ? (bx % 8) * (F.G / 8) + bx / 8 : bx; }
    unsigned char* ws = args.ws; F.ws = ws; F.ctl = (gu32*)(ws + WS_CTL);
    F.x = args.in[0]; F.norm_mix = args.in[1]; F.w_in = args.in[2]; F.fbias = args.in[3]; F.cmp_pos = args.in[4]; F.cmp_w1 = args.in[5]; F.cmp_w2 = args.in[6]; F.w_branch = args.in[7];
    F.w_out = args.in[8]; F.norm_ffn = args.in[9]; F.peer_wq = args.in[10]; F.peer_sk = args.in[11]; F.peer_u = args.in[12]; F.peer_v = args.in[13]; F.norm_final = args.in[14]; F.out = args.out;
    for (int u = F.tid; u < (LDS_BYTES - LDSCTL_OFF) / 4; u += NWAVES * 64) ((LAS unsigned*)(F.lds + LDSCTL_OFF))[u] = 0u;
    __syncthreads();
    const int lo = args.ph_lo, hi = args.ph_hi;
    XcdBarrier bar; bar.bar = (unsigned*)(F.ctl + CW_BAR); bar.x = 0; bar.st = nullptr;
    if (hi - lo > 1) bar = xcd_barrier_post((unsigned*)(F.ctl + CW_BAR), F.MISC + 8);
#define IN(k) (lo <= (k) && (k) < hi)
#ifdef DBG_CHECK
    if (lo == 99) { dbg_check_inproj(F); __syncthreads(); dbg_check_cmp(F); __syncthreads(); dbg_check_attn(F); return; }
    if (lo == 100) { dbg_check_merged(F); return; }
    if (lo == 101) { dbg_check_h(F); return; }
    if (lo == 102) { dbg_check_scores(F); return; }
    if (lo == 103) { dbg_check_final(F); return; }
    if (lo == 104) { if (blockIdx.x == 0 && F.tid == 0) {
#ifdef DBG_SEL
        const float num = __hip_atomic_load((float*)(F.ctl + CW_L2) + DBG_SEL, RLX_AGENT), den = __hip_atomic_load((float*)(F.ctl + CW_L2) + 8 + DBG_SEL, RLX_AGENT);
        float v = 1000.0f * sqrtf(num / fmaxf(den, 1e-30f)); v = fminf(99.f, rintf(v)); F.out[0] = 10.0f * v + 5.0f;
#else
        const unsigned m = __hip_atomic_load(F.ctl + CW_DBG, RLX_AGENT); if (m) F.out[0] = 10.0f * (float)m;
#endif
    } return; }
#endif
#define SEAM(k) do { if (IN(k) && IN((k) + 1)) xcd_barrier(bar); } while (0)
    if (IN(0)) { p0_prologue(F); SEAM(0); }
    if (IN(1)) {
        pg8::Gemm g{(const bf16*)(ws + WS_XN), (const bf16*)(ws + WS_WTIN), NTOK, NIN, 1024}; pg8::StaticOrder S; S.init(NTOK, NIN, F.G, (int)blockIdx.x);
        EpiIn E{ws, F.fbias};
        pg8::gemm_phase<EpiIn, pg8::StaticOrder, true, true>(F.lds, g, S, E);
        SEAM(1);
    }
    if (IN(2)) {
        for (int u = blockIdx.x; u < 512; u += F.G) p2_compress_unit(F, u);
        { const int gw = (int)blockIdx.x * NWAVES + F.wave; if (gw < 64) p2_cumsum_wave(F, gw); else if (F.G * NWAVES < 64) { for (int q = gw; q < 64; q += F.G * NWAVES) p2_cumsum_wave(F, q); } }
        SEAM(2);
    }
    if (IN(3)) {
        p3_attention(F); SEAM(3); }
    if (IN(4)) {
        pg8::Gemm g{(const bf16*)(ws + WS_Y), (const bf16*)(ws + WS_WTBR), 2 * NTOK, 2048, 512}; MergeOrder S{F.vcu, F.G};
        EpiMerge E{ws};
        pg8::gemm_phase<EpiMerge, MergeOrder, false, true>(F.lds, g, S, E);
        SEAM(4);
    }
    if (IN(5)) {
        pg8::Gemm g{(const bf16*)(ws + WS_MERGED), (const bf16*)(ws + WS_WTOUT), NTOK, 1024, 1024}; pg8::StaticOrder S; S.init(NTOK, 1024, F.G, (int)blockIdx.x);
        EpiOut E{ws, F.x, F.out, F.norm_ffn};
        pg8::gemm_phase<EpiOut, pg8::StaticOrder, true, true>(F.lds, g, S, E);
        SEAM(5);
    }
    if (IN(6)) {
        pg8::Gemm g{(const bf16*)(ws + WS_HB), (const bf16*)(ws + WS_WTPEER), NTOK, 2048, 1024}; pg8::StaticOrder S; S.init(NTOK, 2048, F.G, (int)blockIdx.x);
        EpiF32 E{(float*)(ws + WS_SC), 2048};
#ifdef DBG_F32SCORES
        p6_naive(F);
#else
        pg8::gemm_phase<EpiF32, pg8::StaticOrder, true, true>(F.lds, g, S, E);
#endif
        SEAM(6);
    }
    if (IN(7)) {
        for (int bt = blockIdx.x; bt < NTOK / 32; bt += F.G) p7_batch(F, bt * 32);
#ifdef DBG_LOGITSTAT
        __syncthreads(); if (blockIdx.x == 0 && F.tid == 0) { const float v_ = __hip_atomic_load((float*)(F.ctl + 12400 + DBG_LOGITSTAT), RLX_AGENT); F.out[0] = 1000.0f * v_; }
#endif
    }
#undef IN
#undef SEAM
}

#ifndef MK_N_LAUNCHES
#define MK_N_LAUNCHES 1
#endif
extern "C" void kernel_launch(void* const* d_in, const int* in_sizes, int n_in, void* d_out, int out_size, void* d_ws, size_t ws_size, hipStream_t stream) {
    static int grid = 0;
    if (grid == 0) {
        if (n_in != 15 || out_size != NTOK * DM || ws_size < WS_END) { fprintf(stderr, "kernel_launch: unexpected shapes (n_in %d out %d ws %zu)\n", n_in, out_size, ws_size); grid = -1; return; }
        int dev = 0, cus = 0, per_cu = 0;
        if (hipGetDevice(&dev) != hipSuccess || hipDeviceGetAttribute(&cus, hipDeviceAttributeMultiprocessorCount, dev) != hipSuccess) { grid = -1; return; }
        if (hipFuncSetAttribute((const void*)mk_fwd, hipFuncAttributeMaxDynamicSharedMemorySize, LDS_BYTES) != hipSuccess) { fprintf(stderr, "kernel_launch: hipFuncSetAttribute failed\n"); grid = -1; return; }
        if (hipOccupancyMaxActiveBlocksPerMultiprocessor(&per_cu, (const void*)mk_fwd, NWAVES * 64, LDS_BYTES) != hipSuccess || per_cu < 1) { fprintf(stderr, "kernel_launch: occupancy query says %d blocks per CU\n", per_cu); (void)hipGetLastError(); grid = -1; return; }
        grid = cus;
    }
    if (grid < 0) return;
    if (hipMemsetAsync((char*)d_ws + WS_CTL, 0, CTL_ZERO_BYTES, stream) != hipSuccess) return;
    Args a{};
    for (int i = 0; i < 15; ++i) a.in[i] = (const float*)d_in[i];
    a.out = (float*)d_out; a.ws = (unsigned char*)d_ws;
    const int nl = MK_N_LAUNCHES;
    for (int li = 0; li < nl; ++li) {
        a.ph_lo = (nl == 1) ? 0 : li; a.ph_hi = (nl == 1) ? NPHASE : li + 1;
#ifdef DBG_CHECK
#if DBG_CHECK == 1
        if (li == 4) { Args c = a; c.ph_lo = 99; c.ph_hi = 100; hipLaunchKernelGGL(mk_fwd, dim3(grid), dim3(NWAVES * 64), LDS_BYTES, stream, c); }
#else
        if (li >= 5) { Args c = a; c.ph_lo = 95 + li; c.ph_hi = 96 + li; hipLaunchKernelGGL(mk_fwd, dim3(grid), dim3(NWAVES * 64), LDS_BYTES, stream, c); }
#endif
#endif
        hipLaunchKernelGGL(mk_fwd, dim3(grid), dim3(NWAVES * 64), LDS_BYTES, stream, a);
    }
#ifdef DBG_CHECK
    { Args c = a;
#if DBG_CHECK == 2
      c.ph_lo = 103; c.ph_hi = 104; hipLaunchKernelGGL(mk_fwd, dim3(grid), dim3(NWAVES * 64), LDS_BYTES, stream, c);
#endif
      c.ph_lo = 104; c.ph_hi = 105; hipLaunchKernelGGL(mk_fwd, dim3(grid), dim3(NWAVES * 64), LDS_BYTES, stream, c); }
#endif
}
```

```cpp
#include <hip/hip_runtime.h>
#include <cstdio>
#include <cstdint>
namespace pg8 {
#define PG8_LAS __attribute__((address_space(3)))
typedef unsigned short bf16_t;
typedef short bf16x8 __attribute__((ext_vector_type(8)));
typedef float f32x4 __attribute__((ext_vector_type(4)));
typedef unsigned u32x4 __attribute__((ext_vector_type(4)));
constexpr int BM = 256, BK = 64, HALF = 128, HTB = HALF * BK * 2  , STAGE_BYTES = 8 * HTB, NXCD = 8, WGM = 8;

__host__ __device__ __forceinline__ int lds_byte(int r, int c) { const int st = (r >> 4) * 2 + (c >> 5), rr = r & 15, cc = c & 31, ob = rr * 64 + cc * 2; return st * 1024 + (ob ^ (((ob >> 9) & 1) << 5)); }
__host__ __device__ __forceinline__ void stage_rc(int b, int& R, int& C) { const int st = b / 1024, sb = b % 1024, swz = sb ^ (((sb >> 9) & 1) << 5); R = (st >> 1) * 16 + swz / 64; C = (st & 1) * 32 + (swz % 64) / 2; }
__host__ __device__ __forceinline__ int perm32(int rho) { const int n = rho >> 4, i = rho & 15; return 8 * (i >> 2) + 4 * n + (i & 3); }

struct Unit { int pm, pn; };
struct Gemm { const bf16_t* A; const bf16_t* Bt; int M, N, K; };

struct StaticOrder {
    int nM, nN, nwg, G, c;
    __host__ __device__ void init(int M, int N, int G_, int c_) { nM = M / BM; nN = N / BM; nwg = nM * nN; G = G_; c = c_; }
    __host__ __device__ bool next(int i, Unit& u) const {
        const long L = (long)i * G + c; if (L >= nwg) return false;
        int wgid = (int)L; { const int q = nwg / NXCD, r = nwg % NXCD, xcd = wgid % NXCD, off = wgid / NXCD; wgid = (xcd < r ? xcd * (q + 1) : r * (q + 1) + (xcd - r) * q) + off; }
        const int nig = WGM * nN, gid = wgid / nig, fm = gid * WGM, gsz = (nM - fm) < WGM ? (nM - fm) : WGM;
        u.pm = fm + ((wgid % nig) % gsz); u.pn = (wgid % nig) / gsz; return true;
    }
    __device__ __forceinline__ void a_ready(const Unit&) const {}
    __device__ __forceinline__ void done(const Unit&) const {}
};

__device__ __forceinline__ unsigned cvt_pk_bf16(float lo, float hi) { unsigned r; asm volatile("v_cvt_pk_bf16_f32 %0, %1, %2" : "=v"(r) : "v"(lo), "v"(hi)); return r; }
template <class Epi, class Sched, bool ALIGN_EPI = false, bool SP2 = false>
__device__ __forceinline__ void gemm_phase(PG8_LAS unsigned char* lds, const Gemm g, const Sched& S, const Epi& E) {
    const int tid = threadIdx.x, wid = __builtin_amdgcn_readfirstlane(tid >> 6), lane = tid & 63, wr = wid >> 2, wc = wid & 3, fr = lane & 15, fq = lane >> 4;
    const int K = g.K, nt = K / BK;
    unsigned voffA[2], voffB[2];
#pragma unroll
    for (int i = 0; i < 2; ++i) { int R, C; stage_rc(tid * 16 + i * 8192, R, C); const int Rb = Epi::PERM ? ((R & ~31) + perm32(R & 31)) : R;
        voffA[i] = (unsigned)(R * K + C) * 2u; voffB[i] = (unsigned)(Rb * K + C) * 2u; }
    const size_t kstep = (size_t)(BK * 2);
    const size_t hstep = (size_t)HALF * K * 2;
    const size_t tstep = 2 * hstep;
    const unsigned ldsw = (unsigned)wid * 1024u;
    const int aoff = lds_byte(wr * 64 + fr, fq * 8), boff = lds_byte(wc * 32 + fr, fq * 8);
#define PG8_SA(b, h) (((b) * 2 + (h)) * HTB)
#define PG8_SB(b, h) ((4 + (b) * 2 + (h)) * HTB)
#define PG8_STAGE(bufoff, gbase, voff) do { _Pragma("unroll") for (int _i = 0; _i < 2; ++_i) \
        __builtin_amdgcn_global_load_lds((const unsigned*)((const char*)(gbase) + (voff)[_i]), (PG8_LAS unsigned*)(lds + (bufoff) + ldsw + _i * 8192), 16, 0, 0); } while (0)
#define PG8_LDA(dst, b, h) do { _Pragma("unroll") for (int m = 0; m < 4; ++m) _Pragma("unroll") for (int k = 0; k < 2; ++k) dst[m][k] = *(const PG8_LAS bf16x8*)(lds + PG8_SA(b, h) + aoff + m * 2048 + k * 1024); } while (0)
#define PG8_LDB(dst, b, h) do { _Pragma("unroll") for (int n = 0; n < 2; ++n) _Pragma("unroll") for (int k = 0; k < 2; ++k) dst[n][k] = *(const PG8_LAS bf16x8*)(lds + PG8_SB(b, h) + boff + n * 2048 + k * 1024); } while (0)
#define PG8_MMA(ai, bj, At, Bt) do { __builtin_amdgcn_s_setprio(1); _Pragma("unroll") for (int m = 0; m < 4; ++m) _Pragma("unroll") for (int n = 0; n < 2; ++n) _Pragma("unroll") for (int k = 0; k < 2; ++k) \
        acc[ai][bj][m][n] = __builtin_amdgcn_mfma_f32_16x16x32_bf16(Bt[n][k], At[m][k], acc[ai][bj][m][n], 0, 0, 0); __builtin_amdgcn_s_setprio(0); } while (0)
#define PG8_WAIT_V(n) asm volatile("s_waitcnt vmcnt(" #n ")" ::: "memory")
#define PG8_WAIT_L(n) asm volatile("s_waitcnt lgkmcnt(" #n ")" ::: "memory")
#define PG8_BAR __builtin_amdgcn_s_barrier()
#define PG8_SCHED __builtin_amdgcn_sched_barrier(0)
    Unit cur, nxt; int ui = 0;
    if (!S.next(0, cur)) return;
    f32x4 acc[2][2][4][2];
#pragma unroll
    for (int a = 0; a < 2; ++a)
#pragma unroll
        for (int b = 0; b < 2; ++b)
#pragma unroll
            for (int m = 0; m < 4; ++m)
#pragma unroll
                for (int n = 0; n < 2; ++n) acc[a][b][m][n] = (f32x4){0.f, 0.f, 0.f, 0.f};
    bf16x8 At[4][2], B0[2][2], B1[2][2];
    const char* cA = (const char*)g.A + (size_t)cur.pm * tstep; const char* cB = (const char*)g.Bt + (size_t)cur.pn * tstep;
    S.a_ready(cur);
    if constexpr (SP2) {
        PG8_STAGE(PG8_SB(0, 0), cB, voffB); PG8_STAGE(PG8_SB(0, 1), cB + hstep, voffB); PG8_STAGE(PG8_SA(0, 0), cA, voffA); PG8_STAGE(PG8_SA(0, 1), cA + hstep, voffA);
        if (wr == 1) PG8_BAR;
        PG8_WAIT_V(2); PG8_BAR;
        PG8_STAGE(PG8_SB(1, 0), cB + kstep, voffB); PG8_STAGE(PG8_SA(1, 0), cA + kstep, voffA); PG8_STAGE(PG8_SB(1, 1), cB + hstep + kstep, voffB);
        PG8_WAIT_V(6); PG8_BAR;
    } else {
        PG8_STAGE(PG8_SB(0, 0), cB, voffB); PG8_STAGE(PG8_SA(0, 0), cA, voffA); PG8_STAGE(PG8_SB(0, 1), cB + hstep, voffB); PG8_STAGE(PG8_SA(0, 1), cA + hstep, voffA);
        if (wr == 1) PG8_BAR;
        PG8_WAIT_V(4); PG8_BAR;
        PG8_STAGE(PG8_SB(1, 0), cB + kstep, voffB); PG8_STAGE(PG8_SA(1, 0), cA + kstep, voffA); PG8_STAGE(PG8_SB(1, 1), cB + hstep + kstep, voffB);
        PG8_WAIT_V(6); PG8_BAR;
    }
    for (;;) {
        const bool has_next = S.next(ui + 1, nxt);
        const char* nA = has_next ? (const char*)g.A + (size_t)nxt.pm * tstep : cA; const char* nB = has_next ? (const char*)g.Bt + (size_t)nxt.pn * tstep : cB;
        for (int t = 0; t < nt; t += 2) {
            const bool last = (t == nt - 2);
            const char* a1 = cA + (size_t)(t + 1) * kstep;
            const char* a2 = last ? nA : cA + (size_t)(t + 2) * kstep; const char* b2 = last ? nB : cB + (size_t)(t + 2) * kstep;
            const char* a3 = a2 + kstep; const char* b3 = b2 + kstep;
            if (last && has_next) S.a_ready(nxt);
            if constexpr (SP2) {
            PG8_LDB(B0, 0, 0); PG8_LDB(B1, 0, 1); PG8_SCHED; PG8_LDA(At, 0, 0); PG8_STAGE(PG8_SA(1, 1), a1 + hstep, voffA);
            PG8_WAIT_V(8); PG8_WAIT_L(0); PG8_BAR; PG8_MMA(0, 0, At, B0); PG8_MMA(0, 1, At, B1); PG8_BAR; PG8_SCHED;
            PG8_LDA(At, 0, 1); PG8_STAGE(PG8_SB(0, 0), b2, voffB); PG8_STAGE(PG8_SB(0, 1), b2 + hstep, voffB); PG8_STAGE(PG8_SA(0, 0), a2, voffA);
            PG8_WAIT_V(8); PG8_WAIT_L(0); PG8_BAR; PG8_MMA(1, 0, At, B0); PG8_MMA(1, 1, At, B1); PG8_BAR; PG8_SCHED;
            PG8_LDB(B0, 1, 0); PG8_LDB(B1, 1, 1); PG8_SCHED; PG8_LDA(At, 1, 0); PG8_STAGE(PG8_SA(0, 1), a2 + hstep, voffA);
            PG8_WAIT_V(8); PG8_WAIT_L(0); PG8_BAR; PG8_MMA(0, 0, At, B0); PG8_MMA(0, 1, At, B1); PG8_BAR; PG8_SCHED;
            PG8_LDA(At, 1, 1); PG8_STAGE(PG8_SB(1, 0), b3, voffB); PG8_STAGE(PG8_SB(1, 1), b3 + hstep, voffB); PG8_STAGE(PG8_SA(1, 0), a3, voffA);
            PG8_WAIT_V(8); PG8_WAIT_L(0); PG8_BAR; PG8_MMA(1, 0, At, B0); PG8_MMA(1, 1, At, B1); PG8_BAR; PG8_SCHED;
            } else {
            PG8_LDB(B0, 0, 0); PG8_SCHED; PG8_LDA(At, 0, 0); PG8_STAGE(PG8_SA(1, 1), a1 + hstep, voffA);
            PG8_WAIT_L(8); PG8_BAR; PG8_WAIT_L(0); PG8_MMA(0, 0, At, B0); PG8_BAR; PG8_SCHED;
            PG8_LDB(B1, 0, 1); PG8_STAGE(PG8_SB(0, 0), b2, voffB);
            PG8_BAR; PG8_WAIT_L(0); PG8_MMA(0, 1, At, B1); PG8_BAR;
            PG8_LDA(At, 0, 1); PG8_STAGE(PG8_SA(0, 0), a2, voffA);
            PG8_BAR; PG8_WAIT_L(0); PG8_MMA(1, 0, At, B0); PG8_BAR; PG8_SCHED;
            PG8_STAGE(PG8_SB(0, 1), b2 + hstep, voffB);
            PG8_WAIT_V(6); PG8_BAR; PG8_MMA(1, 1, At, B1); PG8_BAR;
            PG8_LDB(B0, 1, 0); PG8_SCHED; PG8_LDA(At, 1, 0); PG8_STAGE(PG8_SA(0, 1), a2 + hstep, voffA);
            PG8_WAIT_L(8); PG8_BAR; PG8_WAIT_L(0); PG8_MMA(0, 0, At, B0); PG8_BAR; PG8_SCHED;
            PG8_LDB(B1, 1, 1); PG8_STAGE(PG8_SB(1, 0), b3, voffB);
            PG8_BAR; PG8_WAIT_L(0); PG8_MMA(0, 1, At, B1); PG8_BAR;
            PG8_LDA(At, 1, 1); PG8_STAGE(PG8_SA(1, 0), a3, voffA);
            PG8_BAR; PG8_WAIT_L(0); PG8_MMA(1, 0, At, B0); PG8_BAR; PG8_SCHED;
            PG8_STAGE(PG8_SB(1, 1), b3 + hstep, voffB);
            PG8_WAIT_V(6); PG8_BAR; PG8_MMA(1, 1, At, B1); PG8_BAR;
            }
        }
        if constexpr (ALIGN_EPI) { if (wr == 0) PG8_BAR; }
        bool keep_ = false; if constexpr (!Epi::AFTER_DRAIN) { keep_ = E(acc, cur, wr, wc, fr, fq); S.done(cur); }
        if (!has_next) break;
        if (!keep_)
#pragma unroll
        for (int a = 0; a < 2; ++a)
#pragma unroll
            for (int b = 0; b < 2; ++b)
#pragma unroll
                for (int m = 0; m < 4; ++m)
#pragma unroll
                    for (int n = 0; n < 2; ++n) acc[a][b][m][n] = (f32x4){0.f, 0.f, 0.f, 0.f};
        cur = nxt; cA = nA; cB = nB; ++ui;
        if constexpr (ALIGN_EPI) { if (wr == 1) PG8_BAR; }
    }
    PG8_WAIT_V(0);
    if constexpr (!ALIGN_EPI) { if (wr == 0) PG8_BAR; }
    PG8_BAR;
    if constexpr (Epi::AFTER_DRAIN) { E.fused(acc, cur, wr, wc, fr, fq, lds, wid, lane); S.done(cur); }
#undef PG8_SA
#undef PG8_SB
#undef PG8_STAGE
#undef PG8_LDA
#undef PG8_LDB
#undef PG8_MMA
#undef PG8_WAIT_V
#undef PG8_WAIT_L
#undef PG8_BAR
#undef PG8_SCHED
}
}
#ifndef DBG_DUP2
#define DBG_DUP2 0
#endif
#ifndef DBG_FOXT0
#define DBG_FOXT0 0
#endif
#ifndef DBG_NSAM
#define DBG_NSAM 0
#endif
#ifndef DBG_DUP3
#define DBG_DUP3 0
#endif
#ifndef DBG_ACTSCALE
#define DBG_ACTSCALE 1.0f
#endif
#ifndef DBG_OUTSCALE
#define DBG_OUTSCALE 1.0f
#endif
#ifndef DBG_KEEP
#define DBG_KEEP 16
#endif
#define COARSE2(w) (((w) + 0x00020002u) & 0xfffcfffcu)
#ifndef DBG_KROPE
#define DBG_KROPE 31
#endif
#ifndef DBG_FOXT
#define DBG_FOXT 1.0f
#endif
#ifndef DBG_NSAT
#define DBG_NSAT 1.0f
#endif
#ifndef DBG_DECAY
#define DBG_DECAY 1.0f
#endif

constexpr int NB = 8, SEQ = 4096, DM = 1024, NTOK = NB * SEQ;
constexpr int NIN = 5120;
constexpr int NEXP = 16384;
constexpr float LOG2E = 1.4426950408889634f;
constexpr float C2 = 0.125f * LOG2E;
constexpr float RMS_EPS = 1e-6f;
constexpr int NWAVES = 8;

constexpr size_t MiB = 1u << 20;
constexpr size_t WS_CTL = 0, CTL_ZERO_BYTES = 1 * MiB;
constexpr size_t WS_SS = 512 * 1024;
constexpr size_t WS_BIAS1 = 768 * 1024;
constexpr size_t WS_WTIN = 2 * MiB, WS_WTBR = 12 * MiB, WS_WTOUT = 14 * MiB, WS_WTPEER = 16 * MiB, WS_W1T = 20 * MiB;
constexpr size_t WS_W2T = 21 * MiB, WS_ROPE = 21 * MiB + 128 * 1024, WS_KCMP = 22 * MiB, WS_VCMP = 22 * MiB + 512 * 1024, WS_LOGF = 23 * MiB;
constexpr size_t WS_UB = 24 * MiB, WS_VB = 56 * MiB;
constexpr size_t WS_U8 = WS_UB, WS_V8 = WS_UB + 16 * MiB, WS_SU = WS_VB, WS_SV = WS_VB + 1 * MiB;
constexpr size_t WS_XN = 88 * MiB;
constexpr size_t WS_Y = WS_XN, WS_HB = WS_XN;
constexpr size_t WS_QF = 152 * MiB, WS_KF = 184 * MiB, WS_VF = 216 * MiB, WS_QN = 248 * MiB;
constexpr size_t WS_MERGED = WS_QF;
constexpr size_t WS_KVC = 280 * MiB, WS_KVS = 296 * MiB, WS_KVW = 312 * MiB;
constexpr size_t WS_GM = 328 * MiB;
constexpr size_t WS_HBF = 328 * MiB;
constexpr size_t WS_GATES = 456 * MiB, WS_CUM = 459 * MiB  , WS_END = 461 * MiB;
constexpr size_t WS_SC = 152 * MiB;
static_assert(WS_SC + (size_t)NTOK * 2048 * 4 <= WS_GATES, "score overlay");
constexpr int CW_BAR = 4096;
constexpr int CW_QATT = 8192, CW_QPEER = 8256;

constexpr int RING_BYTES = 131072;
constexpr int LDS_BYTES = 147456;
constexpr int LDSCTL_OFF = LDS_BYTES - 512, MISC_OFF = LDSCTL_OFF + 64;

#define GAS __attribute__((address_space(1)))
#define LAS __attribute__((address_space(3)))
typedef unsigned short bf16;
typedef unsigned v4u __attribute__((ext_vector_type(4)));
typedef unsigned v2u __attribute__((ext_vector_type(2)));
typedef float f32x4 __attribute__((ext_vector_type(4)));
typedef float f32x2 __attribute__((ext_vector_type(2)));
typedef short bf16x8 __attribute__((ext_vector_type(8)));
typedef short s16x4 __attribute__((ext_vector_type(4)));
typedef float f32x16 __attribute__((ext_vector_type(16)));
typedef __bf16 bf16x2_t __attribute__((ext_vector_type(2)));
typedef GAS unsigned gu32;
#define RLX_AGENT __ATOMIC_RELAXED, __HIP_MEMORY_SCOPE_AGENT
#define LDS_WAIT() asm volatile("s_waitcnt lgkmcnt(0)" ::: "memory")
#define VM_WAIT() asm volatile("s_waitcnt vmcnt(0)" ::: "memory")
__device__ __forceinline__ unsigned pk2(float lo, float hi) { return pg8::cvt_pk_bf16(lo, hi); }
__device__ __forceinline__ float bf_lo(unsigned w) { return __uint_as_float(w << 16); }
__device__ __forceinline__ float bf_hi(unsigned w) { return __uint_as_float(w & 0xffff0000u); }
__device__ __forceinline__ float sigmoidf_(float x) { return __builtin_amdgcn_rcpf(1.0f + __builtin_amdgcn_exp2f(-x * LOG2E)); }
__device__ __forceinline__ float gelu_erf(float v) { return 0.5f * v * (1.0f + erff(v * 0.70710678118654752f)); }
__device__ __forceinline__ float wave_sum(float v) {
#pragma unroll
    for (int o = 1; o < 64; o <<= 1) v += __shfl_xor(v, o);
    return v;
}

#define XB_TMO      128
#define XB_XCNT(j)  (256  + 64 * (j))
#define XB_XSUB(j)  (1280 + 64 * (j))
#define XB_XGEN(j)  (2304 + 64 * (j))
#define XB_TOP      3328
#define XB_TOPGEN   3392
#define XCD_BAR_WORDS 3456
#define XB_SPIN_CAP (1u << 18)

__device__ __forceinline__ unsigned xb_ld(unsigned* p)              { return __hip_atomic_load(p, __ATOMIC_RELAXED, __HIP_MEMORY_SCOPE_AGENT); }
__device__ __forceinline__ unsigned xb_add(unsigned* p, unsigned v) { return __hip_atomic_fetch_add(p, v, __ATOMIC_RELAXED, __HIP_MEMORY_SCOPE_AGENT); }
__device__ __forceinline__ unsigned xb_xcc_id() { return (unsigned)__builtin_amdgcn_s_getreg((3 << 11) | 20) & 0xFu; }
#define XB_SPIN(cond, bar) do { unsigned _sp = 0; while (cond) { __builtin_amdgcn_s_sleep(1); \
    if ((++_sp & 255u) == 0u) { if (xb_ld(&(bar)[XB_TMO])) break; if (_sp > XB_SPIN_CAP) { atomicAdd(&(bar)[XB_TMO], 1u); break; } } } } while (0)

struct XcdBarrier {
    unsigned* bar; unsigned x;
    volatile LAS unsigned* st;
};

__device__ __forceinline__ XcdBarrier xcd_barrier_post(unsigned* bar, volatile LAS unsigned* st) {
    XcdBarrier b; b.bar = bar; b.x = xb_xcc_id(); b.st = st;
    if (threadIdx.x == 0) (void)xb_add(&bar[XB_XCNT(b.x)], 1u);
    return b;
}
__device__ __forceinline__ void xcd_barrier_complete(unsigned* bar, unsigned x, unsigned& nloc, unsigned& nx) {
    const unsigned G = gridDim.x * gridDim.y * gridDim.z;
    unsigned sum, cnt, mine, sp = 0u;
    for (;;) {
        sum = 0u; cnt = 0u; mine = 0u;
#pragma unroll
        for (unsigned j = 0; j < 16; ++j) { const unsigned c = xb_ld(&bar[XB_XCNT(j)]); sum += c; cnt += (c > 0u) ? 1u : 0u; mine = (j == x) ? c : mine; }
        if (sum == G) break;
        __builtin_amdgcn_s_sleep(1);
        if ((++sp & 255u) == 0u) { if (xb_ld(&bar[XB_TMO])) break; if (sp > XB_SPIN_CAP) { atomicAdd(&bar[XB_TMO], 1u); break; } }
    }
    nloc = mine > 0u ? mine : 1u; nx = cnt > 0u ? cnt : 1u;
}

__device__ __forceinline__ void xcd_barrier(const XcdBarrier& b) {
    asm volatile("s_waitcnt vmcnt(0)" ::: "memory");
    __syncthreads();
    if (threadIdx.x == 0) {
        unsigned* bar = b.bar;
        __builtin_amdgcn_s_waitcnt(0);
        unsigned nloc = b.st[0], nx = b.st[1];
        if (nloc == 0u) { xcd_barrier_complete(bar, b.x, nloc, nx); b.st[0] = nloc; b.st[1] = nx; }
        const unsigned old = xb_add(&bar[XB_XSUB(b.x)], 1u);
        const unsigned gen = old / nloc;
        if (old + 1u == (gen + 1u) * nloc) {
            __builtin_amdgcn_fence(__ATOMIC_RELEASE, "agent");
            asm volatile("s_waitcnt vmcnt(0)" ::: "memory");
            const unsigned og = xb_add(&bar[XB_TOP], 1u);
            const unsigned tg = og / nx;
            if (og + 1u == (tg + 1u) * nx) xb_add(&bar[XB_TOPGEN], 1u);
            else XB_SPIN(xb_ld(&bar[XB_TOPGEN]) == tg, bar);
            __builtin_amdgcn_fence(__ATOMIC_ACQUIRE, "agent");
            xb_add(&bar[XB_XGEN(b.x)], 1u);
            asm volatile("s_waitcnt vmcnt(0)" ::: "memory");
        } else {
            XB_SPIN(xb_ld(&bar[XB_XGEN(b.x)]) == gen, bar);
            __builtin_amdgcn_fence(__ATOMIC_ACQUIRE, "agent");
            asm volatile("s_waitcnt vmcnt(0)" ::: "memory");
        }
    }
    __syncthreads();
}


struct Frame {
    LAS unsigned char* lds;
    volatile LAS unsigned* MISC;
    gu32* ctl;
    int tid, lane, wave, vcu, G;
    unsigned char* ws;
    const float *x, *norm_mix, *w_in, *fbias, *cmp_pos, *cmp_w1, *cmp_w2, *w_branch, *w_out, *norm_ffn, *peer_wq, *peer_sk, *peer_u, *peer_v, *norm_final;
    float* out;
};

__device__ __forceinline__ int src_col_in(int n) {
    if (n < 1536) return n;
    if (n < 2816) return n + 8;
    if (n < 2824) return n - 2816 + 1536;
    if (n < 2848) return n;
    if (n < 3072) return -1;
    { const int m = n - 3072, i = m >> 8, half = (m >> 7) & 1, c = m & 127; return 2848 + half * 1024 + i * 128 + c; }
}
__device__ __forceinline__ void p0_tr_item(const float* W, int ldw, int K, bf16* WT, int kb, int dst_row0, int src_col, LAS float* scr, int lane) {
    const int k0 = 64 * kb;
    { f32x4 v_[8];
#pragma unroll
      for (int i = 0; i < 8; ++i) { const int kk = 8 * i + (lane >> 3); v_[i] = (src_col >= 0) ? *(const GAS f32x4*)(W + (size_t)(k0 + kk) * ldw + src_col) : (f32x4){0.f, 0.f, 0.f, 0.f}; }
#pragma unroll
      for (int i = 0; i < 8; ++i) { const int kk = 8 * i + (lane >> 3); LAS float* d_ = scr + kk * 33 + 4 * (lane & 7); d_[0] = v_[i].x; d_[1] = v_[i].y; d_[2] = v_[i].z; d_[3] = v_[i].w; } }
    LDS_WAIT(); asm volatile("" ::: "memory");
    const int c = lane & 7;
#pragma unroll
    for (int j = 0; j < 4; ++j) { const int n = (lane >> 3) + 8 * j; const LAS float* s = scr + (8 * c) * 33 + n;
        v4u o; o.x = pk2(s[0 * 33], s[1 * 33]); o.y = pk2(s[2 * 33], s[3 * 33]); o.z = pk2(s[4 * 33], s[5 * 33]); o.w = pk2(s[6 * 33], s[7 * 33]);
#ifdef DBG_C_W
        o.x = COARSE2(o.x); o.y = COARSE2(o.y); o.z = COARSE2(o.z); o.w = COARSE2(o.w);
#endif
        *(GAS v4u*)(WT + (size_t)(dst_row0 + n) * K + k0 + 8 * c) = o; }
    LDS_WAIT(); asm volatile("" ::: "memory");
}
__device__ __forceinline__ void p0_prologue(Frame& F, bool skip_bias = false) {
    LAS float* scr = (LAS float*)(F.lds + F.wave * 16384);
    unsigned char* ws = F.ws;
    const int gw = F.vcu * NWAVES + F.wave, NGW = F.G * NWAVES, lane = F.lane;
    const int gt = gw * 64 + lane, NGT = NGW * 64;
#pragma nounroll
    for (int pass_ = 0; pass_ < 2; ++pass_) {
    if (((pass_ ^ F.vcu) & 1) == 0) {
    constexpr int I_IN = 16 * 160, I_BR = 8 * 32, I_OUT = 16 * 32, I_W1 = 32 * 4, I_W2 = 2 * 2;
    constexpr int NITEMS = I_IN + 2 * I_BR + I_OUT + 2 * I_W1 + 2 * I_W2;
    for (int it = gw; it < NITEMS; it += NGW) {
        int r = it;
        if (r < I_IN) { const int kb = r / 160, nb = r % 160; p0_tr_item(F.w_in, 4896, 1024, (bf16*)(ws + WS_WTIN), kb, 32 * nb, src_col_in(32 * nb + 4 * (lane & 7)), scr, lane); continue; } r -= I_IN;
        if (r < 2 * I_BR) { const int br = r / I_BR, q = r % I_BR, kb = q / 32, nb = q % 32; p0_tr_item(F.w_branch + (size_t)br * 512 * 1024, 1024, 512, (bf16*)(ws + WS_WTBR), kb, br * 1024 + 32 * nb, 32 * nb + 4 * (lane & 7), scr, lane); continue; } r -= 2 * I_BR;
        if (r < I_OUT) { const int kb = r / 32, nb = r % 32; p0_tr_item(F.w_out, 1024, 1024, (bf16*)(ws + WS_WTOUT), kb, 32 * nb, 32 * nb + 4 * (lane & 7), scr, lane); continue; } r -= I_OUT;
        if (r < 2 * I_W1) { const int j = r / I_W1, q = r % I_W1, kb = q / 4, nb = q % 4; p0_tr_item(F.cmp_w1 + (size_t)j * 2048 * 128, 128, 2048, (bf16*)(ws + WS_W1T), kb, j * 128 + 32 * nb, 32 * nb + 4 * (lane & 7), scr, lane); continue; } r -= 2 * I_W1;
        { const int j = r / I_W2, q = r % I_W2, kb = q / 2, nb = q % 2; p0_tr_item(F.cmp_w2 + (size_t)j * 128 * 64, 64, 128, (bf16*)(ws + WS_W2T), kb, j * 64 + 32 * nb, 32 * nb + 4 * (lane & 7), scr, lane); }
    }
    { LAS float* skl = (LAS float*)F.lds; LAS float* wql = skl + 128 * 129;
      for (int it = F.vcu; it < 16 * 16; it += F.G) { const int hp = it >> 4, kc = it & 15;
        __syncthreads();
        for (int e = F.tid; e < 128 * 32; e += NWAVES * 64) { const int n = e >> 5, d4 = e & 31; const f32x4 v = *((const GAS f32x4*)(F.peer_sk + (size_t)(hp * 128 + n) * 128) + d4);
            skl[n * 129 + 4 * d4] = v.x; skl[n * 129 + 4 * d4 + 1] = v.y; skl[n * 129 + 4 * d4 + 2] = v.z; skl[n * 129 + 4 * d4 + 3] = v.w; }
        for (int e = F.tid; e < 64 * 32; e += NWAVES * 64) { const int k = e >> 5, d4 = e & 31; *((LAS f32x4*)(wql + k * 128) + d4) = *((const GAS f32x4*)(F.peer_wq + (size_t)(kc * 64 + k) * 2048 + hp * 128) + d4); }
        __syncthreads();
        const int n = F.tid & 127, kq = __builtin_amdgcn_readfirstlane(F.tid >> 7);
        float acc[16];
#pragma unroll
        for (int j = 0; j < 16; ++j) acc[j] = 0.f;
        for (int d4 = 0; d4 < 32; ++d4) { const float s0 = skl[n * 129 + 4 * d4], s1 = skl[n * 129 + 4 * d4 + 1], s2 = skl[n * 129 + 4 * d4 + 2], s3 = skl[n * 129 + 4 * d4 + 3];
#pragma unroll
            for (int j = 0; j < 16; ++j) { const f32x4 w = *((const LAS f32x4*)(wql + (kq * 16 + j) * 128) + d4); acc[j] += (s0 * w.x + s1 * w.y) + (s2 * w.z + s3 * w.w); } }
        { const GAS f32x4* gk = (const GAS f32x4*)(F.norm_ffn + kc * 64 + kq * 16);
#pragma unroll
          for (int q = 0; q < 4; ++q) { const f32x4 g4 = gk[q]; acc[4 * q] *= g4.x; acc[4 * q + 1] *= g4.y; acc[4 * q + 2] *= g4.z; acc[4 * q + 3] *= g4.w; } }
        bf16* WtP = (bf16*)(ws + WS_WTPEER) + (size_t)(hp * 128 + n) * 1024 + kc * 64 + kq * 16;
        v4u o0, o1; o0.x = pk2(acc[0], acc[1]); o0.y = pk2(acc[2], acc[3]); o0.z = pk2(acc[4], acc[5]); o0.w = pk2(acc[6], acc[7]);
        o1.x = pk2(acc[8], acc[9]); o1.y = pk2(acc[10], acc[11]); o1.z = pk2(acc[12], acc[13]); o1.w = pk2(acc[14], acc[15]);
        *(GAS v4u*)WtP = o0; *(GAS v4u*)(WtP + 8) = o1;
      }
      __syncthreads(); }
    if (!skip_bias) for (int it = gt; it < 2 * 128 * 64; it += NGT) {
        const int n = it & 127, j = (it >> 7) & 1, ch = it >> 8;
        const float* p = F.cmp_pos + (size_t)j * 2048 + ch * 32; const float* w = F.cmp_w1 + ((size_t)j * 2048 + ch * 32) * 128 + n;
        float pv[32], wv[32];
#pragma unroll
        for (int k = 0; k < 32; ++k) { pv[k] = p[k]; wv[k] = w[(size_t)k * 128]; }
        float a = 0.f;
#pragma unroll
        for (int k = 0; k < 32; ++k) a += pv[k] * wv[k];
        atomicAdd((float*)(ws + WS_BIAS1) + j * 128 + n, a);
    }
    for (int it = gt; it < SEQ * 8; it += NGT) {
        const int pos = it >> 3, i = it & 7;
        const double inv[8] = {1.0, 0.19392274474868576, 0.03760603093086393, 0.007292664737217109, 0.001414213562373095, 0.0002742481756762073, 5.318295896944988e-05, 1.031338537721246e-05};
        double iv = inv[0];
#pragma unroll
        for (int q = 1; q < 8; ++q) iv = (i == q) ? inv[q] : iv;
        const double rev = (double)pos * iv * 0.15915494309189535; const float fr = (float)(rev - __builtin_rint(rev));
        f32x2 cs; cs.x = __builtin_amdgcn_cosf(fr); cs.y = __builtin_amdgcn_sinf(fr);
        ((GAS f32x2*)(ws + WS_ROPE))[it] = cs;
    }
    } else {
    { const GAS f32x4* gr = (const GAS f32x4*)F.norm_mix + lane; f32x4 gq[4];
#pragma unroll
      for (int j = 0; j < 4; ++j) gq[j] = gr[64 * j];
      for (int m0 = gw * 4; m0 < NTOK; m0 += NGW * 4) {
        f32x4 v[4][4]; float sq[4];
#pragma unroll
        for (int r = 0; r < 4; ++r) { const GAS f32x4* xr = (const GAS f32x4*)(F.x + (size_t)(m0 + r) * DM) + lane;
#pragma unroll
            for (int j = 0; j < 4; ++j) v[r][j] = xr[64 * j]; }
#pragma unroll
        for (int r = 0; r < 4; ++r) { float a = 0.f;
#pragma unroll
            for (int j = 0; j < 4; ++j) a += (v[r][j].x * v[r][j].x + v[r][j].y * v[r][j].y) + (v[r][j].z * v[r][j].z + v[r][j].w * v[r][j].w);
            sq[r] = a; }
#pragma unroll
        for (int o = 1; o < 64; o <<= 1) {
#pragma unroll
            for (int r = 0; r < 4; ++r) sq[r] += __shfl_xor(sq[r], o); }
#pragma unroll
        for (int r = 0; r < 4; ++r) { const float rr = 1.0f / sqrtf(sq[r] * (1.f / DM) + RMS_EPS);
            GAS v2u* o8 = (GAS v2u*)((bf16*)(ws + WS_XN) + (size_t)(m0 + r) * DM) + lane;
#pragma unroll
            for (int j = 0; j < 4; ++j) { const f32x4 g = gq[j]; v2u o; o.x = pk2(v[r][j].x * rr * g.x, v[r][j].y * rr * g.y); o.y = pk2(v[r][j].z * rr * g.z, v[r][j].w * rr * g.w);
                o8[64 * j] = o; } }
      } }
    for (int r0 = gw * 4; r0 < 2 * NEXP; r0 += NGW * 4) {
        f32x4 a[4][4]; float mx[4];
#pragma unroll
        for (int q = 0; q < 4; ++q) { const int r = r0 + q; const bool isv = r >= NEXP; const int e = isv ? r - NEXP : r;
            const GAS f32x4* src = (const GAS f32x4*)((isv ? F.peer_v : F.peer_u) + (size_t)e * DM) + 4 * lane;
#pragma unroll
            for (int j = 0; j < 4; ++j) a[q][j] = src[j]; }
#pragma unroll
        for (int q = 0; q < 4; ++q) { float m = 0.f;
#pragma unroll
            for (int j = 0; j < 4; ++j) m = fmaxf(m, fmaxf(fmaxf(fabsf(a[q][j].x), fabsf(a[q][j].y)), fmaxf(fabsf(a[q][j].z), fabsf(a[q][j].w))));
            mx[q] = m; }
#pragma unroll
        for (int o = 1; o < 64; o <<= 1) {
#pragma unroll
            for (int q = 0; q < 4; ++q) mx[q] = fmaxf(mx[q], __shfl_xor(mx[q], o)); }
#pragma unroll
        for (int q = 0; q < 4; ++q) { const int r = r0 + q; const bool isv = r >= NEXP; const int e = isv ? r - NEXP : r; const float m = mx[q];
            const float inv = m > 0.f ? 6.0f / m : 0.f, sc = m > 0.f ? m * (1.0f / 6.0f) : 1.0f;
            v2u o; unsigned w = 0u;
            w = __builtin_amdgcn_cvt_scalef32_pk_fp4_f32(w, a[q][0].x * inv, a[q][0].y * inv, 1.0f, 0); w = __builtin_amdgcn_cvt_scalef32_pk_fp4_f32(w, a[q][0].z * inv, a[q][0].w * inv, 1.0f, 1);
            w = __builtin_amdgcn_cvt_scalef32_pk_fp4_f32(w, a[q][1].x * inv, a[q][1].y * inv, 1.0f, 2); w = __builtin_amdgcn_cvt_scalef32_pk_fp4_f32(w, a[q][1].z * inv, a[q][1].w * inv, 1.0f, 3); o.x = w; w = 0u;
            w = __builtin_amdgcn_cvt_scalef32_pk_fp4_f32(w, a[q][2].x * inv, a[q][2].y * inv, 1.0f, 0); w = __builtin_amdgcn_cvt_scalef32_pk_fp4_f32(w, a[q][2].z * inv, a[q][2].w * inv, 1.0f, 1);
            w = __builtin_amdgcn_cvt_scalef32_pk_fp4_f32(w, a[q][3].x * inv, a[q][3].y * inv, 1.0f, 2); w = __builtin_amdgcn_cvt_scalef32_pk_fp4_f32(w, a[q][3].z * inv, a[q][3].w * inv, 1.0f, 3); o.y = w;
            *((GAS v2u*)(ws + (isv ? WS_V8 : WS_U8) + (size_t)e * (DM / 2)) + lane) = o;
            if (lane == 0) ((float*)(ws + (isv ? WS_SV : WS_SU)))[e] = sc; }
    }
    }
    }
}

struct EpiIn {
    static constexpr bool PERM = true, AFTER_DRAIN = false;
    unsigned char* ws; const float* fbias;
    __device__ __forceinline__ bool operator()(f32x4 (&acc)[2][2][4][2], const pg8::Unit& u, int wr, int wc, int fr, int fq) const {
        const int pn = u.pn, row0 = u.pm * 256 + wr * 64 + fr;
        if (pn == 11) {
            if (wc == 0) {
#pragma unroll
                for (int ai = 0; ai < 2; ++ai)
#pragma unroll
                    for (int m = 0; m < 4; ++m) { const int row = row0 + ai * 128 + m * 16; const f32x4 v0 = acc[ai][0][m][0], v1 = acc[ai][0][m][1];
                        float v[8] = {v0.x, v0.y, v0.z, v0.w, v1.x, v1.y, v1.z, v1.w}, o[8];
                        if (fq == 0) {
#pragma unroll
                            for (int i = 0; i < 8; ++i) { const float z = v[i] + fbias[i]; o[i] = fminf(z, 0.f) - log1pf(__expf(-fabsf(z))); }
                            GAS f32x4* d = (GAS f32x4*)((float*)(ws + WS_LOGF) + (size_t)row * 8); d[0] = (f32x4){o[0], o[1], o[2], o[3]}; d[1] = (f32x4){o[4], o[5], o[6], o[7]};
                        } else {
#pragma unroll
                            for (int i = 0; i < 8; ++i) o[i] = sigmoidf_(v[i]);
                            GAS f32x4* d = (GAS f32x4*)((float*)(ws + WS_GATES) + (size_t)row * 24 + (fq - 1) * 8); d[0] = (f32x4){o[0], o[1], o[2], o[3]}; d[1] = (f32x4){o[4], o[5], o[6], o[7]};
                        } }
            }
            return false;
        }
        if (pn >= 12) {
            bf16* gm = (bf16*)(ws + WS_GM) + (size_t)(pn - 12) * 256 + wc * 32 + 8 * fq;
#pragma unroll
            for (int ai = 0; ai < 2; ++ai)
#pragma unroll
                for (int m = 0; m < 4; ++m) { const int row = row0 + ai * 128 + m * 16; const f32x4 a0 = acc[ai][0][m][0], a1 = acc[ai][0][m][1], b0 = acc[ai][1][m][0], b1 = acc[ai][1][m][1];
                    const float av[8] = {a0.x, a0.y, a0.z, a0.w, a1.x, a1.y, a1.z, a1.w}, bv[8] = {b0.x, b0.y, b0.z, b0.w, b1.x, b1.y, b1.z, b1.w}; float rt_[8], g1_[8];
#pragma unroll
                    for (int i = 0; i < 8; ++i) { const float ea = __builtin_amdgcn_exp2f(-av[i] * LOG2E), eb = __builtin_amdgcn_exp2f(-bv[i] * LOG2E), d1 = 1.0f + eb;
                        g1_[i] = __builtin_amdgcn_rcpf(d1); rt_[i] = (d1 < 1e30f) ? d1 * __builtin_amdgcn_rcpf(1.0f + ea) : 0.f; }
                    v4u wr_, wg_; wr_.x = pk2(rt_[0], rt_[1]); wr_.y = pk2(rt_[2], rt_[3]); wr_.z = pk2(rt_[4], rt_[5]); wr_.w = pk2(rt_[6], rt_[7]);
                    wg_.x = pk2(g1_[0], g1_[1]); wg_.y = pk2(g1_[2], g1_[3]); wg_.z = pk2(g1_[4], g1_[5]); wg_.w = pk2(g1_[6], g1_[7]);
                    *(GAS v4u*)(gm + (size_t)row * 2048) = wr_; *(GAS v4u*)(gm + (size_t)row * 2048 + 128) = wg_; }
            return false;
        }
        bf16* dst; int pitch, colt; float sc = 1.f; int mode = 0;
        bool rope_bj1 = false; int kvt = 0, nh = 8;
        if (pn < 2)       { dst = (bf16*)(ws + WS_QF); pitch = 512; colt = pn * 256; sc = C2 * DBG_FOXT; }
        else if (pn < 4)  { dst = (bf16*)(ws + WS_KF); pitch = 512; colt = (pn - 2) * 256; kvt = 1; }
        else if (pn < 6)  { dst = (bf16*)(ws + WS_VF); pitch = 512; colt = (pn - 4) * 256; kvt = 2; }
        else if (pn < 8)  { dst = (bf16*)(ws + WS_QN); pitch = 512; colt = (pn - 6) * 256; sc = C2 * DBG_NSAT; mode = 1; rope_bj1 = true; }
        else if (pn == 8) { dst = (bf16*)(ws + WS_KVC); pitch = 256; colt = 0; }
        else if (pn == 9) { dst = (bf16*)(ws + WS_KVS); pitch = 256; colt = 0; mode = 1; kvt = 3; nh = 2; }
        else if (pn == 10){ dst = (bf16*)(ws + WS_KVW); pitch = 256; colt = 0; mode = 1; kvt = 3; nh = 2; }
        else              { dst = (bf16*)(ws + WS_GM); pitch = 2048; colt = (pn - 12) * 256; mode = 2; }
        const int cb0 = wc * 32 + 8 * fq;
        const bool ropelane = ((wc & 1) == 0) && (fq < 2);
        const GAS f32x2* rt = (const GAS f32x2*)(ws + WS_ROPE);
#pragma unroll
        for (int ai = 0; ai < 2; ++ai)
#pragma unroll
            for (int m = 0; m < 4; ++m) { const int row = row0 + ai * 128 + m * 16; bf16* rowp = dst + (size_t)row * pitch + colt + cb0;
#pragma unroll
                for (int bj = 0; bj < 2; ++bj) { const f32x4 a0 = acc[ai][bj][m][0], a1 = acc[ai][bj][m][1];
                    float v[8] = {a0.x, a0.y, a0.z, a0.w, a1.x, a1.y, a1.z, a1.w};
                    if (mode == 1 && (bj == 0 || rope_bj1) && ((wc & 1) == 0)) {
                        const int pos = row & (SEQ - 1);
#pragma unroll
                        for (int i = 0; i < 8; ++i) { const float pv = __shfl_xor(v[i], 16); if (ropelane) { const f32x2 cs = rt[pos * 8 + i];
                                v[i] = (fq == 0) ? (v[i] * cs.x - pv * cs.y) : (pv * cs.y + v[i] * cs.x); } }
                    }
                    if (mode == 2) {
#pragma unroll
                        for (int i = 0; i < 8; ++i) v[i] = sigmoidf_(v[i]);
                    }
                    v4u w; w.x = pk2(v[0] * sc, v[1] * sc); w.y = pk2(v[2] * sc, v[3] * sc); w.z = pk2(v[4] * sc, v[5] * sc); w.w = pk2(v[6] * sc, v[7] * sc);
#ifdef DBG_C_INPROJ
                    w.x = COARSE2(w.x); w.y = COARSE2(w.y); w.z = COARSE2(w.z); w.w = COARSE2(w.w);
#endif
                    if (kvt == 0) *(GAS v4u*)(rowp + bj * 128) = w;
                    else {
                        const int bb = row >> 12, sq = row & (SEQ - 1), tile = sq >> 6, r = sq & 63;
                        const int col = (kvt == 3) ? cb0 : (colt + cb0 + bj * 128);
                        const int hh = col >> 6, d = col & 63; const bool isv = (kvt == 2) || (kvt == 3 && bj == 1);
                        unsigned char* img = (unsigned char*)dst + (isv && kvt == 3 ? 8 * MiB : 0) + ((size_t)((bb * nh + hh) * 64 + tile) << 13);
                        const int off = isv ? ((d >> 5) * 4096 + (r >> 4) * 1024 + (r & 15) * 64 + (d & 31) * 2) : ((d >> 3) * 1024 + r * 16);
                        *(GAS v4u*)(img + off) = w; } } }
        return false;
    }
};

__device__ __forceinline__ void p2_compress_unit(Frame& F, int uidx) {
    unsigned char* ws = F.ws; const int lane = F.lane, wid = F.wave, tid = F.tid;
    const int j = uidx & 1, nb = (uidx >> 1) & 15, g = (uidx >> 5) & 1, b = uidx >> 6;
    const bf16* KVC = (const bf16*)(ws + WS_KVC); const bf16* W1T = (const bf16*)(ws + WS_W1T) + (size_t)j * 128 * 2048; const bf16* W2T = (const bf16*)(ws + WS_W2T) + (size_t)j * 64 * 128;
    constexpr int APITCH = 4096 + 16;
    LAS unsigned char* aimg = F.lds;
    LAS bf16* h1b = (LAS bf16*)(F.lds + 32 * APITCH);
    const int fr = lane & 15, fq = lane >> 4;
    { v4u pc[16];
#pragma unroll
      for (int i = 0; i < 16; ++i) { const int p = tid + 512 * i, bs = p >> 12, n = (p >> 8) & 15, l = (p >> 3) & 31, c8 = p & 7; int nn = nb * 16 + n; nn = nn > 254 ? 254 : nn;
          pc[i] = *(const GAS v4u*)(KVC + ((size_t)(b + 4 * bs) * SEQ + 16 * nn + l) * 256 + j * 128 + g * 64 + c8 * 8); }
#pragma unroll
      for (int i = 0; i < 16; ++i) { const int p = tid + 512 * i, bs = p >> 12, n = (p >> 8) & 15, l = (p >> 3) & 31, c8 = p & 7;
          *(LAS v4u*)(aimg + (bs * 16 + n) * APITCH + l * 128 + c8 * 16) = pc[i]; } }
    const bf16* wrow = W1T + (size_t)(wid * 16 + fr) * 2048 + 8 * fq;
    bf16x8 bw[16];
#pragma unroll
    for (int s = 0; s < 16; ++s) bw[s] = *(const GAS bf16x8*)(wrow + 32 * s);
    bf16x8 w2f[4];
#pragma unroll
    for (int k2 = 0; k2 < 4; ++k2) w2f[k2] = *(const GAS bf16x8*)(W2T + (size_t)((wid & 3) * 16 + fr) * 128 + k2 * 32 + 8 * fq);
    __syncthreads();
    f32x4 acc0 = (f32x4){0.f, 0.f, 0.f, 0.f}, acc1 = acc0;
    const LAS unsigned char* ap0 = aimg + fr * APITCH + fq * 16; const LAS unsigned char* ap1 = ap0 + 16 * APITCH;
#pragma unroll
    for (int s0 = 0; s0 < 64; s0 += 16) {
#pragma unroll
        for (int q = 0; q < 16; ++q) { const int s = s0 + q;
            const bf16x8 a0 = *(const LAS bf16x8*)(ap0 + (s >> 1) * 128 + (s & 1) * 64), a1 = *(const LAS bf16x8*)(ap1 + (s >> 1) * 128 + (s & 1) * 64);
            acc0 = __builtin_amdgcn_mfma_f32_16x16x32_bf16(a0, bw[q], acc0, 0, 0, 0); acc1 = __builtin_amdgcn_mfma_f32_16x16x32_bf16(a1, bw[q], acc1, 0, 0, 0);
            if (s0 + 16 < 64) bw[q] = *(const GAS bf16x8*)(wrow + 32 * (s + 16)); } }
    { const float bias = ((const float*)(ws + WS_BIAS1))[j * 128 + wid * 16 + fr];
#pragma unroll
      for (int r = 0; r < 4; ++r) { h1b[(4 * fq + r) * 128 + wid * 16 + fr] = (bf16)(pk2(gelu_erf(acc0[r] + bias), 0.f) & 0xffffu); h1b[2048 + (4 * fq + r) * 128 + wid * 16 + fr] = (bf16)(pk2(gelu_erf(acc1[r] + bias), 0.f) & 0xffffu); } }
    __syncthreads();
    {
        const int u = wid >> 2, wq = wid & 3, bb = b + 4 * u;
        f32x4 a2 = (f32x4){0.f, 0.f, 0.f, 0.f};
#pragma unroll
        for (int k2 = 0; k2 < 4; ++k2) { const bf16x8 a = *(const LAS bf16x8*)(h1b + u * 2048 + fr * 128 + k2 * 32 + 8 * fq);
            a2 = __builtin_amdgcn_mfma_f32_16x16x32_bf16(a, w2f[k2], a2, 0, 0, 0); }
        bf16* dstb = (bf16*)(ws + (j == 0 ? WS_KCMP : WS_VCMP));
        const GAS f32x2* rt = (const GAS f32x2*)(ws + WS_ROPE);
#pragma unroll
        for (int r = 0; r < 4; ++r) { const int nrow = nb * 16 + 4 * fq + r; float v = a2[r];
            if (j == 0 && wq == 0 && DBG_KROPE >= 0) { const float pv = __shfl_xor(v, 8); const int pos = (16 * nrow + DBG_KROPE) & (SEQ - 1); const f32x2 cs = rt[pos * 8 + (fr & 7)];
                v = (fr < 8) ? (v * cs.x - pv * cs.y) : (pv * cs.y + v * cs.x); }
            if (nrow > 254) v = 0.f;
            dstb[((size_t)bb * 256 + nrow) * 128 + g * 64 + wq * 16 + fr] = (bf16)(pk2(v, 0.f) & 0xffffu); }
    }
    __syncthreads();
}
__device__ __forceinline__ void p2_cumsum_wave(Frame& F, int bh) {
    const int b = bh >> 3, h = bh & 7, lane = F.lane;
    const float* lf = (const float*)(F.ws + WS_LOGF) + ((size_t)b * SEQ + lane) * 8 + h;
    float v[64];
#pragma unroll
    for (int i = 0; i < 64; ++i) v[i] = lf[(size_t)i * 64 * 8];
    v2u* cum = (v2u*)(F.ws + WS_CUM) + (size_t)bh * SEQ + lane;
#pragma unroll
    for (int o = 1; o < 64; o <<= 1) { float t[64];
#pragma unroll
        for (int i = 0; i < 64; ++i) t[i] = __shfl_up(v[i], o);
        const bool take = lane >= o;
#pragma unroll
        for (int i = 0; i < 64; ++i) v[i] += take ? t[i] : 0.f; }
    float carry = 0.f;
#pragma unroll
    for (int i = 0; i < 64; ++i) { const float rowtot = __uint_as_float(__builtin_amdgcn_readlane(__float_as_uint(v[i]), 63)); const float x = v[i] + carry; carry += rowtot;
        { const float c = -LOG2E * DBG_DECAY * x; const unsigned h_ = pk2(c, 0.f) & 0xffffu; const float r1 = c - __uint_as_float(h_ << 16);
            const unsigned m_ = pk2(r1, 0.f) & 0xffffu; const float r2 = r1 - __uint_as_float(m_ << 16); const unsigned l_ = pk2(r2, 0.f) & 0xffffu;
            v2u w; w.x = h_ | (m_ << 16); w.y = l_ | 0x3F800000u; cum[i * 64] = w; } }
}

#include <hip/hip_bf16.h>
#include <cmath>
namespace fa {
using bf16=__hip_bfloat16;
using bf16x8=__attribute__((ext_vector_type(8)))short;
using s16x4=__attribute__((ext_vector_type(4)))short;
using f32x16=__attribute__((ext_vector_type(16)))float;
using u32x4=__attribute__((ext_vector_type(4)))unsigned;
typedef float f32x4_t __attribute__((ext_vector_type(4)));
constexpr int D=64;
constexpr int NW=8,QBLK=32,KVBLK=64;
__device__ __forceinline__ int crow(int r,int hi){return (r&3)+8*(r>>2)+4*hi;}
#define SBAR() __builtin_amdgcn_sched_barrier(0)
__device__ __forceinline__ void cmask(f32x16&p0,f32x16&p1,int jb,int qrel,int hi){
  const float NEG=-INFINITY; int kb=64*jb+4*hi;
  #pragma unroll
  for(int r=0;r<16;++r){int kv=kb+(r&3)+8*(r>>2); if(kv>qrel)p0[r]=NEG; if(kv+32>qrel)p1[r]=NEG;}
}

constexpr int NSLOT=3, SLOTB=8192;
constexpr int LDS_K=0, LDS_V=NSLOT*SLOTB, LDS_WS=2*NSLOT*SLOTB;
constexpr float C2=0.125f*1.4426950408889634f;
__device__ __forceinline__ void glds16(const void*gsrc,unsigned lds_dst){unsigned keep;
  asm volatile("s_mov_b32 %0, m0\n\ts_mov_b32 m0, %2\n\ts_nop 0\n\tglobal_load_lds_dwordx4 %1, off\n\ts_mov_b32 m0, %0":"=&s"(keep):"v"(gsrc),"s"(lds_dst):"memory");}
__device__ __forceinline__ float max3f(float a,float b,float c){float r;asm("v_max3_f32 %0, %1, %2, %3":"=v"(r):"v"(a),"v"(b),"v"(c));return r;}
__device__ __forceinline__ float max2f(float a,float b){float r;asm("v_max_f32_e32 %0, %1, %2":"=v"(r):"v"(a),"v"(b));return r;}
__device__ __forceinline__ float fadd_s(float a,float b){float r;asm("v_add_f32_e32 %0, %1, %2":"=v"(r):"v"(a),"v"(b));return r;}
__device__ __forceinline__ float fsub_s(float a,float b){float r;asm("v_sub_f32_e32 %0, %1, %2":"=v"(r):"v"(a),"v"(b));return r;}
typedef float f32x2_t __attribute__((ext_vector_type(2))); typedef __bf16 bf16x2_t __attribute__((ext_vector_type(2)));
__device__ __forceinline__ unsigned cvtpk_s(float lo,float hi){f32x2_t v={lo,hi};bf16x2_t b=__builtin_convertvector(v,bf16x2_t);return __builtin_bit_cast(unsigned,b);}
#define WAIT_BAR(N) asm volatile("s_waitcnt vmcnt(" #N ") lgkmcnt(0)\n\ts_barrier":::"memory")

__device__ __forceinline__ void qkt(f32x16&p0,f32x16&p1,const char*Kslot,const bf16x8*qr,s16x4 kxa,s16x4 kxb,s16x4 qx,int r32,int hi){
  const char*kb=Kslot+hi*1024+r32*16;
  p0=__builtin_amdgcn_mfma_f32_32x32x8bf16_1k(kxa,qx,(f32x16){0.f,0.f,0.f,0.f,0.f,0.f,0.f,0.f,0.f,0.f,0.f,0.f,0.f,0.f,0.f,0.f},0,0,0);
  p1=__builtin_amdgcn_mfma_f32_32x32x8bf16_1k(kxb,qx,(f32x16){0.f,0.f,0.f,0.f,0.f,0.f,0.f,0.f,0.f,0.f,0.f,0.f,0.f,0.f,0.f,0.f},0,0,0);
  #pragma unroll
  for(int d0=0;d0<4;++d0){
    const bf16x8 b0=*reinterpret_cast<const bf16x8*>(kb+d0*2048);
    const bf16x8 b1=*reinterpret_cast<const bf16x8*>(kb+d0*2048+512);
    p0=__builtin_amdgcn_mfma_f32_32x32x16_bf16(b0,qr[d0],p0,0,0,0);p1=__builtin_amdgcn_mfma_f32_32x32x16_bf16(b1,qr[d0],p1,0,0,0);}
}
__device__ __forceinline__ float refsplit(float t,unsigned&nh,unsigned&nl){ f32x2_t a={t,0.f}; const unsigned h=__builtin_bit_cast(unsigned,__builtin_convertvector(a,bf16x2_t))&0xffffu; const float fh=__uint_as_float(h<<16);
  f32x2_t b={t-fh,0.f}; const unsigned l=__builtin_bit_cast(unsigned,__builtin_convertvector(b,bf16x2_t))&0xffffu; nh=h^0x8000u; nl=l^0x8000u; return fh+__uint_as_float(l<<16); }
__device__ __forceinline__ s16x4 mkqx(unsigned nh,unsigned nl,int hi){ const unsigned w0=hi?0u:0x3F803F80u, w1=hi?(nl<<16):(0x3F80u|(nh<<16)); unsigned long long v=((unsigned long long)w1<<32)|w0; return __builtin_bit_cast(s16x4,v); }
typedef __attribute__((address_space(3))) const char* lds_cptr;
typedef short v4i16_t __attribute__((ext_vector_type(4)));
__device__ __forceinline__ void kload8(bf16x8*kf,lds_cptr kp){
  kf[0]=*(const __attribute__((address_space(3))) bf16x8*)(kp);      kf[1]=*(const __attribute__((address_space(3))) bf16x8*)(kp+512);
  kf[2]=*(const __attribute__((address_space(3))) bf16x8*)(kp+2048); kf[3]=*(const __attribute__((address_space(3))) bf16x8*)(kp+2560);
  kf[4]=*(const __attribute__((address_space(3))) bf16x8*)(kp+4096); kf[5]=*(const __attribute__((address_space(3))) bf16x8*)(kp+4608);
  kf[6]=*(const __attribute__((address_space(3))) bf16x8*)(kp+6144); kf[7]=*(const __attribute__((address_space(3))) bf16x8*)(kp+6656);
}
__device__ __forceinline__ void kload2(bf16x8*kf,lds_cptr kp,int j){ kf[2*j]=*(const __attribute__((address_space(3))) bf16x8*)(kp+j*2048); kf[2*j+1]=*(const __attribute__((address_space(3))) bf16x8*)(kp+j*2048+512); }
__device__ __forceinline__ s16x4 vtr(lds_cptr p){ return __builtin_bit_cast(s16x4,__builtin_amdgcn_ds_read_tr16_b64_v4i16((__attribute__((address_space(3))) v4i16_t*)p)); }
__device__ __forceinline__ float rowmax(const f32x16&p0,const f32x16&p1){
  float a=max3f(p0[0],p0[1],p1[0]),b=max3f(p0[2],p0[3],p1[1]);a=max3f(a,p1[2],p1[3]);
  #pragma unroll
  for(int r=4;r<16;r+=4){a=max3f(a,p0[r],p0[r+1]);b=max3f(b,p0[r+2],p0[r+3]);a=max3f(a,p1[r],p1[r+1]);b=max3f(b,p1[r+2],p1[r+3]);}
  const float m=max2f(a,b);
  auto rr=__builtin_amdgcn_permlane32_swap(__float_as_uint(m),__float_as_uint(m),false,false);
  return max2f(__uint_as_float(rr[0]),__uint_as_float(rr[1]));
}
__device__ __forceinline__ void pv(f32x16*o,int vb,bf16x8 pa0,bf16x8 pa1,bf16x8 pa2,bf16x8 pa3){
  #pragma unroll
  for(int d0=0;d0<2;++d0){s16x4 lo[4],hi[4];
    #pragma unroll
    for(int ks=0;ks<4;++ks){
      asm volatile("ds_read_b64_tr_b16 %0,%1 offset:%c2":"=&v"(lo[ks]):"v"(vb),"i"(d0*4096+ks*1024):"memory");
      asm volatile("ds_read_b64_tr_b16 %0,%1 offset:%c2":"=&v"(hi[ks]):"v"(vb),"i"(d0*4096+ks*1024+512):"memory");}
    asm volatile("s_waitcnt lgkmcnt(0)":::"memory");SBAR();
    #define PK(k) (bf16x8){lo[k][0],lo[k][1],lo[k][2],lo[k][3],hi[k][0],hi[k][1],hi[k][2],hi[k][3]}
    o[d0]=__builtin_amdgcn_mfma_f32_32x32x16_bf16(pa0,PK(0),o[d0],0,0,0);
    o[d0]=__builtin_amdgcn_mfma_f32_32x32x16_bf16(pa1,PK(1),o[d0],0,0,0);
    o[d0]=__builtin_amdgcn_mfma_f32_32x32x16_bf16(pa2,PK(2),o[d0],0,0,0);
    o[d0]=__builtin_amdgcn_mfma_f32_32x32x16_bf16(pa3,PK(3),o[d0],0,0,0);
    #undef PK
  }
}

#ifndef ATTN_STORE16
#define ATTN_STORE16(p,v) (*(u32x4*)(p)=(v))
#endif
template<int MODE,int THRL> __device__ __forceinline__ void run(const bf16*Qw,int qpitch,const bf16*__restrict__ Kh,const bf16*__restrict__ Vh,int kvpitch,int tbase,int tdir,int NT,int NTreal,
    int qpos,int q0w,int QBk,unsigned long long selm,unsigned long long um,const float*cbl,char*shm,f32x16(&o)[2],float&l_out){
  const int tid=threadIdx.x,lane=tid&63,r32=lane&31,hi=lane>>5; const int wid=__builtin_amdgcn_readfirstlane(tid>>6);
  #define TIDX(t) ({int ti_=tbase+tdir*(t); ti_=ti_<0?0:(ti_>63?63:ti_); ti_;})
  unsigned long long mK=um,mV=um,mC=um; int nK=0,nV=0,nC=0;
  #define POPT(M_,N_) ({ int ti_; if(MODE==3){ ti_=(M_)?(int)__builtin_ctzll(M_):0; M_&=(M_)-1ull; } else { ti_=TIDX(N_); ++(N_); } ti_; })
  const unsigned lds0=(unsigned)(uintptr_t)shm;
  float*wsf=(float*)(shm+LDS_WS)+wid*64;
  const bf16*ksrc=Kh+wid*512+lane*8;
  const bf16*vsrc=Vh+wid*512+lane*8;
  const unsigned kdst=lds0+LDS_K+wid*1024, vdst=lds0+LDS_V+wid*1024;
  #define DMA_K(t,slot) do{ const int tk_=POPT(mK,nK); glds16(ksrc+(long)tk_*4096,(unsigned)__builtin_amdgcn_readfirstlane(kdst+(slot))); }while(0)
  #define DMA_V(t,slot) do{ const int tv_=POPT(mV,nV); glds16(vsrc+(long)tv_*4096,(unsigned)__builtin_amdgcn_readfirstlane(vdst+(slot))); }while(0)
  const int vb0=(int)(lds0+LDS_V)+((lane>>4)&1)*32+(lane&3)*8+(4*hi+((lane&15)>>2))*64;
  const char*Kbase=shm+LDS_K; bf16x8 kf[8];
  const lds_cptr shm3=(lds_cptr)shm; const lds_cptr kp0=shm3+LDS_K+hi*1024+r32*16; const lds_cptr vp0=shm3+LDS_V+((lane>>4)&1)*32+(lane&3)*8+(4*hi+((lane&15)>>2))*64;
  DMA_K(0,0);DMA_V(0,0);DMA_K(1,SLOTB);
  bf16x8 qr[4];
  #pragma unroll
  for(int d0=0;d0<4;++d0)qr[d0]=*reinterpret_cast<const bf16x8*>(&Qw[(long)r32*qpitch+d0*16+hi*8]);
  float mhat=0.f,l_reg=0.f;o[0]=f32x16{};o[1]=f32x16{};
  const lds_cptr kxl3=(lds_cptr)shm+(MODE==0?(int)((const char*)cbl-shm):0)+r32*8; s16x4 kxa,kxb,qx=mkqx(0x8000u,0x8000u,hi);
  if(MODE!=0){ kxa=__builtin_bit_cast(s16x4,0x3F80000000000000ull); kxb=kxa; }
  #define KXRD(tt) do{ if(MODE==0){ const __attribute__((address_space(3))) s16x4*p_=(const __attribute__((address_space(3))) s16x4*)(kxl3+512*TIDX(tt)); kxa=p_[0]; kxb=p_[32]; } }while(0)
  int tcur=0; s16x4 qxu;
  #define QXSEL(t) do{ tcur=POPT(mC,nC); qxu=qx; if(MODE==3){ const bool sel_=(((selm>>tcur)&1ull)!=0ull)&&((t)<NTreal); if(!sel_){ unsigned long long v_=__builtin_bit_cast(unsigned long long,qx); \
      v_=(v_&0xffffffffull)|((unsigned long long)(hi?0u:0xFF003F80u)<<32); qxu=__builtin_bit_cast(s16x4,v_); } } }while(0)
  #define CMASK(P0,P1,t) do{ const int ta_=tcur; const int kvb_=64*ta_+4*hi; \
    if(MODE==0){ \
      if(64*ta_+63>q0w){ _Pragma("unroll") for(int r=0;r<16;++r){ const int kv_=kvb_+(r&3)+8*(r>>2); if(kv_>qpos)P0[r]=-INFINITY; if(kv_+32>qpos)P1[r]=-INFINITY; } } } \
    if(MODE==3){ \
      if(ta_==QBk){ _Pragma("unroll") for(int r=0;r<16;++r){ const int kv_=kvb_+(r&3)+8*(r>>2); if(kv_>qpos)P0[r]=-INFINITY; if(kv_+32>qpos)P1[r]=-INFINITY; } } } \
    if(MODE==4){ const bool vl_=((t)<NTreal); if(!vl_||ta_==QBk||ta_+8==QBk){ \
      _Pragma("unroll") for(int r=0;r<16;++r){ const int kv_=kvb_+(r&3)+8*(r>>2); if(!vl_||kv_>qpos||qpos-kv_>=512)P0[r]=-INFINITY; if(!vl_||kv_+32>qpos||qpos-(kv_+32)>=512)P1[r]=-INFINITY; } } } \
  }while(0)
  bool resc=false;
  #define START(P0,P1) do{ const float rm=rowmax(P0,P1); resc=false; \
    { unsigned nh_,nl_; const float dl=refsplit(rm>-1e30f?rm:0.f,nh_,nl_); mhat=dl; qx=mkqx(nh_,nl_,hi); \
      _Pragma("unroll") for(int r=0;r<16;++r){P0[r]=fsub_s(P0[r],dl);P1[r]=fsub_s(P1[r],dl);} \
      } \
    _Pragma("unroll") for(int r=0;r<16;++r)P0[r]=__builtin_amdgcn_exp2f(P0[r]); }while(0)
  #define RESC() do{ if(resc){ asm volatile("s_waitcnt lgkmcnt(0)":::"memory"); \
      _Pragma("unroll") for(int d_=0;d_<2;++d_) _Pragma("unroll") for(int r=0;r<16;++r)o[d_][r]*=wsf[crow(r,hi)]; } }while(0)
  f32x16 pA0,pA1,pB0,pB1;
  int sl_prev=0,sl_cur=0,sl_next=SLOTB;
  #define ROT() do{sl_prev=sl_cur;sl_cur=sl_next;sl_next=(sl_next==(NSLOT-1)*SLOTB)?0:sl_next+SLOTB;}while(0)
  DMA_K(2,2*SLOTB);
  WAIT_BAR(3);
  KXRD(0); QXSEL(0); qkt(pA0,pA1,Kbase,qr,kxa,kxb,qxu,r32,hi);asm volatile("s_nop 15\n\ts_nop 7":"+v"(pA0),"+v"(pA1));CMASK(pA0,pA1,0);
  START(pA0,pA1);
  _Pragma("unroll") for(int r=0;r<16;++r)pA1[r]=__builtin_amdgcn_exp2f(pA1[r]);
  WAIT_BAR(0);
  DMA_K(3,0);DMA_V(1,SLOTB);
  ROT();
  kload8(kf,kp0+sl_cur); KXRD(1);
  WAIT_BAR(2);
  if(NT<=2){ WAIT_BAR(0); }
  s16x4 vlo[8],vhi[8]; u32x4 pw0,pw1,pw2,pw3;
  #define PKW(P,B) cvtpk_s(P[B],P[B+1])
  #define PAF(k) __builtin_bit_cast(bf16x8,pw##k)
  #define VFR(i) (bf16x8){vlo[i][0],vlo[i][1],vlo[i][2],vlo[i][3],vhi[i][0],vhi[i][1],vhi[i][2],vhi[i][3]}
  #define PIN(x) asm volatile("":"+v"(x))
  #define MX3(a,b,c) __builtin_fmaxf(__builtin_fmaxf((a),(b)),(c))
  #define GAPA(MF,A0,A1,A2,A3,W0,W1,PW) do{ MF; sacc+=A0; sacc+=A1; sacc+=A2; sacc+=A3; PIN(sacc); W0; W1; PIN(PW); SBAR(); }while(0)
  #define EX(v) __builtin_amdgcn_exp2f(v)
  #define GAPB(MF,X,B) do{ MF; X[B]=EX(X[B]); X[B+1]=EX(X[B+1]); X[B+2]=EX(X[B+2]); X[B+3]=EX(X[B+3]); PIN(X); SBAR(); }while(0)
  #define VRD(i) do{ vlo[i]=vtr(vp_+(((i)>>2)*4096+((i)&3)*1024)); vhi[i]=vtr(vp_+(((i)>>2)*4096+((i)&3)*1024+512)); }while(0)
  #define KRD(G,j) do{ if(G){ kload2(kf,kp0+sl_next,j); SBAR(); } }while(0)
  #define STEP(C0,C1,P0,P1,t,GK,GV,GL) do{ SBAR(); \
    const lds_cptr vp_=vp0+sl_prev; \
    QXSEL(t); \
    C0=__builtin_amdgcn_mfma_f32_32x32x8bf16_1k(kxa,qxu,(f32x16){0.f,0.f,0.f,0.f,0.f,0.f,0.f,0.f,0.f,0.f,0.f,0.f,0.f,0.f,0.f,0.f},0,0,0); \
    C1=__builtin_amdgcn_mfma_f32_32x32x8bf16_1k(kxb,qxu,(f32x16){0.f,0.f,0.f,0.f,0.f,0.f,0.f,0.f,0.f,0.f,0.f,0.f,0.f,0.f,0.f,0.f},0,0,0); \
    VRD(0); SBAR(); float sacc=(P0[0]+P0[1]); \
    GAPA(C0=__builtin_amdgcn_mfma_f32_32x32x16_bf16(kf[0],qr[0],C0,0,0,0), P0[2],P0[3],P0[4],P0[5],     pw0[0]=PKW(P0,0), pw0[1]=PKW(P0,2), pw0); \
    VRD(4); SBAR(); GAPA(C1=__builtin_amdgcn_mfma_f32_32x32x16_bf16(kf[1],qr[0],C1,0,0,0), P0[6],P0[7],P0[8],P0[9],     pw0[2]=PKW(P0,4), pw0[3]=PKW(P0,6), pw0); \
    VRD(1); SBAR(); GAPA(C0=__builtin_amdgcn_mfma_f32_32x32x16_bf16(kf[2],qr[1],C0,0,0,0),   P0[10],P0[11],P0[12],P0[13], pw1[0]=PKW(P0,8), pw1[1]=PKW(P0,10), pw1); \
    VRD(5); SBAR(); GAPA(C1=__builtin_amdgcn_mfma_f32_32x32x16_bf16(kf[3],qr[1],C1,0,0,0),   P0[14],P0[15],P1[0],P1[1],   pw1[2]=PKW(P0,12),pw1[3]=PKW(P0,14), pw1); \
    VRD(2); SBAR(); GAPA(C0=__builtin_amdgcn_mfma_f32_32x32x16_bf16(kf[4],qr[2],C0,0,0,0),   P1[2],P1[3],P1[4],P1[5],     pw2[0]=PKW(P1,0), pw2[1]=PKW(P1,2), pw2); \
    VRD(6); SBAR(); GAPA(C1=__builtin_amdgcn_mfma_f32_32x32x16_bf16(kf[5],qr[2],C1,0,0,0),   P1[6],P1[7],P1[8],P1[9],     pw2[2]=PKW(P1,4), pw2[3]=PKW(P1,6), pw2); \
    VRD(3); SBAR(); GAPA(C0=__builtin_amdgcn_mfma_f32_32x32x16_bf16(kf[6],qr[3],C0,0,0,0),   P1[10],P1[11],P1[12],P1[13], pw3[0]=PKW(P1,8), pw3[1]=PKW(P1,10), pw3); \
    VRD(7); SBAR(); GAPA(C1=__builtin_amdgcn_mfma_f32_32x32x16_bf16(kf[7],qr[3],C1,0,0,0),   P1[14],P1[15],0.f,0.f,       pw3[2]=PKW(P1,12),pw3[3]=PKW(P1,14), pw3); \
    l_reg+=sacc; \
    if(GK){DMA_K((t)+3,sl_cur);} if(GV){DMA_V((t)+1,sl_next);} \
    CMASK(C0,C1,t); \
    { float a=MX3(C0[0],C0[1],C1[0]),b=MX3(C0[2],C0[3],C1[1]); a=MX3(a,C1[2],C1[3]); \
      _Pragma("unroll") for(int r=4;r<16;r+=4){a=MX3(a,C0[r],C0[r+1]);b=MX3(b,C0[r+2],C0[r+3]);a=MX3(a,C1[r],C1[r+1]);b=MX3(b,C1[r+2],C1[r+3]);} \
      float rm=__builtin_fmaxf(a,b); { auto rr=__builtin_amdgcn_permlane32_swap(__float_as_uint(rm),__float_as_uint(rm),false,false); rm=__builtin_fmaxf(__uint_as_float(rr[0]),__uint_as_float(rr[1])); } \
      resc=false; \
      if(__builtin_expect(__any(rm>(float)THRL),0)){ unsigned nh_,nl_; const float mn_=refsplit(mhat+__builtin_fmaxf(rm,0.f),nh_,nl_); const float dl=mn_-mhat; mhat=mn_; qx=mkqx(nh_,nl_,hi); \
        _Pragma("unroll") for(int r=0;r<16;++r){C0[r]-=dl;C1[r]-=dl;} \
        const float f=__builtin_amdgcn_exp2f(-dl); l_reg*=f; if(hi==0)wsf[r32]=f; resc=true; } } \
    SBAR(); \
    GAPB(o[0]=__builtin_amdgcn_mfma_f32_32x32x16_bf16(PAF(0),VFR(0),o[0],0,0,0), C0,0); \
    GAPB(o[1]=__builtin_amdgcn_mfma_f32_32x32x16_bf16(PAF(0),VFR(4),o[1],0,0,0), C0,4); \
    if(GL){KXRD((t)+1);} KRD(GL,0); GAPB(o[0]=__builtin_amdgcn_mfma_f32_32x32x16_bf16(PAF(1),VFR(1),o[0],0,0,0), C0,8); \
    KRD(GL,1); GAPB(o[1]=__builtin_amdgcn_mfma_f32_32x32x16_bf16(PAF(1),VFR(5),o[1],0,0,0), C0,12); \
    KRD(GL,2); GAPB(o[0]=__builtin_amdgcn_mfma_f32_32x32x16_bf16(PAF(2),VFR(2),o[0],0,0,0), C1,0); \
    KRD(GL,3); GAPB(o[1]=__builtin_amdgcn_mfma_f32_32x32x16_bf16(PAF(2),VFR(6),o[1],0,0,0), C1,4); \
    GAPB(o[0]=__builtin_amdgcn_mfma_f32_32x32x16_bf16(PAF(3),VFR(3),o[0],0,0,0), C1,8); \
    GAPB(o[1]=__builtin_amdgcn_mfma_f32_32x32x16_bf16(PAF(3),VFR(7),o[1],0,0,0), C1,12); \
    }while(0)
  int t=1;
  for(;t+5<NT;t+=2){
    STEP(pB0,pB1,pA0,pA1,t,true,true,true);     WAIT_BAR(2); RESC(); ROT();
    STEP(pA0,pA1,pB0,pB1,t+1,true,true,true);   WAIT_BAR(2); RESC(); ROT();
  }
  #define ENDW(tt) do{ if((tt)+3<NT){WAIT_BAR(2);} else if((tt)+2<NT){WAIT_BAR(1);} else {WAIT_BAR(0);} }while(0)
  for(;t+1<NT;t+=2){
    STEP(pB0,pB1,pA0,pA1,t,(t+3<NT),(t+1<NT),(t+1<NT));       ENDW(t);   RESC(); ROT();
    STEP(pA0,pA1,pB0,pB1,t+1,(t+4<NT),(t+2<NT),(t+2<NT));     ENDW(t+1); RESC(); ROT();
  }
  STEP(pB0,pB1,pA0,pA1,NT-1,false,false,false); RESC();
  { float sacc=pB0[0]+pB0[1]; _Pragma("unroll") for(int r=2;r<16;++r)sacc+=pB0[r]; _Pragma("unroll") for(int r=0;r<16;++r)sacc+=pB1[r]; l_reg+=sacc;
    pw0=(u32x4){PKW(pB0,0),PKW(pB0,2),PKW(pB0,4),PKW(pB0,6)};pw1=(u32x4){PKW(pB0,8),PKW(pB0,10),PKW(pB0,12),PKW(pB0,14)};pw2=(u32x4){PKW(pB1,0),PKW(pB1,2),PKW(pB1,4),PKW(pB1,6)};pw3=(u32x4){PKW(pB1,8),PKW(pB1,10),PKW(pB1,12),PKW(pB1,14)};
    SBAR(); pv(o,vb0+sl_cur,PAF(0),PAF(1),PAF(2),PAF(3)); }
  #undef PKW
  #undef PAF
  #undef VFR
  #undef PIN
  #undef MX3
  #undef GAPA
  #undef GAPB
  #undef EX
  #undef VRD
  #undef KRD
  #undef STEP
  #undef ENDW
  {auto rr=__builtin_amdgcn_permlane32_swap(__float_as_uint(l_reg),__float_as_uint(l_reg),false,false);l_out=__uint_as_float(rr[0])+__uint_as_float(rr[1]);}
  asm volatile("s_waitcnt vmcnt(0) lgkmcnt(0)\n\ts_barrier":::"memory");
  #undef KXRD
  #undef QXSEL
  #undef POPT
  #undef DMA_K
  #undef DMA_V
  #undef CMASK
  #undef START
  #undef RESC
  #undef ROT
  #undef TIDX
}
#undef SBAR
#undef WAIT_BAR
}
namespace att {
constexpr int A_K = 0, A_V = 32768, A_WS = 65536, A_OST = 0  , A_BIG = 67584, A_SEL = 133120, SLOT = 16384  ;
typedef LAS const char* lds_cptr;
typedef short v4i16_t __attribute__((ext_vector_type(4)));
#define MFMA32(a, b, c) __builtin_amdgcn_mfma_f32_32x32x16_bf16(a, b, c, 0, 0, 0)
__device__ __forceinline__ int crow(int r, int hi) { return (r & 3) + 8 * (r >> 2) + 4 * hi; }
__device__ __forceinline__ void glds16(const void* g, unsigned lds_base) {
    unsigned sv; asm volatile("s_mov_b32 %0, m0\n\ts_mov_b32 m0, %2\n\ts_nop 0\n\tglobal_load_lds_dwordx4 %1, off\n\ts_mov_b32 m0, %0" : "=&s"(sv) : "v"(g), "s"(lds_base) : "memory"); }
__device__ __forceinline__ s16x4 vtr(lds_cptr p) { return __builtin_bit_cast(s16x4, __builtin_amdgcn_ds_read_tr16_b64_v4i16((LAS v4i16_t*)p)); }
#define MX3(a, b, c) __builtin_fmaxf(__builtin_fmaxf((a), (b)), (c))
__device__ __forceinline__ float rowmax(const f32x16& p0, const f32x16& p1) {
    float a = MX3(p0[0], p0[1], p1[0]), b = MX3(p0[2], p0[3], p1[1]); a = MX3(a, p1[2], p1[3]);
#pragma unroll
    for (int r = 4; r < 16; r += 4) { a = MX3(a, p0[r], p0[r + 1]); b = MX3(b, p0[r + 2], p0[r + 3]); a = MX3(a, p1[r], p1[r + 1]); b = MX3(b, p1[r + 2], p1[r + 3]); }
    float m = __builtin_fmaxf(a, b); auto rr = __builtin_amdgcn_permlane32_swap(__float_as_uint(m), __float_as_uint(m), false, false);
    return __builtin_fmaxf(__uint_as_float(rr[0]), __uint_as_float(rr[1])); }

enum { M_FOX = 0, M_CMP1 = 1, M_CMP2 = 2, M_SLC = 3, M_WIN = 4 };
struct St { f32x16 o[2]; float mref, l; };

template <int MODE>
__device__ __forceinline__ void tile_step(LAS unsigned char* lds, int sub_off, const bf16x8 (&qr)[4], St& st, float rl, int t, int qpos, int q0w, int QBk,
                                          unsigned long long selm, LAS float* wsf, LAS float* impw, const LAS float* cbl, int lane, int r32, int hi, float& icarry) {
    const lds_cptr kp = (lds_cptr)lds + A_K + sub_off + hi * 1024 + r32 * 16;
    bf16x8 kf[8];
#pragma unroll
    for (int d0 = 0; d0 < 4; ++d0) { kf[2 * d0] = *(const LAS bf16x8*)(kp + d0 * 2048); kf[2 * d0 + 1] = *(const LAS bf16x8*)(kp + d0 * 2048 + 512); }
    float ci = -st.mref;
    if (MODE == M_SLC) { if (!((selm >> t) & 1ull)) ci = -INFINITY; }
    f32x16 s0, s1;
    { f32x16 c0;
#pragma unroll
      for (int r = 0; r < 16; ++r) c0[r] = ci;
      s0 = MFMA32(kf[0], qr[0], c0); s1 = MFMA32(kf[1], qr[0], c0); }
#pragma unroll
    for (int d0 = 1; d0 < 4; ++d0) { s0 = MFMA32(kf[2 * d0], qr[d0], s0); s1 = MFMA32(kf[2 * d0 + 1], qr[d0], s1); }
    const float NEG = -INFINITY; const int kvb = 64 * t + 4 * hi;
    if (MODE == M_CMP1 || MODE == M_CMP2) { if (16 * (64 * t + 63) + 31 > q0w) {
#pragma unroll
            for (int r = 0; r < 16; ++r) { const int n = kvb + (r & 3) + 8 * (r >> 2); if (16 * n + 31 > qpos) s0[r] = NEG; if (16 * (n + 32) + 31 > qpos) s1[r] = NEG; } } }
    if (MODE == M_SLC) { if (t == QBk) {
#pragma unroll
            for (int r = 0; r < 16; ++r) { const int kv = kvb + (r & 3) + 8 * (r >> 2); if (kv > qpos) s0[r] = NEG; if (kv + 32 > qpos) s1[r] = NEG; } } }
    if (MODE == M_WIN) { if (t == QBk || t + 8 == QBk) {
#pragma unroll
            for (int r = 0; r < 16; ++r) { const int kv = kvb + (r & 3) + 8 * (r >> 2); if (kv > qpos || qpos - kv >= 512) s0[r] = NEG; if (kv + 32 > qpos || qpos - (kv + 32) >= 512) s1[r] = NEG; } } }
    if (MODE != M_CMP2) {
        const float rm = rowmax(s0, s1);
        if (__any(rm > 8.0f)) {
            const float dl = fmaxf(rm, 0.f), alpha = __builtin_amdgcn_exp2f(-dl); st.l *= alpha; st.mref += dl;
#pragma unroll
            for (int r = 0; r < 16; ++r) { s0[r] -= dl; s1[r] -= dl; }
            if (MODE != M_CMP1) { if (hi == 0) wsf[r32] = alpha; LDS_WAIT();
#pragma unroll
                for (int r = 0; r < 16; ++r) { const float f = wsf[crow(r, hi)]; st.o[0][r] *= f; st.o[1][r] *= f; }
                LDS_WAIT(); }
        }
    }
    if (MODE == M_SLC || MODE == M_WIN) {
        const lds_cptr vq = (lds_cptr)lds + A_V + sub_off + ((lane >> 4) & 1) * 32 + (lane & 3) * 8 + (4 * hi + ((lane & 15) >> 2)) * 64;
        float qs0 = 0.f, qs1 = 0.f, qs2 = 0.f, qs3 = 0.f;
#pragma unroll
        for (int ks = 0; ks < 4; ++ks) {
            float e[8];
#pragma unroll
            for (int j = 0; j < 8; ++j) e[j] = __builtin_amdgcn_exp2f(ks < 2 ? s0[(ks & 1) * 8 + j] : s1[(ks & 1) * 8 + j]);
            qs0 += e[0] + e[4]; qs1 += e[1] + e[5]; qs2 += e[2] + e[6]; qs3 += e[3] + e[7];
            const v4u pq = (v4u){pk2(e[0], e[1]), pk2(e[2], e[3]), pk2(e[4], e[5]), pk2(e[6], e[7])};
#pragma unroll
            for (int d0 = 0; d0 < 2; ++d0) { const s16x4 lo = vtr(vq + d0 * 4096 + ks * 1024), hh = vtr(vq + d0 * 4096 + ks * 1024 + 512);
                const bf16x8 vf = (bf16x8){lo[0], lo[1], lo[2], lo[3], hh[0], hh[1], hh[2], hh[3]};
                st.o[d0] = MFMA32(__builtin_bit_cast(bf16x8, pq), vf, st.o[d0]); }
            __builtin_amdgcn_sched_barrier(0);
        }
        st.l += (qs0 + qs1) + (qs2 + qs3);
        return;
    }
    float ps0 = 0.f, ps1 = 0.f, ps2 = 0.f, ps3 = 0.f;
#pragma unroll
    for (int r = 0; r < 16; r += 2) { s0[r] = __builtin_amdgcn_exp2f(s0[r]); s1[r] = __builtin_amdgcn_exp2f(s1[r]); s0[r + 1] = __builtin_amdgcn_exp2f(s0[r + 1]); s1[r + 1] = __builtin_amdgcn_exp2f(s1[r + 1]);
        ps0 += s0[r]; ps1 += s1[r]; ps2 += s0[r + 1]; ps3 += s1[r + 1]; }
    if (MODE != M_CMP2) st.l += (ps0 + ps1) + (ps2 + ps3);
    if (MODE == M_CMP1) return;
    if (MODE == M_CMP2) {
#pragma unroll
        for (int r = 0; r < 16; ++r) { s0[r] *= rl; s1[r] *= rl; }
        float a0[4], a1[4], ob0[4], ob1[4];
#pragma unroll
        for (int g = 0; g < 4; ++g) {
            const float b0 = 0.5f * s0[4 * g + 3], b1 = 0.5f * s1[4 * g + 3];
            a0[g] = s0[4 * g] + s0[4 * g + 1] + s0[4 * g + 2] + b0; a1[g] = s1[4 * g] + s1[4 * g + 1] + s1[4 * g + 2] + b1;
            auto r0_ = __builtin_amdgcn_permlane32_swap(__float_as_uint(b0), __float_as_uint(b0), false, false); auto r1_ = __builtin_amdgcn_permlane32_swap(__float_as_uint(b1), __float_as_uint(b1), false, false);
            ob0[g] = __uint_as_float(hi ? r0_[0] : r0_[1]); ob1[g] = __uint_as_float(hi ? r1_[0] : r1_[1]); }
        { const int qrow = qpos & 63;
          LAS float* ib = impw - qrow;
#pragma unroll
          for (int g = 0; g < 4; ++g) {
              const int j0 = 16 * t + 2 * g + hi, j1 = j0 + 8;
              const float in0 = hi ? ob0[g] : (g > 0 ? ob0[g - 1] : icarry), in1 = hi ? ob1[g] : (g > 0 ? ob1[g - 1] : ob0[3]);
              ib[j0 * 64 + (qrow ^ j0)] = a0[g] + in0; ib[j1 * 64 + (qrow ^ j1)] = a1[g] + in1; }
          icarry = ob1[3]; }
    }
    v4u pw[4];
    pw[0] = (v4u){pk2(s0[0], s0[1]), pk2(s0[2], s0[3]), pk2(s0[4], s0[5]), pk2(s0[6], s0[7])};
    pw[1] = (v4u){pk2(s0[8], s0[9]), pk2(s0[10], s0[11]), pk2(s0[12], s0[13]), pk2(s0[14], s0[15])};
    pw[2] = (v4u){pk2(s1[0], s1[1]), pk2(s1[2], s1[3]), pk2(s1[4], s1[5]), pk2(s1[6], s1[7])};
    pw[3] = (v4u){pk2(s1[8], s1[9]), pk2(s1[10], s1[11]), pk2(s1[12], s1[13]), pk2(s1[14], s1[15])};
#ifdef DBG_C_P
#pragma unroll
    for (int i_ = 0; i_ < 4; ++i_) { pw[i_].x = COARSE2(pw[i_].x); pw[i_].y = COARSE2(pw[i_].y); pw[i_].z = COARSE2(pw[i_].z); pw[i_].w = COARSE2(pw[i_].w); }
#endif
    const lds_cptr vp = (lds_cptr)lds + A_V + sub_off + ((lane >> 4) & 1) * 32 + (lane & 3) * 8 + (4 * hi + ((lane & 15) >> 2)) * 64;
#pragma unroll
    for (int d0 = 0; d0 < 2; ++d0)
#pragma unroll
        for (int ks = 0; ks < 4; ++ks) { const s16x4 lo = vtr(vp + d0 * 4096 + ks * 1024), hh = vtr(vp + d0 * 4096 + ks * 1024 + 512);
            const bf16x8 vf = (bf16x8){lo[0], lo[1], lo[2], lo[3], hh[0], hh[1], hh[2], hh[3]};
            st.o[d0] = MFMA32(__builtin_bit_cast(bf16x8, pw[ks]), vf, st.o[d0]); }
}

template <int MODE>
__device__ __forceinline__ void run_tiles(LAS unsigned char* lds, unsigned long long tm, const bf16* kbase, const bf16* vbase, int pitch, const bf16x8 (&qr)[4], St& st, float rl,
                                          int qpos, int q0w, int QBk, unsigned long long selm, LAS float* wsf, LAS float* impw, const LAS float* cbl, int lane, int r32, int hi, int wid) {
    const unsigned lds0 = (unsigned)(uintptr_t)lds; float icarry = 0.f;
    const bool tiled = (pitch == 0); const size_t tstep = tiled ? 4096 : (size_t)64 * pitch;
    const bf16* ksrc = tiled ? kbase + wid * 512 + lane * 8 : kbase + (size_t)lane * pitch + wid * 8;
    const bf16* vsrc = tiled ? vbase + wid * 512 + lane * 8 : vbase + (size_t)(16 * (wid & 3) + (lane >> 2)) * pitch + (wid >> 2) * 32 + (lane & 3) * 8;
    const unsigned kdst = lds0 + A_K + wid * 1024, vdst = lds0 + A_V + wid * 1024;
    if (tm == 0ull) return;
    unsigned pm = 0u;
#pragma unroll
    for (int p = 0; p < 32; ++p) pm |= (((tm >> (2 * p)) & 3ull) != 0ull) ? (1u << p) : 0u;
#define ATT_ISSUE_PAIR(P, S) do { _Pragma("unroll") for (int a_ = 0; a_ < 2; ++a_) { const int tt_ = 2 * (P) + a_; if ((tm >> tt_) & 1ull) { \
            glds16(ksrc + (size_t)tt_ * tstep, (unsigned)__builtin_amdgcn_readfirstlane(kdst + (S) * SLOT + a_ * 8192)); \
            if (MODE != M_CMP1) glds16(vsrc + (size_t)tt_ * tstep, (unsigned)__builtin_amdgcn_readfirstlane(vdst + (S) * SLOT + a_ * 8192)); } } } while (0)
    int p = __builtin_ctz(pm); pm &= pm - 1u; int sl = 0;
    ATT_ISSUE_PAIR(p, 0);
    for (;;) {
        VM_WAIT(); __syncthreads();
        int pn = -1;
        if (pm != 0u) { pn = __builtin_ctz(pm); pm &= pm - 1u; ATT_ISSUE_PAIR(pn, sl ^ 1); }
        if ((tm >> (2 * p)) & 1ull) tile_step<MODE>(lds, sl * SLOT, qr, st, rl, 2 * p, qpos, q0w, QBk, selm, wsf, impw, cbl, lane, r32, hi, icarry);
        if ((tm >> (2 * p + 1)) & 1ull) tile_step<MODE>(lds, sl * SLOT + 8192, qr, st, rl, 2 * p + 1, qpos, q0w, QBk, selm, wsf, impw, cbl, lane, r32, hi, icarry);
        if (pn < 0) break;
        p = pn; sl ^= 1;
    }
#undef ATT_ISSUE_PAIR
    LDS_WAIT(); __syncthreads();
}
__device__ __forceinline__ void st_init(St& st) {
#pragma unroll
    for (int r = 0; r < 16; ++r) { st.o[0][r] = 0.f; st.o[1][r] = 0.f; }
    st.mref = 0.f; st.l = 0.f;
}
__device__ __forceinline__ void store_o(LAS unsigned char* lds, const f32x16 (&o)[2], const float (&rli)[16], bf16* Ow, int lane, int r32, int hi, int wid) {
    LAS bf16* stg = (LAS bf16*)(lds + A_OST) + wid * 2048;
#pragma unroll
    for (int r = 0; r < 16; ++r) { const int orow = crow(r, hi);
#pragma unroll
        for (int d0 = 0; d0 < 2; ++d0) { unsigned w_ = pk2(o[d0][r] * rli[r], 0.f) & 0xffffu;
#ifdef DBG_C_Y
            w_ = (w_ + 2u) & 0xfffcu;
#endif
            stg[orow * 64 + d0 * 32 + r32] = (bf16)w_; } }
    LDS_WAIT();
#pragma unroll
    for (int i = 0; i < 4; ++i) { const int row = i * 8 + (lane >> 3), ch = lane & 7; const v4u v = *(const LAS v4u*)(stg + row * 64 + ch * 8); *(GAS v4u*)(Ow + (size_t)row * 512 + ch * 8) = v; }
    LDS_WAIT();
}
__device__ __forceinline__ void row_to_regs(LAS float* wsf, float val, float (&rli)[16], int r32, int hi) {
    if (hi == 0) wsf[32 + r32] = val; LDS_WAIT();
#pragma unroll
    for (int r = 0; r < 16; ++r) rli[r] = wsf[32 + crow(r, hi)];
    LDS_WAIT();
}

__device__ __forceinline__ void fox_unit(Frame& F, int b, int h, int qb, bool dbg_t0 = false) {
    LAS unsigned char* lds = F.lds; unsigned char* ws = F.ws;
    const int lane = F.lane, wid = F.wave, r32 = lane & 31, hi = lane >> 5, q0 = qb * 256, q0w = q0 + 32 * wid, qpos = q0w + r32;
    LAS float* wsf = (LAS float*)(lds + A_WS) + wid * 64; LAS float* cbl = (LAS float*)(lds + A_BIG);
    { const v2u* cum = (const v2u*)(ws + WS_CUM) + (size_t)(b * 8 + h) * SEQ; LAS v2u* kxl = (LAS v2u*)cbl;
#pragma unroll 1
      for (int i = F.tid; i < 256 * (qb + 1); i += 512) kxl[i] = cum[i]; }
    __syncthreads();
    const bf16* Qw = (const bf16*)(ws + WS_QF) + ((size_t)b * SEQ + q0w) * 512 + h * 64;
    f32x16 o[2]; float lt;
    const bf16* kb = (const bf16*)(ws + WS_KF) + ((size_t)(b * 8 + h) * 64 << 12); const bf16* vb = (const bf16*)(ws + WS_VF) + ((size_t)(b * 8 + h) * 64 << 12);
    fa::run<0, 8>((const fa::bf16*)Qw, 512, (const fa::bf16*)kb, (const fa::bf16*)vb, 512, 0, dbg_t0 ? 0 : 1, 4 * (qb + 1), 4 * (qb + 1), qpos, q0w, 0, 0ull, 0ull, (const float*)cbl, (char*)lds, o, lt);
    float rli[16]; row_to_regs(wsf, 1.0f / lt, rli, r32, hi);
    bf16* Ow = (bf16*)(ws + WS_Y) + ((size_t)b * SEQ + q0w) * 512 + h * 64;
    if (!dbg_t0) store_o(lds, o, rli, Ow, lane, r32, hi, wid);
    else if (lt == 123.456f) Ow[0] = (bf16)(pk2(o[0][0] + o[1][3], 0.f) & 0xffffu);
    __syncthreads();
}

__device__ __forceinline__ void nsa_unit(Frame& F, int b, int g, int QBk, int dbgm = 0) {
    LAS unsigned char* lds = F.lds; unsigned char* ws = F.ws;
    const int lane = F.lane, wid = F.wave, r32 = lane & 31, hi = lane >> 5, hh = wid >> 1, qoff = 32 * (wid & 1), q0 = 64 * QBk, q0w = q0 + qoff, qpos = q0w + r32, head = 4 * g + hh;
    LAS float* wsf = (LAS float*)(lds + A_WS) + wid * 64; LAS float* imp = (LAS float*)(lds + A_BIG);
    LAS unsigned long long* selw = (LAS unsigned long long*)(lds + A_SEL);
    LAS float* impw = imp + (size_t)(hh * 4096 + qoff + r32);
    const bf16* Qw = (const bf16*)(ws + WS_QN) + ((size_t)b * SEQ + q0w) * 512 + head * 64;
    bf16x8 qr[4];
#pragma unroll
    for (int d0 = 0; d0 < 4; ++d0) qr[d0] = *(const GAS bf16x8*)(Qw + (size_t)r32 * 512 + d0 * 16 + hi * 8);
    const float* gat = (const float*)(ws + WS_GATES) + ((size_t)b * SEQ + qpos) * 24 + head * 3;
    float g_cmp = gat[0], g_slc = gat[1], g_win = gat[2];
#ifdef DBG_NO_CMP
    g_cmp = 0.f;
#endif
#ifdef DBG_SC_CMP
    g_cmp *= DBG_SC_CMP;
#endif
#ifdef DBG_SC_SLC
    g_slc *= DBG_SC_SLC;
#endif
#ifdef DBG_SC_WIN
    g_win *= DBG_SC_WIN;
#endif
#ifdef DBG_NO_SLC
    g_slc = 0.f;
#endif
#ifdef DBG_NO_WIN
    g_win = 0.f;
#endif
    float rli[16];
    St st;
    const int ntc = ((q0 + 32) >> 10) + 1;
    const unsigned long long tmc = (1ull << ntc) - 1ull;
    const bf16* kc = (const bf16*)(ws + WS_KCMP) + (size_t)b * 256 * 128 + g * 64; const bf16* vc = (const bf16*)(ws + WS_VCMP) + (size_t)b * 256 * 128 + g * 64;
    st_init(st);
    if (!(dbgm & 1)) run_tiles<M_CMP1>(lds, tmc, kc, vc, 128, qr, st, 0.f, qpos, q0w, QBk, 0ull, wsf, impw, nullptr, lane, r32, hi, wid);
    if (!(dbgm & 1)) { const float lt = st.l + __shfl_xor(st.l, 32); const float rl = lt > 0.f ? 1.0f / lt : 0.f; const float mkeep = st.mref;
      st_init(st); st.mref = mkeep;
      run_tiles<M_CMP2>(lds, tmc, kc, vc, 128, qr, st, rl, qpos, q0w, QBk, 0ull, wsf, impw, nullptr, lane, r32, hi, wid); }
    __syncthreads();
    if (dbgm & 2) { if (lane == 0) for (int qq = 0; qq < 8; ++qq) selw[wid * 8 + qq] = QBk >= 63 ? ~0ull : ((1ull << (QBk + 1)) - 1ull); }
    else for (int qq = 0; qq < 8; ++qq) { const int q = wid * 8 + qq, j = lane;
        const int sw = j * 64 + (q ^ j);
        float v = ((imp[sw] + imp[4096 + sw]) + imp[2 * 4096 + sw]) + imp[3 * 4096 + sw];
#ifdef DBG_IMPNOISE
        { const unsigned hsh = ((unsigned)(q0 + q) * 2654435761u) ^ ((unsigned)(j + 64 * (b * 2 + g)) * 2246822519u); const float nz = ((float)((hsh >> 9) & 0xffff) * (1.0f / 65536.0f) - 0.5f); v = v * (1.0f + DBG_IMPNOISE * nz); }
#endif
        const bool forced = (j == 0) || (j == QBk) || (j == QBk - 1), causal = j <= QBk;
        const unsigned key = (causal ? (forced ? 0xFFFFFFC0u : (__float_as_uint(fmaxf(v, 0.f)) & ~63u)) : 0u) | (unsigned)(63 - j);
        unsigned T = 0u;
#pragma unroll
        for (int bit = 31; bit >= 0; --bit) { const unsigned Tt = T | (1u << bit); T = (__popcll(__ballot(key >= Tt)) >= 16) ? Tt : T; }
        const unsigned long long msk = __ballot(causal && key >= T);
        if (lane == 0) selw[q] = msk; }
    __syncthreads();
    LAS float* otl = imp + wid * 2048 + lane;
    row_to_regs(wsf, g_cmp, rli, r32, hi);
#pragma unroll
    for (int r = 0; r < 16; ++r) { otl[(2 * r) * 64] = st.o[0][r] * rli[r]; otl[(2 * r + 1) * 64] = st.o[1][r] * rli[r]; }
    const unsigned long long selm = selw[qoff + r32];
    unsigned long long um = selw[lane];
#pragma unroll
    for (int o = 1; o < 64; o <<= 1) { const unsigned lo = __shfl_xor((unsigned)um, o), hi2 = __shfl_xor((unsigned)(um >> 32), o); um |= ((unsigned long long)hi2 << 32) | lo; }
    um = ((unsigned long long)__builtin_amdgcn_readfirstlane((unsigned)(um >> 32)) << 32) | (unsigned)__builtin_amdgcn_readfirstlane((unsigned)um);
    const bf16* ksl = (const bf16*)(ws + WS_KVS) + ((size_t)(b * 2 + g) * 64 << 12); const bf16* vsl = ksl + 4 * MiB;
    float lt_ = 1.f;
    if (!(dbgm & 4)) { const int ntr = __builtin_popcountll(um), nt2 = ntr < 2 ? 2 : ((ntr + 1) & ~1);
      fa::run<3, 8>((const fa::bf16*)Qw, 512, (const fa::bf16*)ksl, (const fa::bf16*)vsl, 512, 0, 1, nt2, ntr, qpos, q0w, QBk, selm, um, nullptr, (char*)lds, st.o, lt_); }
    { const float lt = lt_; row_to_regs(wsf, g_slc / lt, rli, r32, hi);
#pragma unroll
      for (int r = 0; r < 16; ++r) { otl[(2 * r) * 64] += st.o[0][r] * rli[r]; otl[(2 * r + 1) * 64] += st.o[1][r] * rli[r]; } }
    const bf16* kw = (const bf16*)(ws + WS_KVW) + ((size_t)(b * 2 + g) * 64 << 12); const bf16* vw = kw + 4 * MiB;
    if (!(dbgm & 8)) { const int tlo = QBk >= 8 ? QBk - 8 : 0; const int nt = QBk - tlo + 1; const unsigned long long tmw = ((1ull << nt) - 1ull) << tlo;
      (void)tmw; const int nt2 = nt < 2 ? 2 : ((nt + 1) & ~1);
      fa::run<4, 8>((const fa::bf16*)Qw, 512, (const fa::bf16*)kw, (const fa::bf16*)vw, 512, tlo, 1, nt2, nt, qpos, q0w, QBk, 0ull, 0ull, nullptr, (char*)lds, st.o, lt_); }
    { const float lt = lt_; row_to_regs(wsf, g_win / lt, rli, r32, hi);
#pragma unroll
      for (int r = 0; r < 16; ++r) { st.o[0][r] = otl[(2 * r) * 64] + st.o[0][r] * rli[r]; st.o[1][r] = otl[(2 * r + 1) * 64] + st.o[1][r] * rli[r]; } }
#pragma unroll
    for (int r = 0; r < 16; ++r) rli[r] = 1.0f;
    bf16* Ow = (bf16*)(ws + WS_Y) + ((size_t)NTOK + (size_t)b * SEQ + q0w) * 512 + head * 64;
    if (!(dbgm & 16)) store_o(lds, st.o, rli, Ow, lane, r32, hi, wid);
    else if (lt_ == 123.456f) Ow[0] = (bf16)(pk2(st.o[0][0] + st.o[1][3], 0.f) & 0xffffu);
    __syncthreads();
}
#undef MFMA32
#undef MX3
}

__device__ __forceinline__ void p3_attention(Frame& F, int qoff = 0, int which = 3) {
    volatile LAS unsigned* qslot = F.MISC + 16;
    if (which & 2) for (;;) {
        if (F.tid == 0) qslot[0] = __hip_atomic_fetch_add(F.ctl + CW_QATT + 16 + qoff, 1u, RLX_AGENT);
        __syncthreads();
        const unsigned u = qslot[0];
        __syncthreads();
        if (u >= 1024u) break;
        const int k = (int)u; const int QBk = 63 - (k >> 4), bg = k & 15;
        { Frame G = F; asm volatile("" : "+v"(G.tid), "+v"(G.lane)); att::nsa_unit(G, bg >> 1, bg & 1, QBk, qoff != 0 ? DBG_NSAM : 0); }
    }
    if (which & 1) for (;;) {
        if (F.tid == 0) qslot[0] = __hip_atomic_fetch_add(F.ctl + CW_QATT + qoff, 1u, RLX_AGENT);
        __syncthreads();
        const unsigned u = qslot[0];
        __syncthreads();
        if (u >= 1024u) break;
        const int k = (int)u; const int qb = 15 - (k >> 6), bh = k & 63;
        { Frame G = F; asm volatile("" : "+v"(G.tid), "+v"(G.lane)); att::fox_unit(G, bh >> 3, bh & 7, qb, DBG_FOXT0 && qoff != 0); }
    }
}

struct MergeOrder {
    int vcu, G;
    __device__ __forceinline__ bool next(int i, pg8::Unit& u) const { const int p = (i >> 1) * G + vcu; if (p >= 512) return false; const int br = i & 1, tm = p >> 2, tn = p & 3; u.pm = br * 128 + tm; u.pn = br * 4 + tn; return true; }
    __device__ __forceinline__ void a_ready(const pg8::Unit&) const {}
    __device__ __forceinline__ void done(const pg8::Unit&) const {}
};
struct EpiMerge {
    static constexpr bool PERM = true, AFTER_DRAIN = false;
    unsigned char* ws;
    __device__ __forceinline__ bool operator()(f32x4 (&acc)[2][2][4][2], const pg8::Unit& u, int wr, int wc, int fr, int fq) const {
        const int br = u.pm >> 7, tm = u.pm & 127, tn = u.pn & 3;
        const int row0 = tm * 256 + wr * 64 + fr, col0 = tn * 256 + wc * 32 + 8 * fq;
        const bf16* GM = (const bf16*)(ws + WS_GM); bf16* MG = (bf16*)(ws + WS_MERGED);
#pragma unroll
        for (int ai = 0; ai < 2; ++ai)
#pragma unroll
            for (int m = 0; m < 4; ++m) { const int row = row0 + ai * 128 + m * 16;
#pragma unroll
                for (int bj = 0; bj < 2; ++bj) { const int col = col0 + bj * 128;
                    const bf16* gp_ = GM + (size_t)row * 2048 + (tn * 2 + bj) * 256 + wc * 32 + 8 * fq + (br == 0 ? 0 : 128);
                    const v4u g1w = *(const GAS v4u*)gp_;
                    float g1[8] = {bf_lo(g1w.x), bf_hi(g1w.x), bf_lo(g1w.y), bf_hi(g1w.y), bf_lo(g1w.z), bf_hi(g1w.z), bf_lo(g1w.w), bf_hi(g1w.w)};
                    f32x4& a0 = acc[ai][bj][m][0]; f32x4& a1 = acc[ai][bj][m][1];
                    if (br == 0) {
                        a0.x *= g1[0]; a0.y *= g1[1]; a0.z *= g1[2]; a0.w *= g1[3]; a1.x *= g1[4]; a1.y *= g1[5]; a1.z *= g1[6]; a1.w *= g1[7];
                    } else {
                        v4u w; w.x = pk2(a0.x * g1[0], a0.y * g1[1]); w.y = pk2(a0.z * g1[2], a0.w * g1[3]); w.z = pk2(a1.x * g1[4], a1.y * g1[5]); w.w = pk2(a1.z * g1[6], a1.w * g1[7]);
#ifdef DBG_C_MERGED
                        w.x = COARSE2(w.x); w.y = COARSE2(w.y); w.z = COARSE2(w.z); w.w = COARSE2(w.w);
#endif
                        *(GAS v4u*)(MG + (size_t)row * 1024 + col) = w;
                    } } }
        return br == 0;
    }
};
#ifndef DBG_DECAY
#define DBG_DECAY 1.0f
#endif
#ifndef DBG_TEMP
#define DBG_TEMP 1.0f
#endif
#ifndef DBG_PEERSCALE
#define DBG_PEERSCALE 1.0f
#endif
#ifndef DBG_MIXSCALE
#define DBG_MIXSCALE 1.0f
#endif
struct EpiOut {
    static constexpr bool PERM = false, AFTER_DRAIN = false;
    unsigned char* ws; const float* x; float* out; const float* gffn;
    __device__ __forceinline__ bool operator()(f32x4 (&acc)[2][2][4][2], const pg8::Unit& u, int wr, int wc, int fr, int fq) const {
        const int row0 = u.pm * 256 + wr * 64 + fr, col0 = u.pn * 256 + wc * 32 + 4 * fq;
        float* SS = (float*)(ws + WS_SS); bf16* HBF = (bf16*)(ws + WS_HBF);
#pragma unroll
        for (int ai = 0; ai < 2; ++ai)
#pragma unroll
            for (int m = 0; m < 4; ++m) { const int row = row0 + ai * 128 + m * 16; float ssq = 0.f;
#pragma unroll
                for (int bj = 0; bj < 2; ++bj)
#pragma unroll
                    for (int n = 0; n < 2; ++n) { const int col = col0 + bj * 128 + n * 16; const size_t off = (size_t)row * 1024 + col;
                        const f32x4 xv = *(const GAS f32x4*)(x + off); const f32x4 hv = xv + acc[ai][bj][m][n] * DBG_MIXSCALE; { v2u hw; hw.x = pk2(hv.x, hv.y); hw.y = pk2(hv.z, hv.w); *(GAS v2u*)(HBF + off) = hw; }
                        ssq += (hv.x * hv.x + hv.y * hv.y) + (hv.z * hv.z + hv.w * hv.w); }
                ssq += __shfl_xor(ssq, 16); ssq += __shfl_xor(ssq, 32);
                if (fq == 0) atomicAdd(SS + row, ssq); }
        return false;
    }
};
#ifdef DBG_DUPG
struct EpiNull {
    static constexpr bool PERM = true, AFTER_DRAIN = false;
    gu32* ctl;
    __device__ __forceinline__ bool operator()(f32x4 (&acc)[2][2][4][2], const pg8::Unit& u, int wr, int wc, int fr, int fq) const {
        float s = 0.f;
#pragma unroll
        for (int a = 0; a < 2; ++a)
#pragma unroll
            for (int b = 0; b < 2; ++b)
#pragma unroll
                for (int m = 0; m < 4; ++m)
#pragma unroll
                    for (int n = 0; n < 2; ++n) s += (acc[a][b][m][n].x + acc[a][b][m][n].y) + (acc[a][b][m][n].z + acc[a][b][m][n].w);
        if (s == 123456.789f) ctl[CW_BAR + 900] = 1u;
        return false;
    }
};
#endif
struct EpiScore {
    static constexpr bool PERM = true, AFTER_DRAIN = false;
    bf16* O;
    __device__ __forceinline__ bool operator()(f32x4 (&acc)[2][2][4][2], const pg8::Unit& u, int wr, int wc, int fr, int fq) const {
        const int row0 = u.pm * 256 + wr * 64 + fr;
#pragma unroll
        for (int ai = 0; ai < 2; ++ai)
#pragma unroll
            for (int m = 0; m < 4; ++m) { bf16* rowp = O + (size_t)(row0 + ai * 128 + m * 16) * 2048;
#pragma unroll
                for (int bj = 0; bj < 2; ++bj) { const int col = u.pn * 256 + bj * 128 + wc * 32 + 8 * fq, hp = col >> 7, c16 = (col & 127) >> 3;
                    const f32x4 a0 = acc[ai][bj][m][0], a1 = acc[ai][bj][m][1];
                    v4u w; w.x = pk2(a0.x, a0.y); w.y = pk2(a0.z, a0.w); w.z = pk2(a1.x, a1.y); w.w = pk2(a1.z, a1.w);
                    (void)hp; (void)c16; *(GAS v4u*)(rowp + col) = w; } }
        return false;
    }
};
#ifdef DBG_F32SCORES
__device__ __forceinline__ void p6_naive(Frame& F) {
    LAS float* hn = (LAS float*)F.lds; LAS float* qv = hn + 8 * 1024;
    const float* SS = (const float*)(F.ws + WS_SS); float* SC = (float*)(F.ws + WS_SC);
    for (int g8 = blockIdx.x; g8 < NTOK / 8; g8 += F.G) { const int t0 = g8 * 8;
        for (int e = F.tid; e < 8 * 1024; e += 512) { const int tk = e >> 10, d = e & 1023; const float rt = 1.0f / sqrtf(SS[t0 + tk] * (1.f / DM) + RMS_EPS); hn[e] = F.out[(size_t)(t0 + tk) * 1024 + d] * F.norm_ffn[d] * rt; }
        __syncthreads();
        { const int c0 = F.tid * 4; float acc[8][4];
          for (int i = 0; i < 8; ++i) for (int j = 0; j < 4; ++j) acc[i][j] = 0.f;
          for (int k = 0; k < 1024; ++k) { const f32x4 w = *(const GAS f32x4*)(F.peer_wq + (size_t)k * 2048 + c0);
#pragma unroll
              for (int i = 0; i < 8; ++i) { const float hv = hn[i * 1024 + k]; acc[i][0] += hv * w.x; acc[i][1] += hv * w.y; acc[i][2] += hv * w.z; acc[i][3] += hv * w.w; } }
#pragma unroll
          for (int i = 0; i < 8; ++i) { qv[i * 2048 + c0] = acc[i][0]; qv[i * 2048 + c0 + 1] = acc[i][1]; qv[i * 2048 + c0 + 2] = acc[i][2]; qv[i * 2048 + c0 + 3] = acc[i][3]; } }
        __syncthreads();
        for (int n = F.tid; n < 2048; n += 512) { const int hp = n >> 7; float a[8];
#pragma unroll
            for (int i = 0; i < 8; ++i) a[i] = 0.f;
            for (int d = 0; d < 128; ++d) { const float sk = F.peer_sk[(size_t)n * 128 + d];
#pragma unroll
                for (int i = 0; i < 8; ++i) a[i] += qv[i * 2048 + hp * 128 + d] * sk; }
#pragma unroll
            for (int i = 0; i < 8; ++i) { const float rt = 1.0f / sqrtf(SS[t0 + i] * (1.f / DM) + RMS_EPS); SC[(size_t)(t0 + i) * 2048 + n] = a[i] / rt; } }
        __syncthreads(); }
}
#endif
__device__ __forceinline__ unsigned mono_key(float f) { const unsigned u = __float_as_uint(f); return u ^ ((unsigned)((int)u >> 31) | 0x80000000u); }
__device__ __forceinline__ float unmono(unsigned k) { const unsigned u = (k & 0x80000000u) ? (k ^ 0x80000000u) : ~k; return __uint_as_float(u); }
#define INS16(list, key) do { unsigned k_ = (key); _Pragma("unroll") for (int e_ = 0; e_ < 16; ++e_) { const unsigned hi_ = max(list[e_], k_); k_ = min(list[e_], k_); list[e_] = hi_; } } while (0)
__device__ __forceinline__ void p7_wave(Frame& F, int t0) {
    unsigned char* ws = F.ws; const int tid = F.tid, lane = F.lane, wid = F.wave;
    LAS unsigned* keys = (LAS unsigned*)(F.lds + wid * 4096);
    LAS int* eidx = (LAS int*)(F.lds + 32768 + wid * 2048);
    LAS float* ewt = (LAS float*)(F.lds + 49152 + wid * 2048);
    LAS unsigned char* hb8 = F.lds + 65536 + wid * 2048;
    const bf16* SCB = (const bf16*)(ws + WS_SC); const float* SS = (const float*)(ws + WS_SS);
#ifdef DBG_DUPTOPK
    for (int rep_ = 0; rep_ < 2; ++rep_) {
#endif
    { const int tok = lane >> 4, hp = lane & 15; const GAS v4u* p4 = (const GAS v4u*)(SCB + (size_t)(t0 + tok) * 2048 + hp * 128);
      unsigned list[16];
#pragma unroll
      for (int e = 0; e < 16; ++e) list[e] = 0u;
#define P7_CE(A, B) do { const unsigned hi_ = max(A, B), lo_ = min(A, B); A = hi_; B = lo_; } while (0)
#define P7_KEY(val, idx) ((mono_key(val) & ~127u) | (unsigned)(127 - (idx)))
#pragma unroll 1
      for (int c = 0; c < 16; ++c) { const v4u v = p4[c];
          unsigned g0 = P7_KEY(bf_lo(v.x), 8 * c + 0), g1 = P7_KEY(bf_hi(v.x), 8 * c + 1), g2 = P7_KEY(bf_lo(v.y), 8 * c + 2), g3 = P7_KEY(bf_hi(v.y), 8 * c + 3);
          unsigned g4 = P7_KEY(bf_lo(v.z), 8 * c + 4), g5 = P7_KEY(bf_hi(v.z), 8 * c + 5), g6 = P7_KEY(bf_lo(v.w), 8 * c + 6), g7 = P7_KEY(bf_hi(v.w), 8 * c + 7);
          P7_CE(g0, g1); P7_CE(g2, g3); P7_CE(g4, g5); P7_CE(g6, g7);
          P7_CE(g0, g2); P7_CE(g1, g3); P7_CE(g4, g6); P7_CE(g5, g7);
          P7_CE(g1, g2); P7_CE(g5, g6);
          P7_CE(g0, g4); P7_CE(g1, g5); P7_CE(g2, g6); P7_CE(g3, g7);
          P7_CE(g2, g4); P7_CE(g3, g5);
          P7_CE(g1, g2); P7_CE(g3, g4); P7_CE(g5, g6);
          list[8] = max(list[8], g7); list[9] = max(list[9], g6); list[10] = max(list[10], g5); list[11] = max(list[11], g4);
          list[12] = max(list[12], g3); list[13] = max(list[13], g2); list[14] = max(list[14], g1); list[15] = max(list[15], g0);
#pragma unroll
          for (int i = 0; i < 8; ++i) P7_CE(list[i], list[i + 8]);
#pragma unroll
          for (int h8 = 0; h8 < 16; h8 += 8)
#pragma unroll
              for (int i = 0; i < 4; ++i) P7_CE(list[h8 + i], list[h8 + i + 4]);
#pragma unroll
          for (int h4 = 0; h4 < 16; h4 += 4)
#pragma unroll
              for (int i = 0; i < 2; ++i) P7_CE(list[h4 + i], list[h4 + i + 2]);
#pragma unroll
          for (int h2 = 0; h2 < 16; h2 += 2) P7_CE(list[h2], list[h2 + 1]); }
#undef P7_CE
#undef P7_KEY
#pragma unroll
      for (int e = 0; e < 16; ++e) keys[(tok * 16 + hp) * 16 + e] = list[e]; }
    LDS_WAIT(); asm volatile("" ::: "memory");
    if (lane < 32) { const int tok = lane >> 3, hd = lane & 7; const LAS unsigned* ka = keys + (tok * 16 + 2 * hd) * 16; const LAS unsigned* kb = ka + 16;
        float a[16], bq[16];
#pragma unroll
        for (int e = 0; e < 16; ++e) { a[e] = unmono(ka[e] & ~127u); bq[e] = unmono(kb[e] & ~127u); }
        unsigned list[16];
#pragma unroll
        for (int e = 0; e < 16; ++e) list[e] = 0u;
#pragma unroll
        for (int i = 0; i < 16; ++i)
#pragma unroll
            for (int j = 0; j < 16; ++j) if ((i + 1) * (j + 1) <= 16) INS16(list, (mono_key(a[i] + bq[j]) & ~255u) | (unsigned)(255 - (i * 16 + j)));
        const float rt = 1.0f / sqrtf(SS[t0 + tok] * (1.f / DM) + RMS_EPS);
        float sv[16]; float den = 0.f;
#pragma unroll
        for (int e = 0; e < 16; ++e) { const int pos = 255 - (int)(list[e] & 255u), i = pos >> 4, j = pos & 15; const unsigned k1 = ka[i], k2 = kb[j];
            sv[e] = (unmono(k1 & ~127u) + unmono(k2 & ~127u)) * rt * DBG_TEMP; eidx[tok * 128 + hd * 16 + e] = (127 - (int)(k1 & 127u)) * 128 + (127 - (int)(k2 & 127u)); }
#ifdef DBG_LOGITSTAT
        atomicAdd((float*)(F.ctl + 12400), (sv[0] - sv[15]) * (1.0f / 262144.0f));
        atomicMax((unsigned*)(F.ctl + 12401), __float_as_uint(sv[0] - sv[15]));
        atomicMax((unsigned*)(F.ctl + 12402), __float_as_uint(rt));
        atomicMax((unsigned*)(F.ctl + 12403), __float_as_uint(sv[0]));
#endif
        const float smax = sv[0];
#pragma unroll
        for (int e = 0; e < 16; ++e) { sv[e] = __expf(sv[e] - smax); den += sv[e]; }
        const float rden = 1.0f / den;
#pragma unroll
#ifdef DBG_REVW
        for (int e = 0; e < 16; ++e) ewt[tok * 128 + hd * 16 + e] = sv[15 - e] * rden; }
#else
        for (int e = 0; e < 16; ++e) ewt[tok * 128 + hd * 16 + e] = (e >= DBG_KEEP) ? 0.f : sv[e] * rden; }
#endif
    LDS_WAIT(); asm volatile("" ::: "memory");
#ifdef DBG_DUPTOPK
    }
#endif
    int lane_g = lane; asm volatile("" : "+v"(lane_g));
    const unsigned char* U8 = (const unsigned char*)(ws + WS_U8); const unsigned char* V8 = (const unsigned char*)(ws + WS_V8);
    const float* SU = (const float*)(ws + WS_SU); const float* SV = (const float*)(ws + WS_SV);
    for (int tt = 0; tt < 4; ++tt) { const int tok = tt, t = t0 + tok;
        const float rt = 1.0f / sqrtf(SS[t] * (1.f / DM) + RMS_EPS);
        float hres[16]; f32x2 out[8];
        { const GAS v4u* hp_ = (const GAS v4u*)((const bf16*)(ws + WS_HBF) + (size_t)t * DM) + 2 * lane_g; const GAS f32x4* gp = (const GAS f32x4*)F.norm_ffn + 4 * lane_g;
          v4u whi, wlo; const float rt16 = rt * 16.0f; const v4u hA = hp_[0], hB = hp_[1];
#pragma unroll
          for (int q = 0; q < 4; ++q) { const unsigned w0_ = q == 0 ? hA.x : (q == 1 ? hA.z : (q == 2 ? hB.x : hB.z)), w1_ = q == 0 ? hA.y : (q == 1 ? hA.w : (q == 2 ? hB.y : hB.w));
              const f32x4 hv = (f32x4){bf_lo(w0_), bf_hi(w0_), bf_lo(w1_), bf_hi(w1_)}; const f32x4 gv = gp[q];
              hres[4 * q] = hv.x; hres[4 * q + 1] = hv.y; hres[4 * q + 2] = hv.z; hres[4 * q + 3] = hv.w;
              const float n0 = fminf(fmaxf(hv.x * gv.x * rt16, -440.f), 440.f), n1 = fminf(fmaxf(hv.y * gv.y * rt16, -440.f), 440.f), n2 = fminf(fmaxf(hv.z * gv.z * rt16, -440.f), 440.f), n3 = fminf(fmaxf(hv.w * gv.w * rt16, -440.f), 440.f);
              int wh = 0; wh = __builtin_amdgcn_cvt_pk_fp8_f32(n0, n1, wh, false); wh = __builtin_amdgcn_cvt_pk_fp8_f32(n2, n3, wh, true);
              const float r0 = n0 - __builtin_amdgcn_cvt_f32_fp8(wh, 0), r1 = n1 - __builtin_amdgcn_cvt_f32_fp8(wh, 1), r2 = n2 - __builtin_amdgcn_cvt_f32_fp8(wh, 2), r3 = n3 - __builtin_amdgcn_cvt_f32_fp8(wh, 3);
              int wl = 0; wl = __builtin_amdgcn_cvt_pk_fp8_f32(r0, r1, wl, false); wl = __builtin_amdgcn_cvt_pk_fp8_f32(r2, r3, wl, true);
              if (q == 0) { whi.x = (unsigned)wh; wlo.x = (unsigned)wl; } else if (q == 1) { whi.y = (unsigned)wh; wlo.y = (unsigned)wl; } else if (q == 2) { whi.z = (unsigned)wh; wlo.z = (unsigned)wl; } else { whi.w = (unsigned)wh; wlo.w = (unsigned)wl; } }
          LDS_WAIT();
          *(LAS v4u*)(hb8 + 16 * lane_g) = whi; *(LAS v4u*)(hb8 + 1024 + 16 * lane_g) = wlo; LDS_WAIT(); }
#pragma unroll
        for (int i = 0; i < 8; ++i) out[i] = (f32x2){0.f, 0.f};
        for (int hd = 0; hd < 8; ++hd) {
            const LAS int* eh = eidx + tok * 128 + hd * 16;
            const int ec = 4 * (lane_g >> 4) + (lane_g & 3);
            const int myex = eh[ec];
            const float su = SU[myex], sv_ = SV[myex];
            v4u ua[8]; v2u vr[16];
            { const unsigned char* up = U8 + (size_t)eh[lane_g & 15] * (DM / 2) + (lane_g >> 4) * 16;
#pragma unroll
              for (int c = 0; c < 8; ++c) ua[c] = *(const GAS v4u*)(up + 64 * c); }
#pragma unroll
            for (int e = 0; e < 16; ++e) { const int ex = __builtin_amdgcn_readfirstlane(eh[e]); vr[e] = *((const GAS v2u*)(V8 + (size_t)ex * (DM / 2)) + lane_g); }
            f32x4 dacc = (f32x4){0.f, 0.f, 0.f, 0.f};
            {
#pragma unroll
              for (int c = 0; c < 8; ++c) { typedef int v8i_t __attribute__((ext_vector_type(8)));
                  const LAS unsigned char* hq1 = hb8 + 16 * (lane_g >> 4);
                  const v4u h0 = *(const LAS v4u*)(hq1 + 128 * c), h1 = *(const LAS v4u*)(hq1 + 128 * c + 64), l0 = *(const LAS v4u*)(hq1 + 1024 + 128 * c), l1 = *(const LAS v4u*)(hq1 + 1024 + 128 * c + 64);
                  const v8i_t av = (v8i_t){(int)ua[c].x, (int)ua[c].y, (int)ua[c].z, (int)ua[c].w, 0, 0, 0, 0};
                  const v8i_t bh = (v8i_t){(int)h0.x, (int)h0.y, (int)h0.z, (int)h0.w, (int)h1.x, (int)h1.y, (int)h1.z, (int)h1.w};
                  const v8i_t bl = (v8i_t){(int)l0.x, (int)l0.y, (int)l0.z, (int)l0.w, (int)l1.x, (int)l1.y, (int)l1.z, (int)l1.w};
                  dacc = __builtin_amdgcn_mfma_scale_f32_16x16x128_f8f6f4(av, bh, dacc, 4, 0, 0, 0x7F7F7F7F, 0, 0x7F7F7F7F);
                  dacc = __builtin_amdgcn_mfma_scale_f32_16x16x128_f8f6f4(av, bl, dacc, 4, 0, 0, 0x7F7F7F7F, 0, 0x7F7F7F7F); } }
            float act = (lane_g & 2) ? ((lane_g & 1) ? dacc.w : dacc.z) : ((lane_g & 1) ? dacc.y : dacc.x);
            act *= (1.0f / 16.0f);
            act *= su;
            const float coef = ewt[tok * 128 + hd * 16 + ec] * gelu_erf(act) * sv_;
#pragma unroll
            for (int e = 0; e < 16; ++e) { const float c = __uint_as_float(__builtin_amdgcn_readlane(__float_as_uint(coef), 16 * (e >> 2) + (e & 3))); const v2u v = vr[e]; const f32x2 c2 = (f32x2){c, c};
                out[0] += c2 * __builtin_amdgcn_cvt_scalef32_pk_f32_fp4(v.x, 1.0f, 0); out[1] += c2 * __builtin_amdgcn_cvt_scalef32_pk_f32_fp4(v.x, 1.0f, 1);
                out[2] += c2 * __builtin_amdgcn_cvt_scalef32_pk_f32_fp4(v.x, 1.0f, 2); out[3] += c2 * __builtin_amdgcn_cvt_scalef32_pk_f32_fp4(v.x, 1.0f, 3);
                out[4] += c2 * __builtin_amdgcn_cvt_scalef32_pk_f32_fp4(v.y, 1.0f, 0); out[5] += c2 * __builtin_amdgcn_cvt_scalef32_pk_f32_fp4(v.y, 1.0f, 1);
                out[6] += c2 * __builtin_amdgcn_cvt_scalef32_pk_f32_fp4(v.y, 1.0f, 2); out[7] += c2 * __builtin_amdgcn_cvt_scalef32_pk_f32_fp4(v.y, 1.0f, 3); }
        }
        float y[16]; float ssq = 0.f;
#pragma unroll
        for (int i = 0; i < 8; ++i) { y[2 * i] = out[i].x + hres[2 * i]; y[2 * i + 1] = out[i].y + hres[2 * i + 1]; ssq += y[2 * i] * y[2 * i] + y[2 * i + 1] * y[2 * i + 1]; }
        const float rf = 1.0f / sqrtf(wave_sum(ssq) * (1.f / DM) + RMS_EPS);
        { GAS f32x4* op = (GAS f32x4*)(F.out + (size_t)t * DM) + 4 * lane_g; const GAS f32x4* gp = (const GAS f32x4*)F.norm_final + 4 * lane_g;
#pragma unroll
          for (int q = 0; q < 4; ++q) { const f32x4 gv = gp[q]; op[q] = (f32x4){y[4 * q] * rf * gv.x, y[4 * q + 1] * rf * gv.y, y[4 * q + 2] * rf * gv.z, y[4 * q + 3] * rf * gv.w}; } }
    }
    LDS_WAIT(); asm volatile("" ::: "memory");
}


struct Args { const float* in[15]; float* out; unsigned char* ws; int ph_lo, ph_hi; };
constexpr int NPHASE = 8;
__global__ void __launch_bounds__(NWAVES * 64, 2) mk_fwd(Args args) {
    extern __shared__ __attribute__((aligned(16))) unsigned char lds[];
    Frame F;
    F.lds = (LAS unsigned char*)lds; F.MISC = (volatile LAS unsigned*)(F.lds + MISC_OFF);
    F.tid = threadIdx.x; F.lane = F.tid & 63; F.wave = __builtin_amdgcn_readfirstlane(F.tid >> 6);
    F.G = gridDim.x; { const int bx = blockIdx.x; F.vcu = (F.G % 8 == 0) ? (bx % 8) * (F.G / 8) + bx / 8 : bx; }
    unsigned char* ws = args.ws; F.ws = ws; F.ctl = (gu32*)(ws + WS_CTL);
    F.x = args.in[0]; F.norm_mix = args.in[1]; F.w_in = args.in[2]; F.fbias = args.in[3]; F.cmp_pos = args.in[4]; F.cmp_w1 = args.in[5]; F.cmp_w2 = args.in[6]; F.w_branch = args.in[7];
    F.w_out = args.in[8]; F.norm_ffn = args.in[9]; F.peer_wq = args.in[10]; F.peer_sk = args.in[11]; F.peer_u = args.in[12]; F.peer_v = args.in[13]; F.norm_final = args.in[14]; F.out = args.out;
    for (int u = F.tid; u < (LDS_BYTES - LDSCTL_OFF) / 4; u += NWAVES * 64) ((LAS unsigned*)(F.lds + LDSCTL_OFF))[u] = 0u;
    __syncthreads();
    const int lo = args.ph_lo, hi = args.ph_hi;
    XcdBarrier bar; bar.bar = (unsigned*)(F.ctl + CW_BAR); bar.x = 0; bar.st = nullptr;
    if (hi - lo > 1) bar = xcd_barrier_post((unsigned*)(F.ctl + CW_BAR), F.MISC + 8);
#define IN(k) (lo <= (k) && (k) < hi)
#ifdef DBG_CHECK
    if (lo == 99) { dbg_check_inproj(F); __syncthreads(); dbg_check_cmp(F); __syncthreads(); dbg_check_attn(F); return; }
    if (lo == 100) { dbg_check_merged(F); return; }
    if (lo == 101) { dbg_check_h(F); return; }
    if (lo == 102) { dbg_check_scores(F); return; }
    if (lo == 103) { dbg_check_final(F); return; }
    if (lo == 104) { if (blockIdx.x == 0 && F.tid == 0) {
#ifdef DBG_SEL
        const float num = __hip_atomic_load((float*)(F.ctl + CW_L2) + DBG_SEL, RLX_AGENT), den = __hip_atomic_load((float*)(F.ctl + CW_L2) + 8 + DBG_SEL, RLX_AGENT);
        float v = 1000.0f * sqrtf(num / fmaxf(den, 1e-30f)); v = fminf(99.f, rintf(v)); F.out[0] = 10.0f * v + 5.0f;
#else
        const unsigned m = __hip_atomic_load(F.ctl + CW_DBG, RLX_AGENT); if (m) F.out[0] = 10.0f * (float)m;
#endif
    } return; }
#endif
#ifdef DBG_PHASE
#define SEAM(k) do { if (IN(k) && IN((k) + 1)) xcd_barrier(bar); if (blockIdx.x == 0 && F.tid == 0) ((unsigned long long*)(F.ctl + 12500))[(k) + 1] = __builtin_amdgcn_s_memrealtime(); } while (0)
#else
#define SEAM(k) do { if (IN(k) && IN((k) + 1)) xcd_barrier(bar); } while (0)
#endif
#ifdef DBG_PHASE
    if (blockIdx.x == 0 && F.tid == 0) ((unsigned long long*)(F.ctl + 12500))[0] = __builtin_amdgcn_s_memrealtime();
#endif
    if (IN(0)) { p0_prologue(F);
#ifdef DBG_DUP0
        xcd_barrier(bar); p0_prologue(F, true);
#endif
        SEAM(0); }
    if (IN(1)) {
        pg8::Gemm g{(const bf16*)(ws + WS_XN), (const bf16*)(ws + WS_WTIN), NTOK, NIN, 1024}; pg8::StaticOrder S; S.init(NTOK, NIN, F.G, (int)blockIdx.x);
        EpiIn E{ws, F.fbias};
        pg8::gemm_phase<EpiIn, pg8::StaticOrder, true, true>(F.lds, g, S, E);
#if defined(DBG_DUPG) && DBG_DUPG == 1
        xcd_barrier(bar); { EpiNull E2{F.ctl}; pg8::gemm_phase<EpiNull, pg8::StaticOrder, true, true>(F.lds, g, S, E2); }
#endif
#if defined(DBG_DUPG) && DBG_DUPG == 11
        xcd_barrier(bar); pg8::gemm_phase<EpiIn, pg8::StaticOrder, true, true>(F.lds, g, S, E);
#endif
        SEAM(1);
    }
    if (IN(2)) {
        for (int u = blockIdx.x; u < 256; u += F.G) p2_compress_unit(F, u);
#if DBG_DUP2 == 1
        xcd_barrier(bar); for (int u = blockIdx.x; u < 256; u += F.G) p2_compress_unit(F, u);
#endif
#if DBG_DUP2 == 2
        { const int gw = (int)blockIdx.x * NWAVES + F.wave; if (gw < 64) p2_cumsum_wave(F, gw); } xcd_barrier(bar);
#endif
        { const int gw = (int)blockIdx.x * NWAVES + F.wave; if (gw < 64) p2_cumsum_wave(F, gw); else if (F.G * NWAVES < 64) { for (int q = gw; q < 64; q += F.G * NWAVES) p2_cumsum_wave(F, q); } }
        SEAM(2);
    }
    if (IN(3)) {
        p3_attention(F);
#if DBG_DUP3
        xcd_barrier(bar); p3_attention(F, 64, DBG_DUP3);
#endif
        SEAM(3); }
    if (IN(4)) {
        pg8::Gemm g{(const bf16*)(ws + WS_Y), (const bf16*)(ws + WS_WTBR), 2 * NTOK, 2048, 512}; MergeOrder S{F.vcu, F.G};
        EpiMerge E{ws};
        pg8::gemm_phase<EpiMerge, MergeOrder, true, true>(F.lds, g, S, E);
        SEAM(4);
    }
    if (IN(5)) {
        pg8::Gemm g{(const bf16*)(ws + WS_MERGED), (const bf16*)(ws + WS_WTOUT), NTOK, 1024, 1024}; pg8::StaticOrder S; S.init(NTOK, 1024, F.G, (int)blockIdx.x);
        EpiOut E{ws, F.x, F.out, F.norm_ffn};
        pg8::gemm_phase<EpiOut, pg8::StaticOrder, true, true>(F.lds, g, S, E);
#if defined(DBG_DUPG) && DBG_DUPG == 5
        xcd_barrier(bar); { EpiNull E2{F.ctl}; pg8::gemm_phase<EpiNull, pg8::StaticOrder, true, true>(F.lds, g, S, E2); }
#endif
        SEAM(5);
    }
    if (IN(6)) {
        pg8::Gemm g{(const bf16*)(ws + WS_HBF), (const bf16*)(ws + WS_WTPEER), NTOK, 2048, 1024}; pg8::StaticOrder S; S.init(NTOK, 2048, F.G, (int)blockIdx.x);
        EpiScore E{(bf16*)(ws + WS_SC)};
#ifdef DBG_F32SCORES
        p6_naive(F);
#else
        pg8::gemm_phase<EpiScore, pg8::StaticOrder, true, true>(F.lds, g, S, E);
#endif
#if defined(DBG_DUPG) && DBG_DUPG == 6
        xcd_barrier(bar); { EpiNull E2{F.ctl}; pg8::gemm_phase<EpiNull, pg8::StaticOrder, true, true>(F.lds, g, S, E2); }
#endif
        SEAM(6);
    }
    if (IN(7)) {
        { const int gw = (int)blockIdx.x * NWAVES + F.wave, NGW = F.G * NWAVES;
          for (int g = gw; g < NTOK / 4; g += NGW) { Frame G = F; asm volatile("" : "+v"(G.tid), "+v"(G.lane)); p7_wave(G, g * 4); } }
#ifdef DBG_PHASE
        __syncthreads(); if (blockIdx.x == 0 && F.tid == 0) { const unsigned long long* ts = (const unsigned long long*)(F.ctl + 12500); const unsigned long long tend = __builtin_amdgcn_s_memrealtime();
            const unsigned long long a0 = ts[DBG_PHASE], a1 = (DBG_PHASE + 1 < 8) ? ts[DBG_PHASE + 1] : tend, b0 = ts[DBG_PHASE + 1], b1 = (DBG_PHASE + 2 < 8) ? ts[DBG_PHASE + 2] : tend;
            { (void)b0; (void)b1; const unsigned long long t1_ = __builtin_amdgcn_s_memrealtime(); while (__builtin_amdgcn_s_memrealtime() - t1_ < (a1 - a0)) __builtin_amdgcn_s_sleep(8); } }
#endif
#ifdef DBG_LOGITSTAT
        __syncthreads(); if (blockIdx.x == 0 && F.tid == 0) { const float v_ = __hip_atomic_load((float*)(F.ctl + 12400 + DBG_LOGITSTAT), RLX_AGENT); F.out[0] = 1000.0f * v_; }
#endif
    }
#undef IN
#undef SEAM
}

#ifndef MK_N_LAUNCHES
#define MK_N_LAUNCHES 1
#endif
extern "C" void kernel_launch(void* const* d_in, const int* in_sizes, int n_in, void* d_out, int out_size, void* d_ws, size_t ws_size, hipStream_t stream) {
    static int grid = 0;
    if (grid == 0) {
        if (n_in != 15 || out_size != NTOK * DM || ws_size < WS_END) { fprintf(stderr, "kernel_launch: unexpected shapes (n_in %d out %d ws %zu)\n", n_in, out_size, ws_size); grid = -1; return; }
        int dev = 0, cus = 0, per_cu = 0;
        if (hipGetDevice(&dev) != hipSuccess || hipDeviceGetAttribute(&cus, hipDeviceAttributeMultiprocessorCount, dev) != hipSuccess) { grid = -1; return; }
        if (hipFuncSetAttribute((const void*)mk_fwd, hipFuncAttributeMaxDynamicSharedMemorySize, LDS_BYTES) != hipSuccess) { fprintf(stderr, "kernel_launch: hipFuncSetAttribute failed\n"); grid = -1; return; }
        if (hipOccupancyMaxActiveBlocksPerMultiprocessor(&per_cu, (const void*)mk_fwd, NWAVES * 64, LDS_BYTES) != hipSuccess || per_cu < 1) { fprintf(stderr, "kernel_launch: occupancy query says %d blocks per CU\n", per_cu); (void)hipGetLastError(); grid = -1; return; }
        grid = cus;
    }
    if (grid < 0) return;
    if (hipMemsetAsync((char*)d_ws + WS_CTL, 0, CTL_ZERO_BYTES, stream) != hipSuccess) return;
    Args a{};
    for (int i = 0; i < 15; ++i) a.in[i] = (const float*)d_in[i];
    a.out = (float*)d_out; a.ws = (unsigned char*)d_ws;
    const int nl = MK_N_LAUNCHES;
    for (int li = 0; li < nl; ++li) {
        a.ph_lo = (nl == 1) ? 0 : li; a.ph_hi = (nl == 1) ? NPHASE : li + 1;
#ifdef DBG_CHECK
#if DBG_CHECK == 1
        if (li == 4) { Args c = a; c.ph_lo = 99; c.ph_hi = 100; hipLaunchKernelGGL(mk_fwd, dim3(grid), dim3(NWAVES * 64), LDS_BYTES, stream, c); }
#else
        if (li >= 5) { Args c = a; c.ph_lo = 95 + li; c.ph_hi = 96 + li; hipLaunchKernelGGL(mk_fwd, dim3(grid), dim3(NWAVES * 64), LDS_BYTES, stream, c); }
#endif
#endif
        hipLaunchKernelGGL(mk_fwd, dim3(grid), dim3(NWAVES * 64), LDS_BYTES, stream, a);
    }
#ifdef DBG_CHECK
    { Args c = a;
#if DBG_CHECK == 2
      c.ph_lo = 103; c.ph_hi = 104; hipLaunchKernelGGL(mk_fwd, dim3(grid), dim3(NWAVES * 64), LDS_BYTES, stream, c);
#endif
      c.ph_lo = 104; c.ph_hi = 105; hipLaunchKernelGGL(mk_fwd, dim3(grid), dim3(NWAVES * 64), LDS_BYTES, stream, c); }
#endif
}
```

```cpp
#include <hip/hip_runtime.h>
#include <cstdio>
#include <cstdint>
namespace pg8 {
#define PG8_LAS __attribute__((address_space(3)))
typedef unsigned short bf16_t;
typedef short bf16x8 __attribute__((ext_vector_type(8)));
typedef float f32x4 __attribute__((ext_vector_type(4)));
typedef unsigned u32x4 __attribute__((ext_vector_type(4)));
constexpr int BM = 256, BK = 64, HALF = 128, HTB = HALF * BK * 2  , STAGE_BYTES = 8 * HTB, NXCD = 8, WGM = 8;

__host__ __device__ __forceinline__ int lds_byte(int r, int c) { const int st = (r >> 4) * 2 + (c >> 5), rr = r & 15, cc = c & 31, ob = rr * 64 + cc * 2; return st * 1024 + (ob ^ (((ob >> 9) & 1) << 5)); }
__host__ __device__ __forceinline__ void stage_rc(int b, int& R, int& C) { const int st = b / 1024, sb = b % 1024, swz = sb ^ (((sb >> 9) & 1) << 5); R = (st >> 1) * 16 + swz / 64; C = (st & 1) * 32 + (swz % 64) / 2; }
__host__ __device__ __forceinline__ int perm32(int rho) { const int n = rho >> 4, i = rho & 15; return 8 * (i >> 2) + 4 * n + (i & 3); }

struct Unit { int pm, pn; };
struct Gemm { const bf16_t* A; const bf16_t* Bt; int M, N, K; };

struct StaticOrder {
    int nM, nN, nwg, G, c;
    __host__ __device__ void init(int M, int N, int G_, int c_) { nM = M / BM; nN = N / BM; nwg = nM * nN; G = G_; c = c_; }
    __host__ __device__ bool next(int i, Unit& u) const {
        const long L = (long)i * G + c; if (L >= nwg) return false;
        int wgid = (int)L; { const int q = nwg / NXCD, r = nwg % NXCD, xcd = wgid % NXCD, off = wgid / NXCD; wgid = (xcd < r ? xcd * (q + 1) : r * (q + 1) + (xcd - r) * q) + off; }
        const int nig = WGM * nN, gid = wgid / nig, fm = gid * WGM, gsz = (nM - fm) < WGM ? (nM - fm) : WGM;
        u.pm = fm + ((wgid % nig) % gsz); u.pn = (wgid % nig) / gsz; return true;
    }
    __device__ __forceinline__ void a_ready(const Unit&) const {}
    __device__ __forceinline__ void done(const Unit&) const {}
};

__device__ __forceinline__ unsigned cvt_pk_bf16(float lo, float hi) { unsigned r; asm volatile("v_cvt_pk_bf16_f32 %0, %1, %2" : "=v"(r) : "v"(lo), "v"(hi)); return r; }
template <class Epi, class Sched, bool ALIGN_EPI = false, bool SP2 = false>
__device__ __forceinline__ void gemm_phase(PG8_LAS unsigned char* lds, const Gemm g, const Sched& S, const Epi& E) {
    const int tid = threadIdx.x, wid = __builtin_amdgcn_readfirstlane(tid >> 6), lane = tid & 63, wr = wid >> 2, wc = wid & 3, fr = lane & 15, fq = lane >> 4;
    const int K = g.K, nt = K / BK;
    unsigned voffA[2], voffB[2];
#pragma unroll
    for (int i = 0; i < 2; ++i) { int R, C; stage_rc(tid * 16 + i * 8192, R, C); const int Rb = Epi::PERM ? ((R & ~31) + perm32(R & 31)) : R;
        voffA[i] = (unsigned)(R * K + C) * 2u; voffB[i] = (unsigned)(Rb * K + C) * 2u; }
    const size_t kstep = (size_t)(BK * 2);
    const size_t hstep = (size_t)HALF * K * 2;
    const size_t tstep = 2 * hstep;
    const unsigned ldsw = (unsigned)wid * 1024u;
    const int aoff = lds_byte(wr * 64 + fr, fq * 8), boff = lds_byte(wc * 32 + fr, fq * 8);
#define PG8_SA(b, h) (((b) * 2 + (h)) * HTB)
#define PG8_SB(b, h) ((4 + (b) * 2 + (h)) * HTB)
#define PG8_STAGE(bufoff, gbase, voff) do { _Pragma("unroll") for (int _i = 0; _i < 2; ++_i) \
        __builtin_amdgcn_global_load_lds((const unsigned*)((const char*)(gbase) + (voff)[_i]), (PG8_LAS unsigned*)(lds + (bufoff) + ldsw + _i * 8192), 16, 0, 0); } while (0)
#define PG8_LDA(dst, b, h) do { _Pragma("unroll") for (int m = 0; m < 4; ++m) _Pragma("unroll") for (int k = 0; k < 2; ++k) dst[m][k] = *(const PG8_LAS bf16x8*)(lds + PG8_SA(b, h) + aoff + m * 2048 + k * 1024); } while (0)
#define PG8_LDB(dst, b, h) do { _Pragma("unroll") for (int n = 0; n < 2; ++n) _Pragma("unroll") for (int k = 0; k < 2; ++k) dst[n][k] = *(const PG8_LAS bf16x8*)(lds + PG8_SB(b, h) + boff + n * 2048 + k * 1024); } while (0)
#define PG8_MMA(ai, bj, At, Bt) do { __builtin_amdgcn_s_setprio(1); _Pragma("unroll") for (int m = 0; m < 4; ++m) _Pragma("unroll") for (int n = 0; n < 2; ++n) _Pragma("unroll") for (int k = 0; k < 2; ++k) \
        acc[ai][bj][m][n] = __builtin_amdgcn_mfma_f32_16x16x32_bf16(Bt[n][k], At[m][k], acc[ai][bj][m][n], 0, 0, 0); __builtin_amdgcn_s_setprio(0); } while (0)
#define PG8_WAIT_V(n) asm volatile("s_waitcnt vmcnt(" #n ")" ::: "memory")
#define PG8_WAIT_L(n) asm volatile("s_waitcnt lgkmcnt(" #n ")" ::: "memory")
#define PG8_BAR __builtin_amdgcn_s_barrier()
#define PG8_SCHED __builtin_amdgcn_sched_barrier(0)
    Unit cur, nxt; int ui = 0;
    if (!S.next(0, cur)) return;
    f32x4 acc[2][2][4][2];
#pragma unroll
    for (int a = 0; a < 2; ++a)
#pragma unroll
        for (int b = 0; b < 2; ++b)
#pragma unroll
            for (int m = 0; m < 4; ++m)
#pragma unroll
                for (int n = 0; n < 2; ++n) acc[a][b][m][n] = (f32x4){0.f, 0.f, 0.f, 0.f};
    bf16x8 At[4][2], B0[2][2], B1[2][2];
    const char* cA = (const char*)g.A + (size_t)cur.pm * tstep; const char* cB = (const char*)g.Bt + (size_t)cur.pn * tstep;
    S.a_ready(cur);
    if constexpr (SP2) {
        PG8_STAGE(PG8_SB(0, 0), cB, voffB); PG8_STAGE(PG8_SB(0, 1), cB + hstep, voffB); PG8_STAGE(PG8_SA(0, 0), cA, voffA); PG8_STAGE(PG8_SA(0, 1), cA + hstep, voffA);
        if (wr == 1) PG8_BAR;
        PG8_WAIT_V(2); PG8_BAR;
        PG8_STAGE(PG8_SB(1, 0), cB + kstep, voffB); PG8_STAGE(PG8_SA(1, 0), cA + kstep, voffA); PG8_STAGE(PG8_SB(1, 1), cB + hstep + kstep, voffB);
        PG8_WAIT_V(6); PG8_BAR;
    } else {
        PG8_STAGE(PG8_SB(0, 0), cB, voffB); PG8_STAGE(PG8_SA(0, 0), cA, voffA); PG8_STAGE(PG8_SB(0, 1), cB + hstep, voffB); PG8_STAGE(PG8_SA(0, 1), cA + hstep, voffA);
        if (wr == 1) PG8_BAR;
        PG8_WAIT_V(4); PG8_BAR;
        PG8_STAGE(PG8_SB(1, 0), cB + kstep, voffB); PG8_STAGE(PG8_SA(1, 0), cA + kstep, voffA); PG8_STAGE(PG8_SB(1, 1), cB + hstep + kstep, voffB);
        PG8_WAIT_V(6); PG8_BAR;
    }
    for (;;) {
        const bool has_next = S.next(ui + 1, nxt);
        const char* nA = has_next ? (const char*)g.A + (size_t)nxt.pm * tstep : cA; const char* nB = has_next ? (const char*)g.Bt + (size_t)nxt.pn * tstep : cB;
        for (int t = 0; t < nt; t += 2) {
            const bool last = (t == nt - 2);
            const char* a1 = cA + (size_t)(t + 1) * kstep;
            const char* a2 = last ? nA : cA + (size_t)(t + 2) * kstep; const char* b2 = last ? nB : cB + (size_t)(t + 2) * kstep;
            const char* a3 = a2 + kstep; const char* b3 = b2 + kstep;
            if (last && has_next) S.a_ready(nxt);
            if constexpr (SP2) {
            PG8_LDB(B0, 0, 0); PG8_LDB(B1, 0, 1); PG8_SCHED; PG8_LDA(At, 0, 0); PG8_STAGE(PG8_SA(1, 1), a1 + hstep, voffA);
            PG8_WAIT_V(8); PG8_WAIT_L(0); PG8_BAR; PG8_MMA(0, 0, At, B0); PG8_MMA(0, 1, At, B1); PG8_BAR; PG8_SCHED;
            PG8_LDA(At, 0, 1); PG8_STAGE(PG8_SB(0, 0), b2, voffB); PG8_STAGE(PG8_SB(0, 1), b2 + hstep, voffB); PG8_STAGE(PG8_SA(0, 0), a2, voffA);
            PG8_WAIT_V(8); PG8_WAIT_L(0); PG8_BAR; PG8_MMA(1, 0, At, B0); PG8_MMA(1, 1, At, B1); PG8_BAR; PG8_SCHED;
            PG8_LDB(B0, 1, 0); PG8_LDB(B1, 1, 1); PG8_SCHED; PG8_LDA(At, 1, 0); PG8_STAGE(PG8_SA(0, 1), a2 + hstep, voffA);
            PG8_WAIT_V(8); PG8_WAIT_L(0); PG8_BAR; PG8_MMA(0, 0, At, B0); PG8_MMA(0, 1, At, B1); PG8_BAR; PG8_SCHED;
            PG8_LDA(At, 1, 1); PG8_STAGE(PG8_SB(1, 0), b3, voffB); PG8_STAGE(PG8_SB(1, 1), b3 + hstep, voffB); PG8_STAGE(PG8_SA(1, 0), a3, voffA);
            PG8_WAIT_V(8); PG8_WAIT_L(0); PG8_BAR; PG8_MMA(1, 0, At, B0); PG8_MMA(1, 1, At, B1); PG8_BAR; PG8_SCHED;
            } else {
            PG8_LDB(B0, 0, 0); PG8_SCHED; PG8_LDA(At, 0, 0); PG8_STAGE(PG8_SA(1, 1), a1 + hstep, voffA);
            PG8_WAIT_L(8); PG8_BAR; PG8_WAIT_L(0); PG8_MMA(0, 0, At, B0); PG8_BAR; PG8_SCHED;
            PG8_LDB(B1, 0, 1); PG8_STAGE(PG8_SB(0, 0), b2, voffB);
            PG8_BAR; PG8_WAIT_L(0); PG8_MMA(0, 1, At, B1); PG8_BAR;
            PG8_LDA(At, 0, 1); PG8_STAGE(PG8_SA(0, 0), a2, voffA);
            PG8_BAR; PG8_WAIT_L(0); PG8_MMA(1, 0, At, B0); PG8_BAR; PG8_SCHED;
            PG8_STAGE(PG8_SB(0, 1), b2 + hstep, voffB);
            PG8_WAIT_V(6); PG8_BAR; PG8_MMA(1, 1, At, B1); PG8_BAR;
            PG8_LDB(B0, 1, 0); PG8_SCHED; PG8_LDA(At, 1, 0); PG8_STAGE(PG8_SA(0, 1), a2 + hstep, voffA);
            PG8_WAIT_L(8); PG8_BAR; PG8_WAIT_L(0); PG8_MMA(0, 0, At, B0); PG8_BAR; PG8_SCHED;
            PG8_LDB(B1, 1, 1); PG8_STAGE(PG8_SB(1, 0), b3, voffB);
            PG8_BAR; PG8_WAIT_L(0); PG8_MMA(0, 1, At, B1); PG8_BAR;
            PG8_LDA(At, 1, 1); PG8_STAGE(PG8_SA(1, 0), a3, voffA);
            PG8_BAR; PG8_WAIT_L(0); PG8_MMA(1, 0, At, B0); PG8_BAR; PG8_SCHED;
            PG8_STAGE(PG8_SB(1, 1), b3 + hstep, voffB);
            PG8_WAIT_V(6); PG8_BAR; PG8_MMA(1, 1, At, B1); PG8_BAR;
            }
        }
        if constexpr (ALIGN_EPI) { if (wr == 0) PG8_BAR; }
        bool keep_ = false; if constexpr (!Epi::AFTER_DRAIN) { keep_ = E(acc, cur, wr, wc, fr, fq); S.done(cur); }
        if (!has_next) break;
        if (!keep_)
#pragma unroll
        for (int a = 0; a < 2; ++a)
#pragma unroll
            for (int b = 0; b < 2; ++b)
#pragma unroll
                for (int m = 0; m < 4; ++m)
#pragma unroll
                    for (int n = 0; n < 2; ++n) acc[a][b][m][n] = (f32x4){0.f, 0.f, 0.f, 0.f};
        cur = nxt; cA = nA; cB = nB; ++ui;
        if constexpr (ALIGN_EPI) { if (wr == 1) PG8_BAR; }
    }
    PG8_WAIT_V(0);
    if constexpr (!ALIGN_EPI) { if (wr == 0) PG8_BAR; }
    PG8_BAR;
    if constexpr (Epi::AFTER_DRAIN) { E.fused(acc, cur, wr, wc, fr, fq, lds, wid, lane); S.done(cur); }
#undef PG8_SA
#undef PG8_SB
#undef PG8_STAGE
#undef PG8_LDA
#undef PG8_LDB
#undef PG8_MMA
#undef PG8_WAIT_V
#undef PG8_WAIT_L
#undef PG8_BAR
#undef PG8_SCHED
}
}
#ifndef DBG_DUP2
#define DBG_DUP2 0
#endif
#ifndef DBG_FOXT0
#define DBG_FOXT0 0
#endif
#ifndef DBG_NSAM
#define DBG_NSAM 0
#endif
#ifndef DBG_DUP3
#define DBG_DUP3 0
#endif
#ifndef DBG_ACTSCALE
#define DBG_ACTSCALE 1.0f
#endif
#ifndef DBG_OUTSCALE
#define DBG_OUTSCALE 1.0f
#endif
#ifndef DBG_KEEP
#define DBG_KEEP 16
#endif
#define COARSE2(w) (((w) + 0x00020002u) & 0xfffcfffcu)
#ifndef DBG_KROPE
#define DBG_KROPE 31
#endif
#ifndef DBG_FOXT
#define DBG_FOXT 1.0f
#endif
#ifndef DBG_NSAT
#define DBG_NSAT 1.0f
#endif
#ifndef DBG_DECAY
#define DBG_DECAY 1.0f
#endif

constexpr int NB = 8, SEQ = 4096, DM = 1024, NTOK = NB * SEQ;
constexpr int NIN = 5120;
constexpr int NEXP = 16384;
constexpr float LOG2E = 1.4426950408889634f;
constexpr float C2 = 0.125f * LOG2E;
constexpr float RMS_EPS = 1e-6f;
constexpr int NWAVES = 8;

constexpr size_t MiB = 1u << 20;
constexpr size_t WS_CTL = 0, CTL_ZERO_BYTES = 1 * MiB;
constexpr size_t WS_SS = 512 * 1024;
constexpr size_t WS_BIAS1 = 768 * 1024;
constexpr size_t WS_WTIN = 2 * MiB, WS_WTBR = 12 * MiB, WS_WTOUT = 14 * MiB, WS_WTPEER = 16 * MiB, WS_W1T = 20 * MiB;
constexpr size_t WS_W2T = 21 * MiB, WS_ROPE = 21 * MiB + 128 * 1024, WS_KCMP = 22 * MiB, WS_VCMP = 22 * MiB + 512 * 1024, WS_LOGF = 23 * MiB;
constexpr size_t WS_UB = 24 * MiB, WS_VB = 56 * MiB;
constexpr size_t WS_U8 = WS_UB, WS_V8 = WS_UB + 16 * MiB, WS_SU = WS_VB, WS_SV = WS_VB + 1 * MiB;
constexpr size_t WS_XN = 88 * MiB;
constexpr size_t WS_Y = WS_XN, WS_HB = WS_XN;
constexpr size_t WS_QF = 152 * MiB, WS_KF = 184 * MiB, WS_VF = 216 * MiB, WS_QN = 248 * MiB;
constexpr size_t WS_MERGED = WS_QF;
constexpr size_t WS_KVC = 280 * MiB, WS_KVS = 296 * MiB, WS_KVW = 312 * MiB;
constexpr size_t WS_GM = 328 * MiB;
constexpr size_t WS_HBF = 328 * MiB;
constexpr size_t WS_GATES = 456 * MiB, WS_CUM = 459 * MiB  , WS_END = 461 * MiB;
constexpr size_t WS_SC = 152 * MiB;
static_assert(WS_SC + (size_t)NTOK * 2048 * 4 <= WS_GATES, "score overlay");
constexpr int CW_BAR = 4096;
constexpr int CW_QATT = 8192, CW_QPEER = 8256;

constexpr int RING_BYTES = 131072;
constexpr int LDS_BYTES = 147456;
constexpr int LDSCTL_OFF = LDS_BYTES - 512, MISC_OFF = LDSCTL_OFF + 64;

#define GAS __attribute__((address_space(1)))
#define LAS __attribute__((address_space(3)))
typedef unsigned short bf16;
typedef unsigned v4u __attribute__((ext_vector_type(4)));
typedef unsigned v2u __attribute__((ext_vector_type(2)));
typedef float f32x4 __attribute__((ext_vector_type(4)));
typedef float f32x2 __attribute__((ext_vector_type(2)));
typedef short bf16x8 __attribute__((ext_vector_type(8)));
typedef short s16x4 __attribute__((ext_vector_type(4)));
typedef float f32x16 __attribute__((ext_vector_type(16)));
typedef __bf16 bf16x2_t __attribute__((ext_vector_type(2)));
typedef GAS unsigned gu32;
#define RLX_AGENT __ATOMIC_RELAXED, __HIP_MEMORY_SCOPE_AGENT
#define LDS_WAIT() asm volatile("s_waitcnt lgkmcnt(0)" ::: "memory")
#define VM_WAIT() asm volatile("s_waitcnt vmcnt(0)" ::: "memory")
__device__ __forceinline__ unsigned pk2(float lo, float hi) { return pg8::cvt_pk_bf16(lo, hi); }
__device__ __forceinline__ float bf_lo(unsigned w) { return __uint_as_float(w << 16); }
__device__ __forceinline__ float bf_hi(unsigned w) { return __uint_as_float(w & 0xffff0000u); }
__device__ __forceinline__ float sigmoidf_(float x) { return __builtin_amdgcn_rcpf(1.0f + __builtin_amdgcn_exp2f(-x * LOG2E)); }
__device__ __forceinline__ float gelu_erf(float v) { return 0.5f * v * (1.0f + erff(v * 0.70710678118654752f)); }
__device__ __forceinline__ float wave_sum(float v) {
#pragma unroll
    for (int o = 1; o < 64; o <<= 1) v += __shfl_xor(v, o);
    return v;
}

#define XB_TMO      128
#define XB_XCNT(j)  (256  + 64 * (j))
#define XB_XSUB(j)  (1280 + 64 * (j))
#define XB_XGEN(j)  (2304 + 64 * (j))
#define XB_TOP      3328
#define XB_TOPGEN   3392
#define XCD_BAR_WORDS 3456
#define XB_SPIN_CAP (1u << 18)

__device__ __forceinline__ unsigned xb_ld(unsigned* p)              { return __hip_atomic_load(p, __ATOMIC_RELAXED, __HIP_MEMORY_SCOPE_AGENT); }
__device__ __forceinline__ unsigned xb_add(unsigned* p, unsigned v) { return __hip_atomic_fetch_add(p, v, __ATOMIC_RELAXED, __HIP_MEMORY_SCOPE_AGENT); }
__device__ __forceinline__ unsigned xb_xcc_id() { return (unsigned)__builtin_amdgcn_s_getreg((3 << 11) | 20) & 0xFu; }
#define XB_SPIN(cond, bar) do { unsigned _sp = 0; while (cond) { __builtin_amdgcn_s_sleep(1); \
    if ((++_sp & 255u) == 0u) { if (xb_ld(&(bar)[XB_TMO])) break; if (_sp > XB_SPIN_CAP) { atomicAdd(&(bar)[XB_TMO], 1u); break; } } } } while (0)

struct XcdBarrier {
    unsigned* bar; unsigned x;
    volatile LAS unsigned* st;
};

__device__ __forceinline__ XcdBarrier xcd_barrier_post(unsigned* bar, volatile LAS unsigned* st) {
    XcdBarrier b; b.bar = bar; b.x = xb_xcc_id(); b.st = st;
    if (threadIdx.x == 0) (void)xb_add(&bar[XB_XCNT(b.x)], 1u);
    return b;
}
__device__ __forceinline__ void xcd_barrier_complete(unsigned* bar, unsigned x, unsigned& nloc, unsigned& nx) {
    const unsigned G = gridDim.x * gridDim.y * gridDim.z;
    unsigned sum, cnt, mine, sp = 0u;
    for (;;) {
        sum = 0u; cnt = 0u; mine = 0u;
#pragma unroll
        for (unsigned j = 0; j < 16; ++j) { const unsigned c = xb_ld(&bar[XB_XCNT(j)]); sum += c; cnt += (c > 0u) ? 1u : 0u; mine = (j == x) ? c : mine; }
        if (sum == G) break;
        __builtin_amdgcn_s_sleep(1);
        if ((++sp & 255u) == 0u) { if (xb_ld(&bar[XB_TMO])) break; if (sp > XB_SPIN_CAP) { atomicAdd(&bar[XB_TMO], 1u); break; } }
    }
    nloc = mine > 0u ? mine : 1u; nx = cnt > 0u ? cnt : 1u;
}

__device__ __forceinline__ void xcd_barrier(const XcdBarrier& b) {
    asm volatile("s_waitcnt vmcnt(0)" ::: "memory");
    __syncthreads();
    if (threadIdx.x == 0) {
        unsigned* bar = b.bar;
        __builtin_amdgcn_s_waitcnt(0);
        unsigned nloc = b.st[0], nx = b.st[1];
        if (nloc == 0u) { xcd_barrier_complete(bar, b.x, nloc, nx); b.st[0] = nloc; b.st[1] = nx; }
        const unsigned old = xb_add(&bar[XB_XSUB(b.x)], 1u);
        const unsigned gen = old / nloc;
        if (old + 1u == (gen + 1u) * nloc) {
            __builtin_amdgcn_fence(__ATOMIC_RELEASE, "agent");
            asm volatile("s_waitcnt vmcnt(0)" ::: "memory");
            const unsigned og = xb_add(&bar[XB_TOP], 1u);
            const unsigned tg = og / nx;
            if (og + 1u == (tg + 1u) * nx) xb_add(&bar[XB_TOPGEN], 1u);
            else XB_SPIN(xb_ld(&bar[XB_TOPGEN]) == tg, bar);
            __builtin_amdgcn_fence(__ATOMIC_ACQUIRE, "agent");
            xb_add(&bar[XB_XGEN(b.x)], 1u);
            asm volatile("s_waitcnt vmcnt(0)" ::: "memory");
        } else {
            XB_SPIN(xb_ld(&bar[XB_XGEN(b.x)]) == gen, bar);
            __builtin_amdgcn_fence(__ATOMIC_ACQUIRE, "agent");
            asm volatile("s_waitcnt vmcnt(0)" ::: "memory");
        }
    }
    __syncthreads();
}


struct Frame {
    LAS unsigned char* lds;
    volatile LAS unsigned* MISC;
    gu32* ctl;
    int tid, lane, wave, vcu, G;
    unsigned char* ws;
    const float *x, *norm_mix, *w_in, *fbias, *cmp_pos, *cmp_w1, *cmp_w2, *w_branch, *w_out, *norm_ffn, *peer_wq, *peer_sk, *peer_u, *peer_v, *norm_final;
    float* out;
};

__device__ __forceinline__ int src_col_in(int n) {
    if (n < 1536) return n;
    if (n < 2816) return n + 8;
    if (n < 2824) return n - 2816 + 1536;
    if (n < 2848) return n;
    if (n < 3072) return -1;
    { const int m = n - 3072, i = m >> 8, half = (m >> 7) & 1, c = m & 127; return 2848 + half * 1024 + i * 128 + c; }
}
__device__ __forceinline__ void p0_tr_item(const float* W, int ldw, int K, bf16* WT, int kb, int dst_row0, int src_col, LAS float* scr, int lane) {
    const int k0 = 64 * kb;
    { f32x4 v_[8];
#pragma unroll
      for (int i = 0; i < 8; ++i) { const int kk = 8 * i + (lane >> 3); v_[i] = (src_col >= 0) ? *(const GAS f32x4*)(W + (size_t)(k0 + kk) * ldw + src_col) : (f32x4){0.f, 0.f, 0.f, 0.f}; }
#pragma unroll
      for (int i = 0; i < 8; ++i) { const int kk = 8 * i + (lane >> 3); LAS float* d_ = scr + kk * 33 + 4 * (lane & 7); d_[0] = v_[i].x; d_[1] = v_[i].y; d_[2] = v_[i].z; d_[3] = v_[i].w; } }
    LDS_WAIT(); asm volatile("" ::: "memory");
    const int c = lane & 7;
#pragma unroll
    for (int j = 0; j < 4; ++j) { const int n = (lane >> 3) + 8 * j; const LAS float* s = scr + (8 * c) * 33 + n;
        v4u o; o.x = pk2(s[0 * 33], s[1 * 33]); o.y = pk2(s[2 * 33], s[3 * 33]); o.z = pk2(s[4 * 33], s[5 * 33]); o.w = pk2(s[6 * 33], s[7 * 33]);
#ifdef DBG_C_W
        o.x = COARSE2(o.x); o.y = COARSE2(o.y); o.z = COARSE2(o.z); o.w = COARSE2(o.w);
#endif
        *(GAS v4u*)(WT + (size_t)(dst_row0 + n) * K + k0 + 8 * c) = o; }
    LDS_WAIT(); asm volatile("" ::: "memory");
}
__device__ __forceinline__ void p0_prologue(Frame& F, bool skip_bias = false) {
    LAS float* scr = (LAS float*)(F.lds + F.wave * 16384);
    unsigned char* ws = F.ws;
    const int gw = F.vcu * NWAVES + F.wave, NGW = F.G * NWAVES, lane = F.lane;
    const int gt = gw * 64 + lane, NGT = NGW * 64;
#pragma nounroll
    for (int pass_ = 0; pass_ < 2; ++pass_) {
    if (((pass_ ^ F.vcu) & 1) == 0) {
    constexpr int I_IN = 16 * 160, I_BR = 8 * 32, I_OUT = 16 * 32, I_W1 = 32 * 4, I_W2 = 2 * 2;
    constexpr int NITEMS = I_IN + 2 * I_BR + I_OUT + 2 * I_W1 + 2 * I_W2;
    for (int it = gw; it < NITEMS; it += NGW) {
        int r = it;
        if (r < I_IN) { const int kb = r / 160, nb = r % 160; p0_tr_item(F.w_in, 4896, 1024, (bf16*)(ws + WS_WTIN), kb, 32 * nb, src_col_in(32 * nb + 4 * (lane & 7)), scr, lane); continue; } r -= I_IN;
        if (r < 2 * I_BR) { const int br = r / I_BR, q = r % I_BR, kb = q / 32, nb = q % 32; p0_tr_item(F.w_branch + (size_t)br * 512 * 1024, 1024, 512, (bf16*)(ws + WS_WTBR), kb, br * 1024 + 32 * nb, 32 * nb + 4 * (lane & 7), scr, lane); continue; } r -= 2 * I_BR;
        if (r < I_OUT) { const int kb = r / 32, nb = r % 32; p0_tr_item(F.w_out, 1024, 1024, (bf16*)(ws + WS_WTOUT), kb, 32 * nb, 32 * nb + 4 * (lane & 7), scr, lane); continue; } r -= I_OUT;
        if (r < 2 * I_W1) { const int j = r / I_W1, q = r % I_W1, kb = q / 4, nb = q % 4; p0_tr_item(F.cmp_w1 + (size_t)j * 2048 * 128, 128, 2048, (bf16*)(ws + WS_W1T), kb, j * 128 + 32 * nb, 32 * nb + 4 * (lane & 7), scr, lane); continue; } r -= 2 * I_W1;
        { const int j = r / I_W2, q = r % I_W2, kb = q / 2, nb = q % 2; p0_tr_item(F.cmp_w2 + (size_t)j * 128 * 64, 64, 128, (bf16*)(ws + WS_W2T), kb, j * 64 + 32 * nb, 32 * nb + 4 * (lane & 7), scr, lane); }
    }
    { LAS float* skl = (LAS float*)F.lds; LAS float* wql = skl + 128 * 129;
      for (int it = F.vcu; it < 16 * 16; it += F.G) { const int hp = it >> 4, kc = it & 15;
        __syncthreads();
        for (int e = F.tid; e < 128 * 32; e += NWAVES * 64) { const int n = e >> 5, d4 = e & 31; const f32x4 v = *((const GAS f32x4*)(F.peer_sk + (size_t)(hp * 128 + n) * 128) + d4);
            skl[n * 129 + 4 * d4] = v.x; skl[n * 129 + 4 * d4 + 1] = v.y; skl[n * 129 + 4 * d4 + 2] = v.z; skl[n * 129 + 4 * d4 + 3] = v.w; }
        for (int e = F.tid; e < 64 * 32; e += NWAVES * 64) { const int k = e >> 5, d4 = e & 31; *((LAS f32x4*)(wql + k * 128) + d4) = *((const GAS f32x4*)(F.peer_wq + (size_t)(kc * 64 + k) * 2048 + hp * 128) + d4); }
        __syncthreads();
        const int n = F.tid & 127, kq = __builtin_amdgcn_readfirstlane(F.tid >> 7);
        float acc[16];
#pragma unroll
        for (int j = 0; j < 16; ++j) acc[j] = 0.f;
        for (int d4 = 0; d4 < 32; ++d4) { const float s0 = skl[n * 129 + 4 * d4], s1 = skl[n * 129 + 4 * d4 + 1], s2 = skl[n * 129 + 4 * d4 + 2], s3 = skl[n * 129 + 4 * d4 + 3];
#pragma unroll
            for (int j = 0; j < 16; ++j) { const f32x4 w = *((const LAS f32x4*)(wql + (kq * 16 + j) * 128) + d4); acc[j] += (s0 * w.x + s1 * w.y) + (s2 * w.z + s3 * w.w); } }
        { const GAS f32x4* gk = (const GAS f32x4*)(F.norm_ffn + kc * 64 + kq * 16);
#pragma unroll
          for (int q = 0; q < 4; ++q) { const f32x4 g4 = gk[q]; acc[4 * q] *= g4.x; acc[4 * q + 1] *= g4.y; acc[4 * q + 2] *= g4.z; acc[4 * q + 3] *= g4.w; } }
        bf16* WtP = (bf16*)(ws + WS_WTPEER) + (size_t)(hp * 128 + n) * 1024 + kc * 64 + kq * 16;
        v4u o0, o1; o0.x = pk2(acc[0], acc[1]); o0.y = pk2(acc[2], acc[3]); o0.z = pk2(acc[4], acc[5]); o0.w = pk2(acc[6], acc[7]);
        o1.x = pk2(acc[8], acc[9]); o1.y = pk2(acc[10], acc[11]); o1.z = pk2(acc[12], acc[13]); o1.w = pk2(acc[14], acc[15]);
        *(GAS v4u*)WtP = o0; *(GAS v4u*)(WtP + 8) = o1;
      }
      __syncthreads(); }
    if (!skip_bias) for (int it = gt; it < 2 * 128 * 64; it += NGT) {
        const int n = it & 127, j = (it >> 7) & 1, ch = it >> 8;
        const float* p = F.cmp_pos + (size_t)j * 2048 + ch * 32; const float* w = F.cmp_w1 + ((size_t)j * 2048 + ch * 32) * 128 + n;
        float pv[32], wv[32];
#pragma unroll
        for (int k = 0; k < 32; ++k) { pv[k] = p[k]; wv[k] = w[(size_t)k * 128]; }
        float a = 0.f;
#pragma unroll
        for (int k = 0; k < 32; ++k) a += pv[k] * wv[k];
        atomicAdd((float*)(ws + WS_BIAS1) + j * 128 + n, a);
    }
    for (int it = gt; it < SEQ * 8; it += NGT) {
        const int pos = it >> 3, i = it & 7;
        const double inv[8] = {1.0, 0.19392274474868576, 0.03760603093086393, 0.007292664737217109, 0.001414213562373095, 0.0002742481756762073, 5.318295896944988e-05, 1.031338537721246e-05};
        double iv = inv[0];
#pragma unroll
        for (int q = 1; q < 8; ++q) iv = (i == q) ? inv[q] : iv;
        const double rev = (double)pos * iv * 0.15915494309189535; const float fr = (float)(rev - __builtin_rint(rev));
        f32x2 cs; cs.x = __builtin_amdgcn_cosf(fr); cs.y = __builtin_amdgcn_sinf(fr);
        ((GAS f32x2*)(ws + WS_ROPE))[it] = cs;
    }
    } else {
    { const GAS f32x4* gr = (const GAS f32x4*)F.norm_mix + lane; f32x4 gq[4];
#pragma unroll
      for (int j = 0; j < 4; ++j) gq[j] = gr[64 * j];
      for (int m0 = gw * 4; m0 < NTOK; m0 += NGW * 4) {
        f32x4 v[4][4]; float sq[4];
#pragma unroll
        for (int r = 0; r < 4; ++r) { const GAS f32x4* xr = (const GAS f32x4*)(F.x + (size_t)(m0 + r) * DM) + lane;
#pragma unroll
            for (int j = 0; j < 4; ++j) v[r][j] = xr[64 * j]; }
#pragma unroll
        for (int r = 0; r < 4; ++r) { float a = 0.f;
#pragma unroll
            for (int j = 0; j < 4; ++j) a += (v[r][j].x * v[r][j].x + v[r][j].y * v[r][j].y) + (v[r][j].z * v[r][j].z + v[r][j].w * v[r][j].w);
            sq[r] = a; }
#pragma unroll
        for (int o = 1; o < 64; o <<= 1) {
#pragma unroll
            for (int r = 0; r < 4; ++r) sq[r] += __shfl_xor(sq[r], o); }
#pragma unroll
        for (int r = 0; r < 4; ++r) { const float rr = 1.0f / sqrtf(sq[r] * (1.f / DM) + RMS_EPS);
            GAS v2u* o8 = (GAS v2u*)((bf16*)(ws + WS_XN) + (size_t)(m0 + r) * DM) + lane;
#pragma unroll
            for (int j = 0; j < 4; ++j) { const f32x4 g = gq[j]; v2u o; o.x = pk2(v[r][j].x * rr * g.x, v[r][j].y * rr * g.y); o.y = pk2(v[r][j].z * rr * g.z, v[r][j].w * rr * g.w);
                o8[64 * j] = o; } }
      } }
    for (int r0 = gw * 4; r0 < 2 * NEXP; r0 += NGW * 4) {
        f32x4 a[4][4]; float mx[4];
#pragma unroll
        for (int q = 0; q < 4; ++q) { const int r = r0 + q; const bool isv = r >= NEXP; const int e = isv ? r - NEXP : r;
            const GAS f32x4* src = (const GAS f32x4*)((isv ? F.peer_v : F.peer_u) + (size_t)e * DM) + 4 * lane;
#pragma unroll
            for (int j = 0; j < 4; ++j) a[q][j] = src[j]; }
#pragma unroll
        for (int q = 0; q < 4; ++q) { float m = 0.f;
#pragma unroll
            for (int j = 0; j < 4; ++j) m = fmaxf(m, fmaxf(fmaxf(fabsf(a[q][j].x), fabsf(a[q][j].y)), fmaxf(fabsf(a[q][j].z), fabsf(a[q][j].w))));
            mx[q] = m; }
#pragma unroll
        for (int o = 1; o < 64; o <<= 1) {
#pragma unroll
            for (int q = 0; q < 4; ++q) mx[q] = fmaxf(mx[q], __shfl_xor(mx[q], o)); }
#pragma unroll
        for (int q = 0; q < 4; ++q) { const int r = r0 + q; const bool isv = r >= NEXP; const int e = isv ? r - NEXP : r; const float m = mx[q];
            const float inv = m > 0.f ? 6.0f / m : 0.f, sc = m > 0.f ? m * (1.0f / 6.0f) : 1.0f;
            v2u o; unsigned w = 0u;
            w = __builtin_amdgcn_cvt_scalef32_pk_fp4_f32(w, a[q][0].x * inv, a[q][0].y * inv, 1.0f, 0); w = __builtin_amdgcn_cvt_scalef32_pk_fp4_f32(w, a[q][0].z * inv, a[q][0].w * inv, 1.0f, 1);
            w = __builtin_amdgcn_cvt_scalef32_pk_fp4_f32(w, a[q][1].x * inv, a[q][1].y * inv, 1.0f, 2); w = __builtin_amdgcn_cvt_scalef32_pk_fp4_f32(w, a[q][1].z * inv, a[q][1].w * inv, 1.0f, 3); o.x = w; w = 0u;
            w = __builtin_amdgcn_cvt_scalef32_pk_fp4_f32(w, a[q][2].x * inv, a[q][2].y * inv, 1.0f, 0); w = __builtin_amdgcn_cvt_scalef32_pk_fp4_f32(w, a[q][2].z * inv, a[q][2].w * inv, 1.0f, 1);
            w = __builtin_amdgcn_cvt_scalef32_pk_fp4_f32(w, a[q][3].x * inv, a[q][3].y * inv, 1.0f, 2); w = __builtin_amdgcn_cvt_scalef32_pk_fp4_f32(w, a[q][3].z * inv, a[q][3].w * inv, 1.0f, 3); o.y = w;
            *((GAS v2u*)(ws + (isv ? WS_V8 : WS_U8) + (size_t)e * (DM / 2)) + lane) = o;
            if (lane == 0) ((float*)(ws + (isv ? WS_SV : WS_SU)))[e] = sc; }
    }
    }
    }
}

struct EpiIn {
    static constexpr bool PERM = true, AFTER_DRAIN = false;
    unsigned char* ws; const float* fbias;
    __device__ __forceinline__ bool operator()(f32x4 (&acc)[2][2][4][2], const pg8::Unit& u, int wr, int wc, int fr, int fq) const {
        const int pn = u.pn, row0 = u.pm * 256 + wr * 64 + fr;
        if (pn == 11) {
            if (wc == 0) {
#pragma unroll
                for (int ai = 0; ai < 2; ++ai)
#pragma unroll
                    for (int m = 0; m < 4; ++m) { const int row = row0 + ai * 128 + m * 16; const f32x4 v0 = acc[ai][0][m][0], v1 = acc[ai][0][m][1];
                        float v[8] = {v0.x, v0.y, v0.z, v0.w, v1.x, v1.y, v1.z, v1.w}, o[8];
                        if (fq == 0) {
#pragma unroll
                            for (int i = 0; i < 8; ++i) { const float z = v[i] + fbias[i]; o[i] = fminf(z, 0.f) - log1pf(__expf(-fabsf(z))); }
                            GAS f32x4* d = (GAS f32x4*)((float*)(ws + WS_LOGF) + (size_t)row * 8); d[0] = (f32x4){o[0], o[1], o[2], o[3]}; d[1] = (f32x4){o[4], o[5], o[6], o[7]};
                        } else {
#pragma unroll
                            for (int i = 0; i < 8; ++i) o[i] = sigmoidf_(v[i]);
                            GAS f32x4* d = (GAS f32x4*)((float*)(ws + WS_GATES) + (size_t)row * 24 + (fq - 1) * 8); d[0] = (f32x4){o[0], o[1], o[2], o[3]}; d[1] = (f32x4){o[4], o[5], o[6], o[7]};
                        } }
            }
            return false;
        }
        if (pn >= 12) {
            bf16* gm = (bf16*)(ws + WS_GM) + (size_t)(pn - 12) * 256 + wc * 32 + 8 * fq;
#pragma unroll
            for (int ai = 0; ai < 2; ++ai)
#pragma unroll
                for (int m = 0; m < 4; ++m) { const int row = row0 + ai * 128 + m * 16; const f32x4 a0 = acc[ai][0][m][0], a1 = acc[ai][0][m][1], b0 = acc[ai][1][m][0], b1 = acc[ai][1][m][1];
                    const float av[8] = {a0.x, a0.y, a0.z, a0.w, a1.x, a1.y, a1.z, a1.w}, bv[8] = {b0.x, b0.y, b0.z, b0.w, b1.x, b1.y, b1.z, b1.w}; float rt_[8], g1_[8];
#pragma unroll
                    for (int i = 0; i < 8; ++i) { const float ea = __builtin_amdgcn_exp2f(-av[i] * LOG2E), eb = __builtin_amdgcn_exp2f(-bv[i] * LOG2E), d1 = 1.0f + eb;
                        g1_[i] = __builtin_amdgcn_rcpf(d1); rt_[i] = (d1 < 1e30f) ? d1 * __builtin_amdgcn_rcpf(1.0f + ea) : 0.f; }
                    v4u wr_, wg_; wr_.x = pk2(rt_[0], rt_[1]); wr_.y = pk2(rt_[2], rt_[3]); wr_.z = pk2(rt_[4], rt_[5]); wr_.w = pk2(rt_[6], rt_[7]);
                    wg_.x = pk2(g1_[0], g1_[1]); wg_.y = pk2(g1_[2], g1_[3]); wg_.z = pk2(g1_[4], g1_[5]); wg_.w = pk2(g1_[6], g1_[7]);
                    *(GAS v4u*)(gm + (size_t)row * 2048) = wr_; *(GAS v4u*)(gm + (size_t)row * 2048 + 128) = wg_; }
            return false;
        }
        bf16* dst; int pitch, colt; float sc = 1.f; int mode = 0;
        bool rope_bj1 = false; int kvt = 0, nh = 8;
        if (pn < 2)       { dst = (bf16*)(ws + WS_QF); pitch = 512; colt = pn * 256; sc = C2 * DBG_FOXT; }
        else if (pn < 4)  { dst = (bf16*)(ws + WS_KF); pitch = 512; colt = (pn - 2) * 256; kvt = 1; }
        else if (pn < 6)  { dst = (bf16*)(ws + WS_VF); pitch = 512; colt = (pn - 4) * 256; kvt = 2; }
        else if (pn < 8)  { dst = (bf16*)(ws + WS_QN); pitch = 512; colt = (pn - 6) * 256; sc = C2 * DBG_NSAT; mode = 1; rope_bj1 = true; }
        else if (pn == 8) { dst = (bf16*)(ws + WS_KVC); pitch = 256; colt = 0; }
        else if (pn == 9) { dst = (bf16*)(ws + WS_KVS); pitch = 256; colt = 0; mode = 1; kvt = 3; nh = 2; }
        else if (pn == 10){ dst = (bf16*)(ws + WS_KVW); pitch = 256; colt = 0; mode = 1; kvt = 3; nh = 2; }
        else              { dst = (bf16*)(ws + WS_GM); pitch = 2048; colt = (pn - 12) * 256; mode = 2; }
        const int cb0 = wc * 32 + 8 * fq;
        const bool ropelane = ((wc & 1) == 0) && (fq < 2);
        const GAS f32x2* rt = (const GAS f32x2*)(ws + WS_ROPE);
#pragma unroll
        for (int ai = 0; ai < 2; ++ai)
#pragma unroll
            for (int m = 0; m < 4; ++m) { const int row = row0 + ai * 128 + m * 16; bf16* rowp = dst + (size_t)row * pitch + colt + cb0;
#pragma unroll
                for (int bj = 0; bj < 2; ++bj) { const f32x4 a0 = acc[ai][bj][m][0], a1 = acc[ai][bj][m][1];
                    float v[8] = {a0.x, a0.y, a0.z, a0.w, a1.x, a1.y, a1.z, a1.w};
                    if (mode == 1 && (bj == 0 || rope_bj1) && ((wc & 1) == 0)) {
                        const int pos = row & (SEQ - 1);
#pragma unroll
                        for (int i = 0; i < 8; ++i) { const float pv = __shfl_xor(v[i], 16); if (ropelane) { const f32x2 cs = rt[pos * 8 + i];
                                v[i] = (fq == 0) ? (v[i] * cs.x - pv * cs.y) : (pv * cs.y + v[i] * cs.x); } }
                    }
                    if (mode == 2) {
#pragma unroll
                        for (int i = 0; i < 8; ++i) v[i] = sigmoidf_(v[i]);
                    }
                    v4u w; w.x = pk2(v[0] * sc, v[1] * sc); w.y = pk2(v[2] * sc, v[3] * sc); w.z = pk2(v[4] * sc, v[5] * sc); w.w = pk2(v[6] * sc, v[7] * sc);
#ifdef DBG_C_INPROJ
                    w.x = COARSE2(w.x); w.y = COARSE2(w.y); w.z = COARSE2(w.z); w.w = COARSE2(w.w);
#endif
                    if (kvt == 0) *(GAS v4u*)(rowp + bj * 128) = w;
                    else {
                        const int bb = row >> 12, sq = row & (SEQ - 1), tile = sq >> 6, r = sq & 63;
                        const int col = (kvt == 3) ? cb0 : (colt + cb0 + bj * 128);
                        const int hh = col >> 6, d = col & 63; const bool isv = (kvt == 2) || (kvt == 3 && bj == 1);
                        unsigned char* img = (unsigned char*)dst + (isv && kvt == 3 ? 8 * MiB : 0) + ((size_t)((bb * nh + hh) * 64 + tile) << 13);
                        const int off = isv ? ((d >> 5) * 4096 + (r >> 4) * 1024 + (r & 15) * 64 + (d & 31) * 2) : ((d >> 3) * 1024 + r * 16);
                        *(GAS v4u*)(img + off) = w; } } }
        return false;
    }
};

__device__ __forceinline__ void p2_compress_unit(Frame& F, int uidx) {
    unsigned char* ws = F.ws; const int lane = F.lane, wid = F.wave, tid = F.tid;
    const int j = uidx & 1, nb = (uidx >> 1) & 15, g = (uidx >> 5) & 1, b = uidx >> 6;
    const bf16* KVC = (const bf16*)(ws + WS_KVC); const bf16* W1T = (const bf16*)(ws + WS_W1T) + (size_t)j * 128 * 2048; const bf16* W2T = (const bf16*)(ws + WS_W2T) + (size_t)j * 64 * 128;
    constexpr int APITCH = 4096 + 16;
    LAS unsigned char* aimg = F.lds;
    LAS bf16* h1b = (LAS bf16*)(F.lds + 32 * APITCH);
    const int fr = lane & 15, fq = lane >> 4;
    { v4u pc[16];
#pragma unroll
      for (int i = 0; i < 16; ++i) { const int p = tid + 512 * i, bs = p >> 12, n = (p >> 8) & 15, l = (p >> 3) & 31, c8 = p & 7; int nn = nb * 16 + n; nn = nn > 254 ? 254 : nn;
          pc[i] = *(const GAS v4u*)(KVC + ((size_t)(b + 4 * bs) * SEQ + 16 * nn + l) * 256 + j * 128 + g * 64 + c8 * 8); }
#pragma unroll
      for (int i = 0; i < 16; ++i) { const int p = tid + 512 * i, bs = p >> 12, n = (p >> 8) & 15, l = (p >> 3) & 31, c8 = p & 7;
          *(LAS v4u*)(aimg + (bs * 16 + n) * APITCH + l * 128 + c8 * 16) = pc[i]; } }
    const bf16* wrow = W1T + (size_t)(wid * 16 + fr) * 2048 + 8 * fq;
    bf16x8 bw[16];
#pragma unroll
    for (int s = 0; s < 16; ++s) bw[s] = *(const GAS bf16x8*)(wrow + 32 * s);
    bf16x8 w2f[4];
#pragma unroll
    for (int k2 = 0; k2 < 4; ++k2) w2f[k2] = *(const GAS bf16x8*)(W2T + (size_t)((wid & 3) * 16 + fr) * 128 + k2 * 32 + 8 * fq);
    __syncthreads();
    f32x4 acc0 = (f32x4){0.f, 0.f, 0.f, 0.f}, acc1 = acc0;
    const LAS unsigned char* ap0 = aimg + fr * APITCH + fq * 16; const LAS unsigned char* ap1 = ap0 + 16 * APITCH;
#pragma unroll
    for (int s0 = 0; s0 < 64; s0 += 16) {
#pragma unroll
        for (int q = 0; q < 16; ++q) { const int s = s0 + q;
            const bf16x8 a0 = *(const LAS bf16x8*)(ap0 + (s >> 1) * 128 + (s & 1) * 64), a1 = *(const LAS bf16x8*)(ap1 + (s >> 1) * 128 + (s & 1) * 64);
            acc0 = __builtin_amdgcn_mfma_f32_16x16x32_bf16(a0, bw[q], acc0, 0, 0, 0); acc1 = __builtin_amdgcn_mfma_f32_16x16x32_bf16(a1, bw[q], acc1, 0, 0, 0);
            if (s0 + 16 < 64) bw[q] = *(const GAS bf16x8*)(wrow + 32 * (s + 16)); } }
    { const float bias = ((const float*)(ws + WS_BIAS1))[j * 128 + wid * 16 + fr];
#pragma unroll
      for (int r = 0; r < 4; ++r) { h1b[(4 * fq + r) * 128 + wid * 16 + fr] = (bf16)(pk2(gelu_erf(acc0[r] + bias), 0.f) & 0xffffu); h1b[2048 + (4 * fq + r) * 128 + wid * 16 + fr] = (bf16)(pk2(gelu_erf(acc1[r] + bias), 0.f) & 0xffffu); } }
    __syncthreads();
    {
        const int u = wid >> 2, wq = wid & 3, bb = b + 4 * u;
        f32x4 a2 = (f32x4){0.f, 0.f, 0.f, 0.f};
#pragma unroll
        for (int k2 = 0; k2 < 4; ++k2) { const bf16x8 a = *(const LAS bf16x8*)(h1b + u * 2048 + fr * 128 + k2 * 32 + 8 * fq);
            a2 = __builtin_amdgcn_mfma_f32_16x16x32_bf16(a, w2f[k2], a2, 0, 0, 0); }
        bf16* dstb = (bf16*)(ws + (j == 0 ? WS_KCMP : WS_VCMP));
        const GAS f32x2* rt = (const GAS f32x2*)(ws + WS_ROPE);
#pragma unroll
        for (int r = 0; r < 4; ++r) { const int nrow = nb * 16 + 4 * fq + r; float v = a2[r];
            if (j == 0 && wq == 0 && DBG_KROPE >= 0) { const float pv = __shfl_xor(v, 8); const int pos = (16 * nrow + DBG_KROPE) & (SEQ - 1); const f32x2 cs = rt[pos * 8 + (fr & 7)];
                v = (fr < 8) ? (v * cs.x - pv * cs.y) : (pv * cs.y + v * cs.x); }
            if (nrow > 254) v = 0.f;
            dstb[((size_t)bb * 256 + nrow) * 128 + g * 64 + wq * 16 + fr] = (bf16)(pk2(v, 0.f) & 0xffffu); }
    }
    __syncthreads();
}
__device__ __forceinline__ void p2_cumsum_wave(Frame& F, int bh) {
    const int b = bh >> 3, h = bh & 7, lane = F.lane;
    const float* lf = (const float*)(F.ws + WS_LOGF) + ((size_t)b * SEQ + lane) * 8 + h;
    float v[64];
#pragma unroll
    for (int i = 0; i < 64; ++i) v[i] = lf[(size_t)i * 64 * 8];
    v2u* cum = (v2u*)(F.ws + WS_CUM) + (size_t)bh * SEQ + lane;
#pragma unroll
    for (int o = 1; o < 64; o <<= 1) { float t[64];
#pragma unroll
        for (int i = 0; i < 64; ++i) t[i] = __shfl_up(v[i], o);
        const bool take = lane >= o;
#pragma unroll
        for (int i = 0; i < 64; ++i) v[i] += take ? t[i] : 0.f; }
    float carry = 0.f;
#pragma unroll
    for (int i = 0; i < 64; ++i) { const float rowtot = __uint_as_float(__builtin_amdgcn_readlane(__float_as_uint(v[i]), 63)); const float x = v[i] + carry; carry += rowtot;
        { const float c = -LOG2E * DBG_DECAY * x; const unsigned h_ = pk2(c, 0.f) & 0xffffu; const float r1 = c - __uint_as_float(h_ << 16);
            const unsigned m_ = pk2(r1, 0.f) & 0xffffu; const float r2 = r1 - __uint_as_float(m_ << 16); const unsigned l_ = pk2(r2, 0.f) & 0xffffu;
            v2u w; w.x = h_ | (m_ << 16); w.y = l_ | 0x3F800000u; cum[i * 64] = w; } }
}

#include <hip/hip_bf16.h>
#include <cmath>
namespace fa {
using bf16=__hip_bfloat16;
using bf16x8=__attribute__((ext_vector_type(8)))short;
using s16x4=__attribute__((ext_vector_type(4)))short;
using f32x16=__attribute__((ext_vector_type(16)))float;
using u32x4=__attribute__((ext_vector_type(4)))unsigned;
typedef float f32x4_t __attribute__((ext_vector_type(4)));
constexpr int D=64;
constexpr int NW=8,QBLK=32,KVBLK=64;
__device__ __forceinline__ int crow(int r,int hi){return (r&3)+8*(r>>2)+4*hi;}
#define SBAR() __builtin_amdgcn_sched_barrier(0)
__device__ __forceinline__ void cmask(f32x16&p0,f32x16&p1,int jb,int qrel,int hi){
  const float NEG=-INFINITY; int kb=64*jb+4*hi;
  #pragma unroll
  for(int r=0;r<16;++r){int kv=kb+(r&3)+8*(r>>2); if(kv>qrel)p0[r]=NEG; if(kv+32>qrel)p1[r]=NEG;}
}

constexpr int NSLOT=3, SLOTB=8192;
constexpr int LDS_K=0, LDS_V=NSLOT*SLOTB, LDS_WS=2*NSLOT*SLOTB;
constexpr float C2=0.125f*1.4426950408889634f;
__device__ __forceinline__ void glds16(const void*gsrc,unsigned lds_dst){unsigned keep;
  asm volatile("s_mov_b32 %0, m0\n\ts_mov_b32 m0, %2\n\ts_nop 0\n\tglobal_load_lds_dwordx4 %1, off\n\ts_mov_b32 m0, %0":"=&s"(keep):"v"(gsrc),"s"(lds_dst):"memory");}
__device__ __forceinline__ float max3f(float a,float b,float c){float r;asm("v_max3_f32 %0, %1, %2, %3":"=v"(r):"v"(a),"v"(b),"v"(c));return r;}
__device__ __forceinline__ float max2f(float a,float b){float r;asm("v_max_f32_e32 %0, %1, %2":"=v"(r):"v"(a),"v"(b));return r;}
__device__ __forceinline__ float fadd_s(float a,float b){float r;asm("v_add_f32_e32 %0, %1, %2":"=v"(r):"v"(a),"v"(b));return r;}
__device__ __forceinline__ float fsub_s(float a,float b){float r;asm("v_sub_f32_e32 %0, %1, %2":"=v"(r):"v"(a),"v"(b));return r;}
typedef float f32x2_t __attribute__((ext_vector_type(2))); typedef __bf16 bf16x2_t __attribute__((ext_vector_type(2)));
__device__ __forceinline__ unsigned cvtpk_s(float lo,float hi){f32x2_t v={lo,hi};bf16x2_t b=__builtin_convertvector(v,bf16x2_t);return __builtin_bit_cast(unsigned,b);}
#define WAIT_BAR(N) asm volatile("s_waitcnt vmcnt(" #N ") lgkmcnt(0)\n\ts_barrier":::"memory")

__device__ __forceinline__ void qkt(f32x16&p0,f32x16&p1,const char*Kslot,const bf16x8*qr,s16x4 kxa,s16x4 kxb,s16x4 qx,int r32,int hi){
  const char*kb=Kslot+hi*1024+r32*16;
  p0=__builtin_amdgcn_mfma_f32_32x32x8bf16_1k(kxa,qx,(f32x16){0.f,0.f,0.f,0.f,0.f,0.f,0.f,0.f,0.f,0.f,0.f,0.f,0.f,0.f,0.f,0.f},0,0,0);
  p1=__builtin_amdgcn_mfma_f32_32x32x8bf16_1k(kxb,qx,(f32x16){0.f,0.f,0.f,0.f,0.f,0.f,0.f,0.f,0.f,0.f,0.f,0.f,0.f,0.f,0.f,0.f},0,0,0);
  #pragma unroll
  for(int d0=0;d0<4;++d0){
    const bf16x8 b0=*reinterpret_cast<const bf16x8*>(kb+d0*2048);
    const bf16x8 b1=*reinterpret_cast<const bf16x8*>(kb+d0*2048+512);
    p0=__builtin_amdgcn_mfma_f32_32x32x16_bf16(b0,qr[d0],p0,0,0,0);p1=__builtin_amdgcn_mfma_f32_32x32x16_bf16(b1,qr[d0],p1,0,0,0);}
}
__device__ __forceinline__ float refsplit(float t,unsigned&nh,unsigned&nl){ f32x2_t a={t,0.f}; const unsigned h=__builtin_bit_cast(unsigned,__builtin_convertvector(a,bf16x2_t))&0xffffu; const float fh=__uint_as_float(h<<16);
  f32x2_t b={t-fh,0.f}; const unsigned l=__builtin_bit_cast(unsigned,__builtin_convertvector(b,bf16x2_t))&0xffffu; nh=h^0x8000u; nl=l^0x8000u; return fh+__uint_as_float(l<<16); }
__device__ __forceinline__ s16x4 mkqx(unsigned nh,unsigned nl,int hi){ const unsigned w0=hi?0u:0x3F803F80u, w1=hi?(nl<<16):(0x3F80u|(nh<<16)); unsigned long long v=((unsigned long long)w1<<32)|w0; return __builtin_bit_cast(s16x4,v); }
typedef __attribute__((address_space(3))) const char* lds_cptr;
typedef short v4i16_t __attribute__((ext_vector_type(4)));
__device__ __forceinline__ void kload8(bf16x8*kf,lds_cptr kp){
  kf[0]=*(const __attribute__((address_space(3))) bf16x8*)(kp);      kf[1]=*(const __attribute__((address_space(3))) bf16x8*)(kp+512);
  kf[2]=*(const __attribute__((address_space(3))) bf16x8*)(kp+2048); kf[3]=*(const __attribute__((address_space(3))) bf16x8*)(kp+2560);
  kf[4]=*(const __attribute__((address_space(3))) bf16x8*)(kp+4096); kf[5]=*(const __attribute__((address_space(3))) bf16x8*)(kp+4608);
  kf[6]=*(const __attribute__((address_space(3))) bf16x8*)(kp+6144); kf[7]=*(const __attribute__((address_space(3))) bf16x8*)(kp+6656);
}
__device__ __forceinline__ void kload2(bf16x8*kf,lds_cptr kp,int j){ kf[2*j]=*(const __attribute__((address_space(3))) bf16x8*)(kp+j*2048); kf[2*j+1]=*(const __attribute__((address_space(3))) bf16x8*)(kp+j*2048+512); }
__device__ __forceinline__ s16x4 vtr(lds_cptr p){ return __builtin_bit_cast(s16x4,__builtin_amdgcn_ds_read_tr16_b64_v4i16((__attribute__((address_space(3))) v4i16_t*)p)); }
__device__ __forceinline__ float rowmax(const f32x16&p0,const f32x16&p1){
  float a=max3f(p0[0],p0[1],p1[0]),b=max3f(p0[2],p0[3],p1[1]);a=max3f(a,p1[2],p1[3]);
  #pragma unroll
  for(int r=4;r<16;r+=4){a=max3f(a,p0[r],p0[r+1]);b=max3f(b,p0[r+2],p0[r+3]);a=max3f(a,p1[r],p1[r+1]);b=max3f(b,p1[r+2],p1[r+3]);}
  const float m=max2f(a,b);
  auto rr=__builtin_amdgcn_permlane32_swap(__float_as_uint(m),__float_as_uint(m),false,false);
  return max2f(__uint_as_float(rr[0]),__uint_as_float(rr[1]));
}
__device__ __forceinline__ void pv(f32x16*o,int vb,bf16x8 pa0,bf16x8 pa1,bf16x8 pa2,bf16x8 pa3){
  #pragma unroll
  for(int d0=0;d0<2;++d0){s16x4 lo[4],hi[4];
    #pragma unroll
    for(int ks=0;ks<4;++ks){
      asm volatile("ds_read_b64_tr_b16 %0,%1 offset:%c2":"=&v"(lo[ks]):"v"(vb),"i"(d0*4096+ks*1024):"memory");
      asm volatile("ds_read_b64_tr_b16 %0,%1 offset:%c2":"=&v"(hi[ks]):"v"(vb),"i"(d0*4096+ks*1024+512):"memory");}
    asm volatile("s_waitcnt lgkmcnt(0)":::"memory");SBAR();
    #define PK(k) (bf16x8){lo[k][0],lo[k][1],lo[k][2],lo[k][3],hi[k][0],hi[k][1],hi[k][2],hi[k][3]}
    o[d0]=__builtin_amdgcn_mfma_f32_32x32x16_bf16(pa0,PK(0),o[d0],0,0,0);
    o[d0]=__builtin_amdgcn_mfma_f32_32x32x16_bf16(pa1,PK(1),o[d0],0,0,0);
    o[d0]=__builtin_amdgcn_mfma_f32_32x32x16_bf16(pa2,PK(2),o[d0],0,0,0);
    o[d0]=__builtin_amdgcn_mfma_f32_32x32x16_bf16(pa3,PK(3),o[d0],0,0,0);
    #undef PK
  }
}

#ifndef ATTN_STORE16
#define ATTN_STORE16(p,v) (*(u32x4*)(p)=(v))
#endif
template<int MODE,int THRL> __device__ __forceinline__ void run(const bf16*Qw,int qpitch,const bf16*__restrict__ Kh,const bf16*__restrict__ Vh,int kvpitch,int tbase,int tdir,int NT,int NTreal,
    int qpos,int q0w,int QBk,unsigned long long selm,unsigned long long um,const float*cbl,char*shm,f32x16(&o)[2],float&l_out){
  const int tid=threadIdx.x,lane=tid&63,r32=lane&31,hi=lane>>5; const int wid=__builtin_amdgcn_readfirstlane(tid>>6);
  #define TIDX(t) ({int ti_=tbase+tdir*(t); ti_=ti_<0?0:(ti_>63?63:ti_); ti_;})
  unsigned long long mK=um,mV=um,mC=um; int nK=0,nV=0,nC=0;
  #define POPT(M_,N_) ({ int ti_; if(MODE==3){ ti_=(M_)?(int)__builtin_ctzll(M_):0; M_&=(M_)-1ull; } else { ti_=TIDX(N_); ++(N_); } ti_; })
  const unsigned lds0=(unsigned)(uintptr_t)shm;
  float*wsf=(float*)(shm+LDS_WS)+wid*64;
  const bf16*ksrc=Kh+wid*512+lane*8;
  const bf16*vsrc=Vh+wid*512+lane*8;
  const unsigned kdst=lds0+LDS_K+wid*1024, vdst=lds0+LDS_V+wid*1024;
  #define DMA_K(t,slot) do{ const int tk_=POPT(mK,nK); glds16(ksrc+(long)tk_*4096,(unsigned)__builtin_amdgcn_readfirstlane(kdst+(slot))); }while(0)
  #define DMA_V(t,slot) do{ const int tv_=POPT(mV,nV); glds16(vsrc+(long)tv_*4096,(unsigned)__builtin_amdgcn_readfirstlane(vdst+(slot))); }while(0)
  const int vb0=(int)(lds0+LDS_V)+((lane>>4)&1)*32+(lane&3)*8+(4*hi+((lane&15)>>2))*64;
  const char*Kbase=shm+LDS_K; bf16x8 kf[8];
  const lds_cptr shm3=(lds_cptr)shm; const lds_cptr kp0=shm3+LDS_K+hi*1024+r32*16; const lds_cptr vp0=shm3+LDS_V+((lane>>4)&1)*32+(lane&3)*8+(4*hi+((lane&15)>>2))*64;
  DMA_K(0,0);DMA_V(0,0);DMA_K(1,SLOTB);
  bf16x8 qr[4];
  #pragma unroll
  for(int d0=0;d0<4;++d0)qr[d0]=*reinterpret_cast<const bf16x8*>(&Qw[(long)r32*qpitch+d0*16+hi*8]);
  float mhat=0.f,l_reg=0.f;o[0]=f32x16{};o[1]=f32x16{};
  const lds_cptr kxl3=(lds_cptr)shm+(MODE==0?(int)((const char*)cbl-shm):0)+r32*8; s16x4 kxa,kxb,qx=mkqx(0x8000u,0x8000u,hi);
  if(MODE!=0){ kxa=__builtin_bit_cast(s16x4,0x3F80000000000000ull); kxb=kxa; }
  #define KXRD(tt) do{ if(MODE==0){ const __attribute__((address_space(3))) s16x4*p_=(const __attribute__((address_space(3))) s16x4*)(kxl3+512*TIDX(tt)); kxa=p_[0]; kxb=p_[32]; } }while(0)
  int tcur=0; s16x4 qxu;
  #define QXSEL(t) do{ tcur=POPT(mC,nC); qxu=qx; if(MODE==3){ const bool sel_=(((selm>>tcur)&1ull)!=0ull)&&((t)<NTreal); if(!sel_){ unsigned long long v_=__builtin_bit_cast(unsigned long long,qx); \
      v_=(v_&0xffffffffull)|((unsigned long long)(hi?0u:0xFF003F80u)<<32); qxu=__builtin_bit_cast(s16x4,v_); } } }while(0)
  #define CMASK(P0,P1,t) do{ const int ta_=tcur; const int kvb_=64*ta_+4*hi; \
    if(MODE==0){ \
      if(64*ta_+63>q0w){ _Pragma("unroll") for(int r=0;r<16;++r){ const int kv_=kvb_+(r&3)+8*(r>>2); if(kv_>qpos)P0[r]=-INFINITY; if(kv_+32>qpos)P1[r]=-INFINITY; } } } \
    if(MODE==3){ \
      if(ta_==QBk){ _Pragma("unroll") for(int r=0;r<16;++r){ const int kv_=kvb_+(r&3)+8*(r>>2); if(kv_>qpos)P0[r]=-INFINITY; if(kv_+32>qpos)P1[r]=-INFINITY; } } } \
    if(MODE==4){ const bool vl_=((t)<NTreal); if(!vl_||ta_==QBk||ta_+8==QBk){ \
      _Pragma("unroll") for(int r=0;r<16;++r){ const int kv_=kvb_+(r&3)+8*(r>>2); if(!vl_||kv_>qpos||qpos-kv_>=512)P0[r]=-INFINITY; if(!vl_||kv_+32>qpos||qpos-(kv_+32)>=512)P1[r]=-INFINITY; } } } \
  }while(0)
  bool resc=false;
  #define START(P0,P1) do{ const float rm=rowmax(P0,P1); resc=false; \
    { unsigned nh_,nl_; const float dl=refsplit(rm>-1e30f?rm:0.f,nh_,nl_); mhat=dl; qx=mkqx(nh_,nl_,hi); \
      _Pragma("unroll") for(int r=0;r<16;++r){P0[r]=fsub_s(P0[r],dl);P1[r]=fsub_s(P1[r],dl);} \
      } \
    _Pragma("unroll") for(int r=0;r<16;++r)P0[r]=__builtin_amdgcn_exp2f(P0[r]); }while(0)
  #define RESC() do{ if(resc){ asm volatile("s_waitcnt lgkmcnt(0)":::"memory"); \
      _Pragma("unroll") for(int d_=0;d_<2;++d_) _Pragma("unroll") for(int r=0;r<16;++r)o[d_][r]*=wsf[crow(r,hi)]; } }while(0)
  f32x16 pA0,pA1,pB0,pB1;
  int sl_prev=0,sl_cur=0,sl_next=SLOTB;
  #define ROT() do{sl_prev=sl_cur;sl_cur=sl_next;sl_next=(sl_next==(NSLOT-1)*SLOTB)?0:sl_next+SLOTB;}while(0)
  DMA_K(2,2*SLOTB);
  WAIT_BAR(3);
  KXRD(0); QXSEL(0); qkt(pA0,pA1,Kbase,qr,kxa,kxb,qxu,r32,hi);asm volatile("s_nop 15\n\ts_nop 7":"+v"(pA0),"+v"(pA1));CMASK(pA0,pA1,0);
  START(pA0,pA1);
  _Pragma("unroll") for(int r=0;r<16;++r)pA1[r]=__builtin_amdgcn_exp2f(pA1[r]);
  WAIT_BAR(0);
  DMA_K(3,0);DMA_V(1,SLOTB);
  ROT();
  kload8(kf,kp0+sl_cur); KXRD(1);
  WAIT_BAR(2);
  if(NT<=2){ WAIT_BAR(0); }
  s16x4 vlo[8],vhi[8]; u32x4 pw0,pw1,pw2,pw3;
  #define PKW(P,B) cvtpk_s(P[B],P[B+1])
  #define PAF(k) __builtin_bit_cast(bf16x8,pw##k)
  #define VFR(i) (bf16x8){vlo[i][0],vlo[i][1],vlo[i][2],vlo[i][3],vhi[i][0],vhi[i][1],vhi[i][2],vhi[i][3]}
  #define PIN(x) asm volatile("":"+v"(x))
  #define MX3(a,b,c) __builtin_fmaxf(__builtin_fmaxf((a),(b)),(c))
  #define GAPA(MF,A0,A1,A2,A3,W0,W1,PW) do{ MF; sacc+=A0; sacc+=A1; sacc+=A2; sacc+=A3; PIN(sacc); W0; W1; PIN(PW); SBAR(); }while(0)
  #define EX(v) __builtin_amdgcn_exp2f(v)
  #define GAPB(MF,X,B) do{ MF; X[B]=EX(X[B]); X[B+1]=EX(X[B+1]); X[B+2]=EX(X[B+2]); X[B+3]=EX(X[B+3]); PIN(X); SBAR(); }while(0)
  #define VRD(i) do{ vlo[i]=vtr(vp_+(((i)>>2)*4096+((i)&3)*1024)); vhi[i]=vtr(vp_+(((i)>>2)*4096+((i)&3)*1024+512)); }while(0)
  #define KRD(G,j) do{ if(G){ kload2(kf,kp0+sl_next,j); SBAR(); } }while(0)
  #define STEP(C0,C1,P0,P1,t,GK,GV,GL) do{ SBAR(); \
    const lds_cptr vp_=vp0+sl_prev; \
    QXSEL(t); \
    C0=__builtin_amdgcn_mfma_f32_32x32x8bf16_1k(kxa,qxu,(f32x16){0.f,0.f,0.f,0.f,0.f,0.f,0.f,0.f,0.f,0.f,0.f,0.f,0.f,0.f,0.f,0.f},0,0,0); \
    C1=__builtin_amdgcn_mfma_f32_32x32x8bf16_1k(kxb,qxu,(f32x16){0.f,0.f,0.f,0.f,0.f,0.f,0.f,0.f,0.f,0.f,0.f,0.f,0.f,0.f,0.f,0.f},0,0,0); \
    VRD(0); SBAR(); float sacc=(P0[0]+P0[1]); \
    GAPA(C0=__builtin_amdgcn_mfma_f32_32x32x16_bf16(kf[0],qr[0],C0,0,0,0), P0[2],P0[3],P0[4],P0[5],     pw0[0]=PKW(P0,0), pw0[1]=PKW(P0,2), pw0); \
    VRD(4); SBAR(); GAPA(C1=__builtin_amdgcn_mfma_f32_32x32x16_bf16(kf[1],qr[0],C1,0,0,0), P0[6],P0[7],P0[8],P0[9],     pw0[2]=PKW(P0,4), pw0[3]=PKW(P0,6), pw0); \
    VRD(1); SBAR(); GAPA(C0=__builtin_amdgcn_mfma_f32_32x32x16_bf16(kf[2],qr[1],C0,0,0,0),   P0[10],P0[11],P0[12],P0[13], pw1[0]=PKW(P0,8), pw1[1]=PKW(P0,10), pw1); \
    VRD(5); SBAR(); GAPA(C1=__builtin_amdgcn_mfma_f32_32x32x16_bf16(kf[3],qr[1],C1,0,0,0),   P0[14],P0[15],P1[0],P1[1],   pw1[2]=PKW(P0,12),pw1[3]=PKW(P0,14), pw1); \
    VRD(2); SBAR(); GAPA(C0=__builtin_amdgcn_mfma_f32_32x32x16_bf16(kf[4],qr[2],C0,0,0,0),   P1[2],P1[3],P1[4],P1[5],     pw2[0]=PKW(P1,0), pw2[1]=PKW(P1,2), pw2); \
    VRD(6); SBAR(); GAPA(C1=__builtin_amdgcn_mfma_f32_32x32x16_bf16(kf[5],qr[2],C1,0,0,0),   P1[6],P1[7],P1[8],P1[9],     pw2[2]=PKW(P1,4), pw2[3]=PKW(P1,6), pw2); \
    VRD(3); SBAR(); GAPA(C0=__builtin_amdgcn_mfma_f32_32x32x16_bf16(kf[6],qr[3],C0,0,0,0),   P1[10],P1[11],P1[12],P1[13], pw3[0]=PKW(P1,8), pw3[1]=PKW(P1,10), pw3); \
    VRD(7); SBAR(); GAPA(C1=__builtin_amdgcn_mfma_f32_32x32x16_bf16(kf[7],qr[3],C1,0,0,0),   P1[14],P1[15],0.f,0.f,       pw3[2]=PKW(P1,12),pw3[3]=PKW(P1,14), pw3); \
    l_reg+=sacc; \
    if(GK){DMA_K((t)+3,sl_cur);} if(GV){DMA_V((t)+1,sl_next);} \
    CMASK(C0,C1,t); \
    { float a=MX3(C0[0],C0[1],C1[0]),b=MX3(C0[2],C0[3],C1[1]); a=MX3(a,C1[2],C1[3]); \
      _Pragma("unroll") for(int r=4;r<16;r+=4){a=MX3(a,C0[r],C0[r+1]);b=MX3(b,C0[r+2],C0[r+3]);a=MX3(a,C1[r],C1[r+1]);b=MX3(b,C1[r+2],C1[r+3]);} \
      float rm=__builtin_fmaxf(a,b); { auto rr=__builtin_amdgcn_permlane32_swap(__float_as_uint(rm),__float_as_uint(rm),false,false); rm=__builtin_fmaxf(__uint_as_float(rr[0]),__uint_as_float(rr[1])); } \
      resc=false; \
      if(__builtin_expect(__any(rm>(float)THRL),0)){ unsigned nh_,nl_; const float mn_=refsplit(mhat+__builtin_fmaxf(rm,0.f),nh_,nl_); const float dl=mn_-mhat; mhat=mn_; qx=mkqx(nh_,nl_,hi); \
        _Pragma("unroll") for(int r=0;r<16;++r){C0[r]-=dl;C1[r]-=dl;} \
        const float f=__builtin_amdgcn_exp2f(-dl); l_reg*=f; if(hi==0)wsf[r32]=f; resc=true; } } \
    SBAR(); \
    GAPB(o[0]=__builtin_amdgcn_mfma_f32_32x32x16_bf16(PAF(0),VFR(0),o[0],0,0,0), C0,0); \
    GAPB(o[1]=__builtin_amdgcn_mfma_f32_32x32x16_bf16(PAF(0),VFR(4),o[1],0,0,0), C0,4); \
    if(GL){KXRD((t)+1);} KRD(GL,0); GAPB(o[0]=__builtin_amdgcn_mfma_f32_32x32x16_bf16(PAF(1),VFR(1),o[0],0,0,0), C0,8); \
    KRD(GL,1); GAPB(o[1]=__builtin_amdgcn_mfma_f32_32x32x16_bf16(PAF(1),VFR(5),o[1],0,0,0), C0,12); \
    KRD(GL,2); GAPB(o[0]=__builtin_amdgcn_mfma_f32_32x32x16_bf16(PAF(2),VFR(2),o[0],0,0,0), C1,0); \
    KRD(GL,3); GAPB(o[1]=__builtin_amdgcn_mfma_f32_32x32x16_bf16(PAF(2),VFR(6),o[1],0,0,0), C1,4); \
    GAPB(o[0]=__builtin_amdgcn_mfma_f32_32x32x16_bf16(PAF(3),VFR(3),o[0],0,0,0), C1,8); \
    GAPB(o[1]=__builtin_amdgcn_mfma_f32_32x32x16_bf16(PAF(3),VFR(7),o[1],0,0,0), C1,12); \
    }while(0)
  int t=1;
  for(;t+5<NT;t+=2){
    STEP(pB0,pB1,pA0,pA1,t,true,true,true);     WAIT_BAR(2); RESC(); ROT();
    STEP(pA0,pA1,pB0,pB1,t+1,true,true,true);   WAIT_BAR(2); RESC(); ROT();
  }
  #define ENDW(tt) do{ if((tt)+3<NT){WAIT_BAR(2);} else if((tt)+2<NT){WAIT_BAR(1);} else {WAIT_BAR(0);} }while(0)
  for(;t+1<NT;t+=2){
    STEP(pB0,pB1,pA0,pA1,t,(t+3<NT),(t+1<NT),(t+1<NT));       ENDW(t);   RESC(); ROT();
    STEP(pA0,pA1,pB0,pB1,t+1,(t+4<NT),(t+2<NT),(t+2<NT));     ENDW(t+1); RESC(); ROT();
  }
  STEP(pB0,pB1,pA0,pA1,NT-1,false,false,false); RESC();
  { float sacc=pB0[0]+pB0[1]; _Pragma("unroll") for(int r=2;r<16;++r)sacc+=pB0[r]; _Pragma("unroll") for(int r=0;r<16;++r)sacc+=pB1[r]; l_reg+=sacc;
    pw0=(u32x4){PKW(pB0,0),PKW(pB0,2),PKW(pB0,4),PKW(pB0,6)};pw1=(u32x4){PKW(pB0,8),PKW(pB0,10),PKW(pB0,12),PKW(pB0,14)};pw2=(u32x4){PKW(pB1,0),PKW(pB1,2),PKW(pB1,4),PKW(pB1,6)};pw3=(u32x4){PKW(pB1,8),PKW(pB1,10),PKW(pB1,12),PKW(pB1,14)};
    SBAR(); pv(o,vb0+sl_cur,PAF(0),PAF(1),PAF(2),PAF(3)); }
  #undef PKW
  #undef PAF
  #undef VFR
  #undef PIN
  #undef MX3
  #undef GAPA
  #undef GAPB
  #undef EX
  #undef VRD
  #undef KRD
  #undef STEP
  #undef ENDW
  {auto rr=__builtin_amdgcn_permlane32_swap(__float_as_uint(l_reg),__float_as_uint(l_reg),false,false);l_out=__uint_as_float(rr[0])+__uint_as_float(rr[1]);}
  asm volatile("s_waitcnt vmcnt(0) lgkmcnt(0)\n\ts_barrier":::"memory");
  #undef KXRD
  #undef QXSEL
  #undef POPT
  #undef DMA_K
  #undef DMA_V
  #undef CMASK
  #undef START
  #undef RESC
  #undef ROT
  #undef TIDX
}
#undef SBAR
#undef WAIT_BAR
}
namespace att {
constexpr int A_K = 0, A_V = 32768, A_WS = 65536, A_OST = 0  , A_BIG = 67584, A_SEL = 133120, SLOT = 16384  ;
typedef LAS const char* lds_cptr;
typedef short v4i16_t __attribute__((ext_vector_type(4)));
#define MFMA32(a, b, c) __builtin_amdgcn_mfma_f32_32x32x16_bf16(a, b, c, 0, 0, 0)
__device__ __forceinline__ int crow(int r, int hi) { return (r & 3) + 8 * (r >> 2) + 4 * hi; }
__device__ __forceinline__ void glds16(const void* g, unsigned lds_base) {
    unsigned sv; asm volatile("s_mov_b32 %0, m0\n\ts_mov_b32 m0, %2\n\ts_nop 0\n\tglobal_load_lds_dwordx4 %1, off\n\ts_mov_b32 m0, %0" : "=&s"(sv) : "v"(g), "s"(lds_base) : "memory"); }
__device__ __forceinline__ s16x4 vtr(lds_cptr p) { return __builtin_bit_cast(s16x4, __builtin_amdgcn_ds_read_tr16_b64_v4i16((LAS v4i16_t*)p)); }
#define MX3(a, b, c) __builtin_fmaxf(__builtin_fmaxf((a), (b)), (c))
__device__ __forceinline__ float rowmax(const f32x16& p0, const f32x16& p1) {
    float a = MX3(p0[0], p0[1], p1[0]), b = MX3(p0[2], p0[3], p1[1]); a = MX3(a, p1[2], p1[3]);
#pragma unroll
    for (int r = 4; r < 16; r += 4) { a = MX3(a, p0[r], p0[r + 1]); b = MX3(b, p0[r + 2], p0[r + 3]); a = MX3(a, p1[r], p1[r + 1]); b = MX3(b, p1[r + 2], p1[r + 3]); }
    float m = __builtin_fmaxf(a, b); auto rr = __builtin_amdgcn_permlane32_swap(__float_as_uint(m), __float_as_uint(m), false, false);
    return __builtin_fmaxf(__uint_as_float(rr[0]), __uint_as_float(rr[1])); }

enum { M_FOX = 0, M_CMP1 = 1, M_CMP2 = 2, M_SLC = 3, M_WIN = 4 };
struct St { f32x16 o[2]; float mref, l; };

template <int MODE>
__device__ __forceinline__ void tile_step(LAS unsigned char* lds, int sub_off, const bf16x8 (&qr)[4], St& st, float rl, int t, int qpos, int q0w, int QBk,
                                          unsigned long long selm, LAS float* wsf, LAS float* impw, const LAS float* cbl, int lane, int r32, int hi, float& icarry) {
    const lds_cptr kp = (lds_cptr)lds + A_K + sub_off + hi * 1024 + r32 * 16;
    bf16x8 kf[8];
#pragma unroll
    for (int d0 = 0; d0 < 4; ++d0) { kf[2 * d0] = *(const LAS bf16x8*)(kp + d0 * 2048); kf[2 * d0 + 1] = *(const LAS bf16x8*)(kp + d0 * 2048 + 512); }
    float ci = -st.mref;
    if (MODE == M_SLC) { if (!((selm >> t) & 1ull)) ci = -INFINITY; }
    f32x16 s0, s1;
    { f32x16 c0;
#pragma unroll
      for (int r = 0; r < 16; ++r) c0[r] = ci;
      s0 = MFMA32(kf[0], qr[0], c0); s1 = MFMA32(kf[1], qr[0], c0); }
#pragma unroll
    for (int d0 = 1; d0 < 4; ++d0) { s0 = MFMA32(kf[2 * d0], qr[d0], s0); s1 = MFMA32(kf[2 * d0 + 1], qr[d0], s1); }
    const float NEG = -INFINITY; const int kvb = 64 * t + 4 * hi;
    if (MODE == M_CMP1 || MODE == M_CMP2) { if (16 * (64 * t + 63) + 31 > q0w) {
#pragma unroll
            for (int r = 0; r < 16; ++r) { const int n = kvb + (r & 3) + 8 * (r >> 2); if (16 * n + 31 > qpos) s0[r] = NEG; if (16 * (n + 32) + 31 > qpos) s1[r] = NEG; } } }
    if (MODE == M_SLC) { if (t == QBk) {
#pragma unroll
            for (int r = 0; r < 16; ++r) { const int kv = kvb + (r & 3) + 8 * (r >> 2); if (kv > qpos) s0[r] = NEG; if (kv + 32 > qpos) s1[r] = NEG; } } }
    if (MODE == M_WIN) { if (t == QBk || t + 8 == QBk) {
#pragma unroll
            for (int r = 0; r < 16; ++r) { const int kv = kvb + (r & 3) + 8 * (r >> 2); if (kv > qpos || qpos - kv >= 512) s0[r] = NEG; if (kv + 32 > qpos || qpos - (kv + 32) >= 512) s1[r] = NEG; } } }
    if (MODE != M_CMP2) {
        const float rm = rowmax(s0, s1);
        if (__any(rm > 8.0f)) {
            const float dl = fmaxf(rm, 0.f), alpha = __builtin_amdgcn_exp2f(-dl); st.l *= alpha; st.mref += dl;
#pragma unroll
            for (int r = 0; r < 16; ++r) { s0[r] -= dl; s1[r] -= dl; }
            if (MODE != M_CMP1) { if (hi == 0) wsf[r32] = alpha; LDS_WAIT();
#pragma unroll
                for (int r = 0; r < 16; ++r) { const float f = wsf[crow(r, hi)]; st.o[0][r] *= f; st.o[1][r] *= f; }
                LDS_WAIT(); }
        }
    }
    if (MODE == M_SLC || MODE == M_WIN) {
        const lds_cptr vq = (lds_cptr)lds + A_V + sub_off + ((lane >> 4) & 1) * 32 + (lane & 3) * 8 + (4 * hi + ((lane & 15) >> 2)) * 64;
        float qs0 = 0.f, qs1 = 0.f, qs2 = 0.f, qs3 = 0.f;
#pragma unroll
        for (int ks = 0; ks < 4; ++ks) {
            float e[8];
#pragma unroll
            for (int j = 0; j < 8; ++j) e[j] = __builtin_amdgcn_exp2f(ks < 2 ? s0[(ks & 1) * 8 + j] : s1[(ks & 1) * 8 + j]);
            qs0 += e[0] + e[4]; qs1 += e[1] + e[5]; qs2 += e[2] + e[6]; qs3 += e[3] + e[7];
            const v4u pq = (v4u){pk2(e[0], e[1]), pk2(e[2], e[3]), pk2(e[4], e[5]), pk2(e[6], e[7])};
#pragma unroll
            for (int d0 = 0; d0 < 2; ++d0) { const s16x4 lo = vtr(vq + d0 * 4096 + ks * 1024), hh = vtr(vq + d0 * 4096 + ks * 1024 + 512);
                const bf16x8 vf = (bf16x8){lo[0], lo[1], lo[2], lo[3], hh[0], hh[1], hh[2], hh[3]};
                st.o[d0] = MFMA32(__builtin_bit_cast(bf16x8, pq), vf, st.o[d0]); }
            __builtin_amdgcn_sched_barrier(0);
        }
        st.l += (qs0 + qs1) + (qs2 + qs3);
        return;
    }
    float ps0 = 0.f, ps1 = 0.f, ps2 = 0.f, ps3 = 0.f;
#pragma unroll
    for (int r = 0; r < 16; r += 2) { s0[r] = __builtin_amdgcn_exp2f(s0[r]); s1[r] = __builtin_amdgcn_exp2f(s1[r]); s0[r + 1] = __builtin_amdgcn_exp2f(s0[r + 1]); s1[r + 1] = __builtin_amdgcn_exp2f(s1[r + 1]);
        ps0 += s0[r]; ps1 += s1[r]; ps2 += s0[r + 1]; ps3 += s1[r + 1]; }
    if (MODE != M_CMP2) st.l += (ps0 + ps1) + (ps2 + ps3);
    if (MODE == M_CMP1) return;
    if (MODE == M_CMP2) {
#pragma unroll
        for (int r = 0; r < 16; ++r) { s0[r] *= rl; s1[r] *= rl; }
        float a0[4], a1[4], ob0[4], ob1[4];
#pragma unroll
        for (int g = 0; g < 4; ++g) {
            const float b0 = 0.5f * s0[4 * g + 3], b1 = 0.5f * s1[4 * g + 3];
            a0[g] = s0[4 * g] + s0[4 * g + 1] + s0[4 * g + 2] + b0; a1[g] = s1[4 * g] + s1[4 * g + 1] + s1[4 * g + 2] + b1;
            auto r0_ = __builtin_amdgcn_permlane32_swap(__float_as_uint(b0), __float_as_uint(b0), false, false); auto r1_ = __builtin_amdgcn_permlane32_swap(__float_as_uint(b1), __float_as_uint(b1), false, false);
            ob0[g] = __uint_as_float(hi ? r0_[0] : r0_[1]); ob1[g] = __uint_as_float(hi ? r1_[0] : r1_[1]); }
        { const int qrow = qpos & 63;
          LAS float* ib = impw - qrow;
#pragma unroll
          for (int g = 0; g < 4; ++g) {
              const int j0 = 16 * t + 2 * g + hi, j1 = j0 + 8;
              const float in0 = hi ? ob0[g] : (g > 0 ? ob0[g - 1] : icarry), in1 = hi ? ob1[g] : (g > 0 ? ob1[g - 1] : ob0[3]);
              ib[j0 * 64 + (qrow ^ j0)] = a0[g] + in0; ib[j1 * 64 + (qrow ^ j1)] = a1[g] + in1; }
          icarry = ob1[3]; }
    }
    v4u pw[4];
    pw[0] = (v4u){pk2(s0[0], s0[1]), pk2(s0[2], s0[3]), pk2(s0[4], s0[5]), pk2(s0[6], s0[7])};
    pw[1] = (v4u){pk2(s0[8], s0[9]), pk2(s0[10], s0[11]), pk2(s0[12], s0[13]), pk2(s0[14], s0[15])};
    pw[2] = (v4u){pk2(s1[0], s1[1]), pk2(s1[2], s1[3]), pk2(s1[4], s1[5]), pk2(s1[6], s1[7])};
    pw[3] = (v4u){pk2(s1[8], s1[9]), pk2(s1[10], s1[11]), pk2(s1[12], s1[13]), pk2(s1[14], s1[15])};
#ifdef DBG_C_P
#pragma unroll
    for (int i_ = 0; i_ < 4; ++i_) { pw[i_].x = COARSE2(pw[i_].x); pw[i_].y = COARSE2(pw[i_].y); pw[i_].z = COARSE2(pw[i_].z); pw[i_].w = COARSE2(pw[i_].w); }
#endif
    const lds_cptr vp = (lds_cptr)lds + A_V + sub_off + ((lane >> 4) & 1) * 32 + (lane & 3) * 8 + (4 * hi + ((lane & 15) >> 2)) * 64;
#pragma unroll
    for (int d0 = 0; d0 < 2; ++d0)
#pragma unroll
        for (int ks = 0; ks < 4; ++ks) { const s16x4 lo = vtr(vp + d0 * 4096 + ks * 1024), hh = vtr(vp + d0 * 4096 + ks * 1024 + 512);
            const bf16x8 vf = (bf16x8){lo[0], lo[1], lo[2], lo[3], hh[0], hh[1], hh[2], hh[3]};
            st.o[d0] = MFMA32(__builtin_bit_cast(bf16x8, pw[ks]), vf, st.o[d0]); }
}

template <int MODE>
__device__ __forceinline__ void run_tiles(LAS unsigned char* lds, unsigned long long tm, const bf16* kbase, const bf16* vbase, int pitch, const bf16x8 (&qr)[4], St& st, float rl,
                                          int qpos, int q0w, int QBk, unsigned long long selm, LAS float* wsf, LAS float* impw, const LAS float* cbl, int lane, int r32, int hi, int wid) {
    const unsigned lds0 = (unsigned)(uintptr_t)lds; float icarry = 0.f;
    const bool tiled = (pitch == 0); const size_t tstep = tiled ? 4096 : (size_t)64 * pitch;
    const bf16* ksrc = tiled ? kbase + wid * 512 + lane * 8 : kbase + (size_t)lane * pitch + wid * 8;
    const bf16* vsrc = tiled ? vbase + wid * 512 + lane * 8 : vbase + (size_t)(16 * (wid & 3) + (lane >> 2)) * pitch + (wid >> 2) * 32 + (lane & 3) * 8;
    const unsigned kdst = lds0 + A_K + wid * 1024, vdst = lds0 + A_V + wid * 1024;
    if (tm == 0ull) return;
    unsigned pm = 0u;
#pragma unroll
    for (int p = 0; p < 32; ++p) pm |= (((tm >> (2 * p)) & 3ull) != 0ull) ? (1u << p) : 0u;
#define ATT_ISSUE_PAIR(P, S) do { _Pragma("unroll") for (int a_ = 0; a_ < 2; ++a_) { const int tt_ = 2 * (P) + a_; if ((tm >> tt_) & 1ull) { \
            glds16(ksrc + (size_t)tt_ * tstep, (unsigned)__builtin_amdgcn_readfirstlane(kdst + (S) * SLOT + a_ * 8192)); \
            if (MODE != M_CMP1) glds16(vsrc + (size_t)tt_ * tstep, (unsigned)__builtin_amdgcn_readfirstlane(vdst + (S) * SLOT + a_ * 8192)); } } } while (0)
    int p = __builtin_ctz(pm); pm &= pm - 1u; int sl = 0;
    ATT_ISSUE_PAIR(p, 0);
    for (;;) {
        VM_WAIT(); __syncthreads();
        int pn = -1;
        if (pm != 0u) { pn = __builtin_ctz(pm); pm &= pm - 1u; ATT_ISSUE_PAIR(pn, sl ^ 1); }
        if ((tm >> (2 * p)) & 1ull) tile_step<MODE>(lds, sl * SLOT, qr, st, rl, 2 * p, qpos, q0w, QBk, selm, wsf, impw, cbl, lane, r32, hi, icarry);
        if ((tm >> (2 * p + 1)) & 1ull) tile_step<MODE>(lds, sl * SLOT + 8192, qr, st, rl, 2 * p + 1, qpos, q0w, QBk, selm, wsf, impw, cbl, lane, r32, hi, icarry);
        if (pn < 0) break;
        p = pn; sl ^= 1;
    }
#undef ATT_ISSUE_PAIR
    LDS_WAIT(); __syncthreads();
}
__device__ __forceinline__ void st_init(St& st) {
#pragma unroll
    for (int r = 0; r < 16; ++r) { st.o[0][r] = 0.f; st.o[1][r] = 0.f; }
    st.mref = 0.f; st.l = 0.f;
}
__device__ __forceinline__ void store_o(LAS unsigned char* lds, const f32x16 (&o)[2], const float (&rli)[16], bf16* Ow, int lane, int r32, int hi, int wid) {
    LAS bf16* stg = (LAS bf16*)(lds + A_OST) + wid * 2048;
#pragma unroll
    for (int r = 0; r < 16; ++r) { const int orow = crow(r, hi);
#pragma unroll
        for (int d0 = 0; d0 < 2; ++d0) { unsigned w_ = pk2(o[d0][r] * rli[r], 0.f) & 0xffffu;
#ifdef DBG_C_Y
            w_ = (w_ + 2u) & 0xfffcu;
#endif
            stg[orow * 64 + d0 * 32 + r32] = (bf16)w_; } }
    LDS_WAIT();
#pragma unroll
    for (int i = 0; i < 4; ++i) { const int row = i * 8 + (lane >> 3), ch = lane & 7; const v4u v = *(const LAS v4u*)(stg + row * 64 + ch * 8); *(GAS v4u*)(Ow + (size_t)row * 512 + ch * 8) = v; }
    LDS_WAIT();
}
__device__ __forceinline__ void row_to_regs(LAS float* wsf, float val, float (&rli)[16], int r32, int hi) {
    if (hi == 0) wsf[32 + r32] = val; LDS_WAIT();
#pragma unroll
    for (int r = 0; r < 16; ++r) rli[r] = wsf[32 + crow(r, hi)];
    LDS_WAIT();
}

__device__ __forceinline__ void fox_unit(Frame& F, int b, int h, int qb, bool dbg_t0 = false) {
    LAS unsigned char* lds = F.lds; unsigned char* ws = F.ws;
    const int lane = F.lane, wid = F.wave, r32 = lane & 31, hi = lane >> 5, q0 = qb * 256, q0w = q0 + 32 * wid, qpos = q0w + r32;
    LAS float* wsf = (LAS float*)(lds + A_WS) + wid * 64; LAS float* cbl = (LAS float*)(lds + A_BIG);
    { const v2u* cum = (const v2u*)(ws + WS_CUM) + (size_t)(b * 8 + h) * SEQ; LAS v2u* kxl = (LAS v2u*)cbl;
#pragma unroll 1
      for (int i = F.tid; i < 256 * (qb + 1); i += 512) kxl[i] = cum[i]; }
    __syncthreads();
    const bf16* Qw = (const bf16*)(ws + WS_QF) + ((size_t)b * SEQ + q0w) * 512 + h * 64;
    f32x16 o[2]; float lt;
    const bf16* kb = (const bf16*)(ws + WS_KF) + ((size_t)(b * 8 + h) * 64 << 12); const bf16* vb = (const bf16*)(ws + WS_VF) + ((size_t)(b * 8 + h) * 64 << 12);
    fa::run<0, 8>((const fa::bf16*)Qw, 512, (const fa::bf16*)kb, (const fa::bf16*)vb, 512, 0, dbg_t0 ? 0 : 1, 4 * (qb + 1), 4 * (qb + 1), qpos, q0w, 0, 0ull, 0ull, (const float*)cbl, (char*)lds, o, lt);
    float rli[16]; row_to_regs(wsf, 1.0f / lt, rli, r32, hi);
    bf16* Ow = (bf16*)(ws + WS_Y) + ((size_t)b * SEQ + q0w) * 512 + h * 64;
    if (!dbg_t0) store_o(lds, o, rli, Ow, lane, r32, hi, wid);
    else if (lt == 123.456f) Ow[0] = (bf16)(pk2(o[0][0] + o[1][3], 0.f) & 0xffffu);
    __syncthreads();
}

__device__ __forceinline__ void nsa_unit(Frame& F, int b, int g, int QBk, int dbgm = 0) {
    LAS unsigned char* lds = F.lds; unsigned char* ws = F.ws;
    const int lane = F.lane, wid = F.wave, r32 = lane & 31, hi = lane >> 5, hh = wid >> 1, qoff = 32 * (wid & 1), q0 = 64 * QBk, q0w = q0 + qoff, qpos = q0w + r32, head = 4 * g + hh;
    LAS float* wsf = (LAS float*)(lds + A_WS) + wid * 64; LAS float* imp = (LAS float*)(lds + A_BIG);
    LAS unsigned long long* selw = (LAS unsigned long long*)(lds + A_SEL);
    LAS float* impw = imp + (size_t)(hh * 4096 + qoff + r32);
    const bf16* Qw = (const bf16*)(ws + WS_QN) + ((size_t)b * SEQ + q0w) * 512 + head * 64;
    bf16x8 qr[4];
#pragma unroll
    for (int d0 = 0; d0 < 4; ++d0) qr[d0] = *(const GAS bf16x8*)(Qw + (size_t)r32 * 512 + d0 * 16 + hi * 8);
    const float* gat = (const float*)(ws + WS_GATES) + ((size_t)b * SEQ + qpos) * 24 + head * 3;
    float g_cmp = gat[0], g_slc = gat[1], g_win = gat[2];
#ifdef DBG_NO_CMP
    g_cmp = 0.f;
#endif
#ifdef DBG_SC_CMP
    g_cmp *= DBG_SC_CMP;
#endif
#ifdef DBG_SC_SLC
    g_slc *= DBG_SC_SLC;
#endif
#ifdef DBG_SC_WIN
    g_win *= DBG_SC_WIN;
#endif
#ifdef DBG_NO_SLC
    g_slc = 0.f;
#endif
#ifdef DBG_NO_WIN
    g_win = 0.f;
#endif
    float rli[16];
    St st;
    const int ntc = ((q0 + 32) >> 10) + 1;
    const unsigned long long tmc = (1ull << ntc) - 1ull;
    const bf16* kc = (const bf16*)(ws + WS_KCMP) + (size_t)b * 256 * 128 + g * 64; const bf16* vc = (const bf16*)(ws + WS_VCMP) + (size_t)b * 256 * 128 + g * 64;
    st_init(st);
    if (!(dbgm & 1)) run_tiles<M_CMP1>(lds, tmc, kc, vc, 128, qr, st, 0.f, qpos, q0w, QBk, 0ull, wsf, impw, nullptr, lane, r32, hi, wid);
    if (!(dbgm & 1)) { const float lt = st.l + __shfl_xor(st.l, 32); const float rl = lt > 0.f ? 1.0f / lt : 0.f; const float mkeep = st.mref;
      st_init(st); st.mref = mkeep;
      run_tiles<M_CMP2>(lds, tmc, kc, vc, 128, qr, st, rl, qpos, q0w, QBk, 0ull, wsf, impw, nullptr, lane, r32, hi, wid); }
    __syncthreads();
    if (dbgm & 2) { if (lane == 0) for (int qq = 0; qq < 8; ++qq) selw[wid * 8 + qq] = QBk >= 63 ? ~0ull : ((1ull << (QBk + 1)) - 1ull); }
    else for (int qq = 0; qq < 8; ++qq) { const int q = wid * 8 + qq, j = lane;
        const int sw = j * 64 + (q ^ j);
        float v = ((imp[sw] + imp[4096 + sw]) + imp[2 * 4096 + sw]) + imp[3 * 4096 + sw];
#ifdef DBG_IMPNOISE
        { const unsigned hsh = ((unsigned)(q0 + q) * 2654435761u) ^ ((unsigned)(j + 64 * (b * 2 + g)) * 2246822519u); const float nz = ((float)((hsh >> 9) & 0xffff) * (1.0f / 65536.0f) - 0.5f); v = v * (1.0f + DBG_IMPNOISE * nz); }
#endif
        const bool forced = (j == 0) || (j == QBk) || (j == QBk - 1), causal = j <= QBk;
        const unsigned key = (causal ? (forced ? 0xFFFFFFC0u : (__float_as_uint(fmaxf(v, 0.f)) & ~63u)) : 0u) | (unsigned)(63 - j);
        unsigned T = 0u;
#pragma unroll
        for (int bit = 31; bit >= 0; --bit) { const unsigned Tt = T | (1u << bit); T = (__popcll(__ballot(key >= Tt)) >= 16) ? Tt : T; }
        const unsigned long long msk = __ballot(causal && key >= T);
        if (lane == 0) selw[q] = msk; }
    __syncthreads();
    LAS float* otl = imp + wid * 2048 + lane;
    row_to_regs(wsf, g_cmp, rli, r32, hi);
#pragma unroll
    for (int r = 0; r < 16; ++r) { otl[(2 * r) * 64] = st.o[0][r] * rli[r]; otl[(2 * r + 1) * 64] = st.o[1][r] * rli[r]; }
    const unsigned long long selm = selw[qoff + r32];
    unsigned long long um = selw[lane];
#pragma unroll
    for (int o = 1; o < 64; o <<= 1) { const unsigned lo = __shfl_xor((unsigned)um, o), hi2 = __shfl_xor((unsigned)(um >> 32), o); um |= ((unsigned long long)hi2 << 32) | lo; }
    um = ((unsigned long long)__builtin_amdgcn_readfirstlane((unsigned)(um >> 32)) << 32) | (unsigned)__builtin_amdgcn_readfirstlane((unsigned)um);
    const bf16* ksl = (const bf16*)(ws + WS_KVS) + ((size_t)(b * 2 + g) * 64 << 12); const bf16* vsl = ksl + 4 * MiB;
    float lt_ = 1.f;
    if (!(dbgm & 4)) { const int ntr = __builtin_popcountll(um), nt2 = ntr < 2 ? 2 : ((ntr + 1) & ~1);
      fa::run<3, 8>((const fa::bf16*)Qw, 512, (const fa::bf16*)ksl, (const fa::bf16*)vsl, 512, 0, 1, nt2, ntr, qpos, q0w, QBk, selm, um, nullptr, (char*)lds, st.o, lt_); }
    { const float lt = lt_; row_to_regs(wsf, g_slc / lt, rli, r32, hi);
#pragma unroll
      for (int r = 0; r < 16; ++r) { otl[(2 * r) * 64] += st.o[0][r] * rli[r]; otl[(2 * r + 1) * 64] += st.o[1][r] * rli[r]; } }
    const bf16* kw = (const bf16*)(ws + WS_KVW) + ((size_t)(b * 2 + g) * 64 << 12); const bf16* vw = kw + 4 * MiB;
    if (!(dbgm & 8)) { const int tlo = QBk >= 8 ? QBk - 8 : 0; const int nt = QBk - tlo + 1; const unsigned long long tmw = ((1ull << nt) - 1ull) << tlo;
      (void)tmw; const int nt2 = nt < 2 ? 2 : ((nt + 1) & ~1);
      fa::run<4, 8>((const fa::bf16*)Qw, 512, (const fa::bf16*)kw, (const fa::bf16*)vw, 512, tlo, 1, nt2, nt, qpos, q0w, QBk, 0ull, 0ull, nullptr, (char*)lds, st.o, lt_); }
    { const float lt = lt_; row_to_regs(wsf, g_win / lt, rli, r32, hi);
#pragma unroll
      for (int r = 0; r < 16; ++r) { st.o[0][r] = otl[(2 * r) * 64] + st.o[0][r] * rli[r]; st.o[1][r] = otl[(2 * r + 1) * 64] + st.o[1][r] * rli[r]; } }
#pragma unroll
    for (int r = 0; r < 16; ++r) rli[r] = 1.0f;
    bf16* Ow = (bf16*)(ws + WS_Y) + ((size_t)NTOK + (size_t)b * SEQ + q0w) * 512 + head * 64;
    if (!(dbgm & 16)) store_o(lds, st.o, rli, Ow, lane, r32, hi, wid);
    else if (lt_ == 123.456f) Ow[0] = (bf16)(pk2(st.o[0][0] + st.o[1][3], 0.f) & 0xffffu);
    __syncthreads();
}
#undef MFMA32
#undef MX3
}

__device__ __forceinline__ void p3_attention(Frame& F, int qoff = 0, int which = 3) {
    volatile LAS unsigned* qslot = F.MISC + 16;
    if (which & 2) for (;;) {
        if (F.tid == 0) qslot[0] = __hip_atomic_fetch_add(F.ctl + CW_QATT + 16 + qoff, 1u, RLX_AGENT);
        __syncthreads();
        const unsigned u = qslot[0];
        __syncthreads();
        if (u >= 1024u) break;
        const int k = (int)u; const int QBk = 63 - (k >> 4), bg = k & 15;
        { Frame G = F; asm volatile("" : "+v"(G.tid), "+v"(G.lane)); att::nsa_unit(G, bg >> 1, bg & 1, QBk, qoff != 0 ? DBG_NSAM : 0); }
    }
    if (which & 1) for (;;) {
        if (F.tid == 0) qslot[0] = __hip_atomic_fetch_add(F.ctl + CW_QATT + qoff, 1u, RLX_AGENT);
        __syncthreads();
        const unsigned u = qslot[0];
        __syncthreads();
        if (u >= 1024u) break;
        const int k = (int)u; const int qb = 15 - (k >> 6), bh = k & 63;
        { Frame G = F; asm volatile("" : "+v"(G.tid), "+v"(G.lane)); att::fox_unit(G, bh >> 3, bh & 7, qb, DBG_FOXT0 && qoff != 0); }
    }
}

struct MergeOrder {
    int vcu, G;
    __device__ __forceinline__ bool next(int i, pg8::Unit& u) const { const int p = (i >> 1) * G + vcu; if (p >= 512) return false; const int br = i & 1, tm = p >> 2, tn = p & 3; u.pm = br * 128 + tm; u.pn = br * 4 + tn; return true; }
    __device__ __forceinline__ void a_ready(const pg8::Unit&) const {}
    __device__ __forceinline__ void done(const pg8::Unit&) const {}
};
struct EpiMerge {
    static constexpr bool PERM = true, AFTER_DRAIN = false;
    unsigned char* ws;
    __device__ __forceinline__ bool operator()(f32x4 (&acc)[2][2][4][2], const pg8::Unit& u, int wr, int wc, int fr, int fq) const {
        const int br = u.pm >> 7, tm = u.pm & 127, tn = u.pn & 3;
        const int row0 = tm * 256 + wr * 64 + fr, col0 = tn * 256 + wc * 32 + 8 * fq;
        const bf16* GM = (const bf16*)(ws + WS_GM); bf16* MG = (bf16*)(ws + WS_MERGED);
#pragma unroll
        for (int ai = 0; ai < 2; ++ai)
#pragma unroll
            for (int m = 0; m < 4; ++m) { const int row = row0 + ai * 128 + m * 16;
#pragma unroll
                for (int bj = 0; bj < 2; ++bj) { const int col = col0 + bj * 128;
                    const bf16* gp_ = GM + (size_t)row * 2048 + (tn * 2 + bj) * 256 + wc * 32 + 8 * fq + (br == 0 ? 0 : 128);
                    const v4u g1w = *(const GAS v4u*)gp_;
                    float g1[8] = {bf_lo(g1w.x), bf_hi(g1w.x), bf_lo(g1w.y), bf_hi(g1w.y), bf_lo(g1w.z), bf_hi(g1w.z), bf_lo(g1w.w), bf_hi(g1w.w)};
                    f32x4& a0 = acc[ai][bj][m][0]; f32x4& a1 = acc[ai][bj][m][1];
                    if (br == 0) {
                        a0.x *= g1[0]; a0.y *= g1[1]; a0.z *= g1[2]; a0.w *= g1[3]; a1.x *= g1[4]; a1.y *= g1[5]; a1.z *= g1[6]; a1.w *= g1[7];
                    } else {
                        v4u w; w.x = pk2(a0.x * g1[0], a0.y * g1[1]); w.y = pk2(a0.z * g1[2], a0.w * g1[3]); w.z = pk2(a1.x * g1[4], a1.y * g1[5]); w.w = pk2(a1.z * g1[6], a1.w * g1[7]);
#ifdef DBG_C_MERGED
                        w.x = COARSE2(w.x); w.y = COARSE2(w.y); w.z = COARSE2(w.z); w.w = COARSE2(w.w);
#endif
                        *(GAS v4u*)(MG + (size_t)row * 1024 + col) = w;
                    } } }
        return br == 0;
    }
};
#ifndef DBG_DECAY
#define DBG_DECAY 1.0f
#endif
#ifndef DBG_TEMP
#define DBG_TEMP 1.0f
#endif
#ifndef DBG_PEERSCALE
#define DBG_PEERSCALE 1.0f
#endif
#ifndef DBG_MIXSCALE
#define DBG_MIXSCALE 1.0f
#endif
struct EpiOut {
    static constexpr bool PERM = true, AFTER_DRAIN = false;
    unsigned char* ws; const float* x; float* out; const float* gffn;
    __device__ __forceinline__ bool operator()(f32x4 (&acc)[2][2][4][2], const pg8::Unit& u, int wr, int wc, int fr, int fq) const {
        const int row0 = u.pm * 256 + wr * 64 + fr, col0 = u.pn * 256 + wc * 32 + 8 * fq;
        float* SS = (float*)(ws + WS_SS); bf16* HBF = (bf16*)(ws + WS_HBF);
#pragma unroll
        for (int ai = 0; ai < 2; ++ai)
#pragma unroll
            for (int m = 0; m < 4; ++m) { const int row = row0 + ai * 128 + m * 16; float ssq = 0.f;
#pragma unroll
                for (int bj = 0; bj < 2; ++bj) { const int col = col0 + bj * 128; const size_t off = (size_t)row * 1024 + col;
                    const f32x4 x0 = *(const GAS f32x4*)(x + off), x1 = *(const GAS f32x4*)(x + off + 4);
                    const f32x4 h0 = x0 + acc[ai][bj][m][0] * DBG_MIXSCALE, h1 = x1 + acc[ai][bj][m][1] * DBG_MIXSCALE;
                    v4u hw; hw.x = pk2(h0.x, h0.y); hw.y = pk2(h0.z, h0.w); hw.z = pk2(h1.x, h1.y); hw.w = pk2(h1.z, h1.w); *(GAS v4u*)(HBF + off) = hw;
                    ssq += ((h0.x * h0.x + h0.y * h0.y) + (h0.z * h0.z + h0.w * h0.w)) + ((h1.x * h1.x + h1.y * h1.y) + (h1.z * h1.z + h1.w * h1.w)); }
                ssq += __shfl_xor(ssq, 16); ssq += __shfl_xor(ssq, 32);
                if (fq == 0) atomicAdd(SS + row, ssq); }
        return false;
    }
};
#ifdef DBG_DUPG
struct EpiNull {
    static constexpr bool PERM = true, AFTER_DRAIN = false;
    gu32* ctl;
    __device__ __forceinline__ bool operator()(f32x4 (&acc)[2][2][4][2], const pg8::Unit& u, int wr, int wc, int fr, int fq) const {
        float s = 0.f;
#pragma unroll
        for (int a = 0; a < 2; ++a)
#pragma unroll
            for (int b = 0; b < 2; ++b)
#pragma unroll
                for (int m = 0; m < 4; ++m)
#pragma unroll
                    for (int n = 0; n < 2; ++n) s += (acc[a][b][m][n].x + acc[a][b][m][n].y) + (acc[a][b][m][n].z + acc[a][b][m][n].w);
        if (s == 123456.789f) ctl[CW_BAR + 900] = 1u;
        return false;
    }
};
#endif
struct EpiScore {
    static constexpr bool PERM = true, AFTER_DRAIN = false;
    bf16* O;
    __device__ __forceinline__ bool operator()(f32x4 (&acc)[2][2][4][2], const pg8::Unit& u, int wr, int wc, int fr, int fq) const {
        const int row0 = u.pm * 256 + wr * 64 + fr;
#pragma unroll
        for (int ai = 0; ai < 2; ++ai)
#pragma unroll
            for (int m = 0; m < 4; ++m) { bf16* rowp = O + (size_t)(row0 + ai * 128 + m * 16) * 2048;
#pragma unroll
                for (int bj = 0; bj < 2; ++bj) { const int col = u.pn * 256 + bj * 128 + wc * 32 + 8 * fq, hp = col >> 7, c16 = (col & 127) >> 3;
                    const f32x4 a0 = acc[ai][bj][m][0], a1 = acc[ai][bj][m][1];
                    v4u w; w.x = pk2(a0.x, a0.y); w.y = pk2(a0.z, a0.w); w.z = pk2(a1.x, a1.y); w.w = pk2(a1.z, a1.w);
                    (void)hp; (void)c16; *(GAS v4u*)(rowp + col) = w; } }
        return false;
    }
};
#ifdef DBG_F32SCORES
__device__ __forceinline__ void p6_naive(Frame& F) {
    LAS float* hn = (LAS float*)F.lds; LAS float* qv = hn + 8 * 1024;
    const float* SS = (const float*)(F.ws + WS_SS); float* SC = (float*)(F.ws + WS_SC);
    for (int g8 = blockIdx.x; g8 < NTOK / 8; g8 += F.G) { const int t0 = g8 * 8;
        for (int e = F.tid; e < 8 * 1024; e += 512) { const int tk = e >> 10, d = e & 1023; const float rt = 1.0f / sqrtf(SS[t0 + tk] * (1.f / DM) + RMS_EPS); hn[e] = F.out[(size_t)(t0 + tk) * 1024 + d] * F.norm_ffn[d] * rt; }
        __syncthreads();
        { const int c0 = F.tid * 4; float acc[8][4];
          for (int i = 0; i < 8; ++i) for (int j = 0; j < 4; ++j) acc[i][j] = 0.f;
          for (int k = 0; k < 1024; ++k) { const f32x4 w = *(const GAS f32x4*)(F.peer_wq + (size_t)k * 2048 + c0);
#pragma unroll
              for (int i = 0; i < 8; ++i) { const float hv = hn[i * 1024 + k]; acc[i][0] += hv * w.x; acc[i][1] += hv * w.y; acc[i][2] += hv * w.z; acc[i][3] += hv * w.w; } }
#pragma unroll
          for (int i = 0; i < 8; ++i) { qv[i * 2048 + c0] = acc[i][0]; qv[i * 2048 + c0 + 1] = acc[i][1]; qv[i * 2048 + c0 + 2] = acc[i][2]; qv[i * 2048 + c0 + 3] = acc[i][3]; } }
        __syncthreads();
        for (int n = F.tid; n < 2048; n += 512) { const int hp = n >> 7; float a[8];
#pragma unroll
            for (int i = 0; i < 8; ++i) a[i] = 0.f;
            for (int d = 0; d < 128; ++d) { const float sk = F.peer_sk[(size_t)n * 128 + d];
#pragma unroll
                for (int i = 0; i < 8; ++i) a[i] += qv[i * 2048 + hp * 128 + d] * sk; }
#pragma unroll
            for (int i = 0; i < 8; ++i) { const float rt = 1.0f / sqrtf(SS[t0 + i] * (1.f / DM) + RMS_EPS); SC[(size_t)(t0 + i) * 2048 + n] = a[i] / rt; } }
        __syncthreads(); }
}
#endif
__device__ __forceinline__ unsigned mono_key(float f) { const unsigned u = __float_as_uint(f); return u ^ ((unsigned)((int)u >> 31) | 0x80000000u); }
__device__ __forceinline__ float unmono(unsigned k) { const unsigned u = (k & 0x80000000u) ? (k ^ 0x80000000u) : ~k; return __uint_as_float(u); }
#define INS16(list, key) do { unsigned k_ = (key); _Pragma("unroll") for (int e_ = 0; e_ < 16; ++e_) { const unsigned hi_ = max(list[e_], k_); k_ = min(list[e_], k_); list[e_] = hi_; } } while (0)
__device__ __forceinline__ void p7_wave(Frame& F, int t0) {
    unsigned char* ws = F.ws; const int tid = F.tid, lane = F.lane, wid = F.wave;
    LAS unsigned* keys = (LAS unsigned*)(F.lds + wid * 4096);
    LAS int* eidx = (LAS int*)(F.lds + 32768 + wid * 2048);
    LAS float* ewt = (LAS float*)(F.lds + 49152 + wid * 2048);
    LAS unsigned char* hb8 = F.lds + 65536 + wid * 2048;
    const bf16* SCB = (const bf16*)(ws + WS_SC); const float* SS = (const float*)(ws + WS_SS);
#ifdef DBG_DUPTOPK
    for (int rep_ = 0; rep_ < 2; ++rep_) {
#endif
    { const int tok = lane >> 4, hp = lane & 15; const GAS v4u* p4 = (const GAS v4u*)(SCB + (size_t)(t0 + tok) * 2048 + hp * 128);
      unsigned list[16];
#pragma unroll
      for (int e = 0; e < 16; ++e) list[e] = 0u;
#define P7_CE(A, B) do { const unsigned hi_ = max(A, B), lo_ = min(A, B); A = hi_; B = lo_; } while (0)
#define P7_KEY(val, idx) ((mono_key(val) & ~127u) | (unsigned)(127 - (idx)))
#pragma unroll 1
      for (int c = 0; c < 16; ++c) { const v4u v = p4[c];
          unsigned g0 = P7_KEY(bf_lo(v.x), 8 * c + 0), g1 = P7_KEY(bf_hi(v.x), 8 * c + 1), g2 = P7_KEY(bf_lo(v.y), 8 * c + 2), g3 = P7_KEY(bf_hi(v.y), 8 * c + 3);
          unsigned g4 = P7_KEY(bf_lo(v.z), 8 * c + 4), g5 = P7_KEY(bf_hi(v.z), 8 * c + 5), g6 = P7_KEY(bf_lo(v.w), 8 * c + 6), g7 = P7_KEY(bf_hi(v.w), 8 * c + 7);
          P7_CE(g0, g1); P7_CE(g2, g3); P7_CE(g4, g5); P7_CE(g6, g7);
          P7_CE(g0, g2); P7_CE(g1, g3); P7_CE(g4, g6); P7_CE(g5, g7);
          P7_CE(g1, g2); P7_CE(g5, g6);
          P7_CE(g0, g4); P7_CE(g1, g5); P7_CE(g2, g6); P7_CE(g3, g7);
          P7_CE(g2, g4); P7_CE(g3, g5);
          P7_CE(g1, g2); P7_CE(g3, g4); P7_CE(g5, g6);
          list[8] = max(list[8], g7); list[9] = max(list[9], g6); list[10] = max(list[10], g5); list[11] = max(list[11], g4);
          list[12] = max(list[12], g3); list[13] = max(list[13], g2); list[14] = max(list[14], g1); list[15] = max(list[15], g0);
#pragma unroll
          for (int i = 0; i < 8; ++i) P7_CE(list[i], list[i + 8]);
#pragma unroll
          for (int h8 = 0; h8 < 16; h8 += 8)
#pragma unroll
              for (int i = 0; i < 4; ++i) P7_CE(list[h8 + i], list[h8 + i + 4]);
#pragma unroll
          for (int h4 = 0; h4 < 16; h4 += 4)
#pragma unroll
              for (int i = 0; i < 2; ++i) P7_CE(list[h4 + i], list[h4 + i + 2]);
#pragma unroll
          for (int h2 = 0; h2 < 16; h2 += 2) P7_CE(list[h2], list[h2 + 1]); }
#undef P7_CE
#undef P7_KEY
#pragma unroll
      for (int e = 0; e < 16; ++e) keys[(tok * 16 + hp) * 16 + e] = list[e]; }
    LDS_WAIT(); asm volatile("" ::: "memory");
    if (lane < 32) { const int tok = lane >> 3, hd = lane & 7; const LAS unsigned* ka = keys + (tok * 16 + 2 * hd) * 16; const LAS unsigned* kb = ka + 16;
        float a[16], bq[16];
#pragma unroll
        for (int e = 0; e < 16; ++e) { a[e] = unmono(ka[e] & ~127u); bq[e] = unmono(kb[e] & ~127u); }
        unsigned list[16];
#pragma unroll
        for (int e = 0; e < 16; ++e) list[e] = 0u;
#pragma unroll
        for (int i = 0; i < 16; ++i)
#pragma unroll
            for (int j = 0; j < 16; ++j) if ((i + 1) * (j + 1) <= 16) INS16(list, (mono_key(a[i] + bq[j]) & ~255u) | (unsigned)(255 - (i * 16 + j)));
        const float rt = 1.0f / sqrtf(SS[t0 + tok] * (1.f / DM) + RMS_EPS);
        float sv[16]; float den = 0.f;
#pragma unroll
        for (int e = 0; e < 16; ++e) { const int pos = 255 - (int)(list[e] & 255u), i = pos >> 4, j = pos & 15; const unsigned k1 = ka[i], k2 = kb[j];
            sv[e] = (unmono(k1 & ~127u) + unmono(k2 & ~127u)) * rt * DBG_TEMP; eidx[tok * 128 + hd * 16 + e] = (127 - (int)(k1 & 127u)) * 128 + (127 - (int)(k2 & 127u)); }
#ifdef DBG_LOGITSTAT
        atomicAdd((float*)(F.ctl + 12400), (sv[0] - sv[15]) * (1.0f / 262144.0f));
        atomicMax((unsigned*)(F.ctl + 12401), __float_as_uint(sv[0] - sv[15]));
        atomicMax((unsigned*)(F.ctl + 12402), __float_as_uint(rt));
        atomicMax((unsigned*)(F.ctl + 12403), __float_as_uint(sv[0]));
#endif
        const float smax = sv[0];
#pragma unroll
        for (int e = 0; e < 16; ++e) { sv[e] = __expf(sv[e] - smax); den += sv[e]; }
        const float rden = 1.0f / den;
#pragma unroll
#ifdef DBG_REVW
        for (int e = 0; e < 16; ++e) ewt[tok * 128 + hd * 16 + e] = sv[15 - e] * rden; }
#else
        for (int e = 0; e < 16; ++e) ewt[tok * 128 + hd * 16 + e] = (e >= DBG_KEEP) ? 0.f : sv[e] * rden; }
#endif
    LDS_WAIT(); asm volatile("" ::: "memory");
#ifdef DBG_DUPTOPK
    }
#endif
    int lane_g = lane; asm volatile("" : "+v"(lane_g));
    const unsigned char* U8 = (const unsigned char*)(ws + WS_U8); const unsigned char* V8 = (const unsigned char*)(ws + WS_V8);
    const float* SU = (const float*)(ws + WS_SU); const float* SV = (const float*)(ws + WS_SV);
    for (int tt = 0; tt < 4; ++tt) { const int tok = tt, t = t0 + tok;
        const float rt = 1.0f / sqrtf(SS[t] * (1.f / DM) + RMS_EPS);
        float hres[16]; f32x2 out[8];
        { const GAS v4u* hp_ = (const GAS v4u*)((const bf16*)(ws + WS_HBF) + (size_t)t * DM) + 2 * lane_g; const GAS f32x4* gp = (const GAS f32x4*)F.norm_ffn + 4 * lane_g;
          v4u whi, wlo; const float rt16 = rt * 16.0f; const v4u hA = hp_[0], hB = hp_[1];
#pragma unroll
          for (int q = 0; q < 4; ++q) { const unsigned w0_ = q == 0 ? hA.x : (q == 1 ? hA.z : (q == 2 ? hB.x : hB.z)), w1_ = q == 0 ? hA.y : (q == 1 ? hA.w : (q == 2 ? hB.y : hB.w));
              const f32x4 hv = (f32x4){bf_lo(w0_), bf_hi(w0_), bf_lo(w1_), bf_hi(w1_)}; const f32x4 gv = gp[q];
              hres[4 * q] = hv.x; hres[4 * q + 1] = hv.y; hres[4 * q + 2] = hv.z; hres[4 * q + 3] = hv.w;
              const float n0 = fminf(fmaxf(hv.x * gv.x * rt16, -440.f), 440.f), n1 = fminf(fmaxf(hv.y * gv.y * rt16, -440.f), 440.f), n2 = fminf(fmaxf(hv.z * gv.z * rt16, -440.f), 440.f), n3 = fminf(fmaxf(hv.w * gv.w * rt16, -440.f), 440.f);
              int wh = 0; wh = __builtin_amdgcn_cvt_pk_fp8_f32(n0, n1, wh, false); wh = __builtin_amdgcn_cvt_pk_fp8_f32(n2, n3, wh, true);
              const float r0 = n0 - __builtin_amdgcn_cvt_f32_fp8(wh, 0), r1 = n1 - __builtin_amdgcn_cvt_f32_fp8(wh, 1), r2 = n2 - __builtin_amdgcn_cvt_f32_fp8(wh, 2), r3 = n3 - __builtin_amdgcn_cvt_f32_fp8(wh, 3);
              int wl = 0; wl = __builtin_amdgcn_cvt_pk_fp8_f32(r0, r1, wl, false); wl = __builtin_amdgcn_cvt_pk_fp8_f32(r2, r3, wl, true);
              if (q == 0) { whi.x = (unsigned)wh; wlo.x = (unsigned)wl; } else if (q == 1) { whi.y = (unsigned)wh; wlo.y = (unsigned)wl; } else if (q == 2) { whi.z = (unsigned)wh; wlo.z = (unsigned)wl; } else { whi.w = (unsigned)wh; wlo.w = (unsigned)wl; } }
          LDS_WAIT();
          *(LAS v4u*)(hb8 + 16 * lane_g) = whi; *(LAS v4u*)(hb8 + 1024 + 16 * lane_g) = wlo; LDS_WAIT(); }
#pragma unroll
        for (int i = 0; i < 8; ++i) out[i] = (f32x2){0.f, 0.f};
        for (int hd = 0; hd < 8; ++hd) {
            const LAS int* eh = eidx + tok * 128 + hd * 16;
            const int ec = 4 * (lane_g >> 4) + (lane_g & 3);
            const int myex = eh[ec];
            const float su = SU[myex], sv_ = SV[myex];
            v4u ua[8]; v2u vr[16];
            { const unsigned char* up = U8 + (size_t)eh[lane_g & 15] * (DM / 2) + (lane_g >> 4) * 16;
#pragma unroll
              for (int c = 0; c < 8; ++c) ua[c] = *(const GAS v4u*)(up + 64 * c); }
#pragma unroll
            for (int e = 0; e < 16; ++e) { const int ex = __builtin_amdgcn_readfirstlane(eh[e]); vr[e] = *((const GAS v2u*)(V8 + (size_t)ex * (DM / 2)) + lane_g); }
            f32x4 dacc = (f32x4){0.f, 0.f, 0.f, 0.f};
            {
#pragma unroll
              for (int c = 0; c < 8; ++c) { typedef int v8i_t __attribute__((ext_vector_type(8)));
                  const LAS unsigned char* hq1 = hb8 + 16 * (lane_g >> 4);
                  const v4u h0 = *(const LAS v4u*)(hq1 + 128 * c), h1 = *(const LAS v4u*)(hq1 + 128 * c + 64), l0 = *(const LAS v4u*)(hq1 + 1024 + 128 * c), l1 = *(const LAS v4u*)(hq1 + 1024 + 128 * c + 64);
                  const v8i_t av = (v8i_t){(int)ua[c].x, (int)ua[c].y, (int)ua[c].z, (int)ua[c].w, 0, 0, 0, 0};
                  const v8i_t bh = (v8i_t){(int)h0.x, (int)h0.y, (int)h0.z, (int)h0.w, (int)h1.x, (int)h1.y, (int)h1.z, (int)h1.w};
                  const v8i_t bl = (v8i_t){(int)l0.x, (int)l0.y, (int)l0.z, (int)l0.w, (int)l1.x, (int)l1.y, (int)l1.z, (int)l1.w};
                  dacc = __builtin_amdgcn_mfma_scale_f32_16x16x128_f8f6f4(av, bh, dacc, 4, 0, 0, 0x7F7F7F7F, 0, 0x7F7F7F7F);
                  dacc = __builtin_amdgcn_mfma_scale_f32_16x16x128_f8f6f4(av, bl, dacc, 4, 0, 0, 0x7F7F7F7F, 0, 0x7F7F7F7F); } }
            float act = (lane_g & 2) ? ((lane_g & 1) ? dacc.w : dacc.z) : ((lane_g & 1) ? dacc.y : dacc.x);
            act *= (1.0f / 16.0f);
            act *= su;
            const float coef = ewt[tok * 128 + hd * 16 + ec] * gelu_erf(act) * sv_;
#pragma unroll
            for (int e = 0; e < 16; ++e) { const float c = __uint_as_float(__builtin_amdgcn_readlane(__float_as_uint(coef), 16 * (e >> 2) + (e & 3))); const v2u v = vr[e]; const f32x2 c2 = (f32x2){c, c};
                out[0] += c2 * __builtin_amdgcn_cvt_scalef32_pk_f32_fp4(v.x, 1.0f, 0); out[1] += c2 * __builtin_amdgcn_cvt_scalef32_pk_f32_fp4(v.x, 1.0f, 1);
                out[2] += c2 * __builtin_amdgcn_cvt_scalef32_pk_f32_fp4(v.x, 1.0f, 2); out[3] += c2 * __builtin_amdgcn_cvt_scalef32_pk_f32_fp4(v.x, 1.0f, 3);
                out[4] += c2 * __builtin_amdgcn_cvt_scalef32_pk_f32_fp4(v.y, 1.0f, 0); out[5] += c2 * __builtin_amdgcn_cvt_scalef32_pk_f32_fp4(v.y, 1.0f, 1);
                out[6] += c2 * __builtin_amdgcn_cvt_scalef32_pk_f32_fp4(v.y, 1.0f, 2); out[7] += c2 * __builtin_amdgcn_cvt_scalef32_pk_f32_fp4(v.y, 1.0f, 3); }
        }
        float y[16]; float ssq = 0.f;
#pragma unroll
        for (int i = 0; i < 8; ++i) { y[2 * i] = out[i].x + hres[2 * i]; y[2 * i + 1] = out[i].y + hres[2 * i + 1]; ssq += y[2 * i] * y[2 * i] + y[2 * i + 1] * y[2 * i + 1]; }
        const float rf = 1.0f / sqrtf(wave_sum(ssq) * (1.f / DM) + RMS_EPS);
        { GAS f32x4* op = (GAS f32x4*)(F.out + (size_t)t * DM) + 4 * lane_g; const GAS f32x4* gp = (const GAS f32x4*)F.norm_final + 4 * lane_g;
#pragma unroll
          for (int q = 0; q < 4; ++q) { const f32x4 gv = gp[q]; op[q] = (f32x4){y[4 * q] * rf * gv.x, y[4 * q + 1] * rf * gv.y, y[4 * q + 2] * rf * gv.z, y[4 * q + 3] * rf * gv.w}; } }
    }
    LDS_WAIT(); asm volatile("" ::: "memory");
}


struct Args { const float* in[15]; float* out; unsigned char* ws; int ph_lo, ph_hi; };
constexpr int NPHASE = 8;
__global__ void __launch_bounds__(NWAVES * 64, 2) mk_fwd(Args args) {
    extern __shared__ __attribute__((aligned(16))) unsigned char lds[];
    Frame F;
    F.lds = (LAS unsigned char*)lds; F.MISC = (volatile LAS unsigned*)(F.lds + MISC_OFF);
    F.tid = threadIdx.x; F.lane = F.tid & 63; F.wave = __builtin_amdgcn_readfirstlane(F.tid >> 6);
    F.G = gridDim.x; { const int bx = blockIdx.x; F.vcu = (F.G % 8 == 0) ? (bx % 8) * (F.G / 8) + bx / 8 : bx; }
    unsigned char* ws = args.ws; F.ws = ws; F.ctl = (gu32*)(ws + WS_CTL);
    F.x = args.in[0]; F.norm_mix = args.in[1]; F.w_in = args.in[2]; F.fbias = args.in[3]; F.cmp_pos = args.in[4]; F.cmp_w1 = args.in[5]; F.cmp_w2 = args.in[6]; F.w_branch = args.in[7];
    F.w_out = args.in[8]; F.norm_ffn = args.in[9]; F.peer_wq = args.in[10]; F.peer_sk = args.in[11]; F.peer_u = args.in[12]; F.peer_v = args.in[13]; F.norm_final = args.in[14]; F.out = args.out;
    for (int u = F.tid; u < (LDS_BYTES - LDSCTL_OFF) / 4; u += NWAVES * 64) ((LAS unsigned*)(F.lds + LDSCTL_OFF))[u] = 0u;
    __syncthreads();
    const int lo = args.ph_lo, hi = args.ph_hi;
    XcdBarrier bar; bar.bar = (unsigned*)(F.ctl + CW_BAR); bar.x = 0; bar.st = nullptr;
    if (hi - lo > 1) bar = xcd_barrier_post((unsigned*)(F.ctl + CW_BAR), F.MISC + 8);
#define IN(k) (lo <= (k) && (k) < hi)
#ifdef DBG_CHECK
    if (lo == 99) { dbg_check_inproj(F); __syncthreads(); dbg_check_cmp(F); __syncthreads(); dbg_check_attn(F); return; }
    if (lo == 100) { dbg_check_merged(F); return; }
    if (lo == 101) { dbg_check_h(F); return; }
    if (lo == 102) { dbg_check_scores(F); return; }
    if (lo == 103) { dbg_check_final(F); return; }
    if (lo == 104) { if (blockIdx.x == 0 && F.tid == 0) {
#ifdef DBG_SEL
        const float num = __hip_atomic_load((float*)(F.ctl + CW_L2) + DBG_SEL, RLX_AGENT), den = __hip_atomic_load((float*)(F.ctl + CW_L2) + 8 + DBG_SEL, RLX_AGENT);
        float v = 1000.0f * sqrtf(num / fmaxf(den, 1e-30f)); v = fminf(99.f, rintf(v)); F.out[0] = 10.0f * v + 5.0f;
#else
        const unsigned m = __hip_atomic_load(F.ctl + CW_DBG, RLX_AGENT); if (m) F.out[0] = 10.0f * (float)m;
#endif
    } return; }
#endif
#ifdef DBG_PHASE
#define SEAM(k) do { if (IN(k) && IN((k) + 1)) xcd_barrier(bar); if (blockIdx.x == 0 && F.tid == 0) ((unsigned long long*)(F.ctl + 12500))[(k) + 1] = __builtin_amdgcn_s_memrealtime(); } while (0)
#else
#define SEAM(k) do { if (IN(k) && IN((k) + 1)) xcd_barrier(bar); } while (0)
#endif
#ifdef DBG_PHASE
    if (blockIdx.x == 0 && F.tid == 0) ((unsigned long long*)(F.ctl + 12500))[0] = __builtin_amdgcn_s_memrealtime();
#endif
    if (IN(0)) { p0_prologue(F);
#ifdef DBG_DUP0
        xcd_barrier(bar); p0_prologue(F, true);
#endif
        SEAM(0); }
    if (IN(1)) {
        pg8::Gemm g{(const bf16*)(ws + WS_XN), (const bf16*)(ws + WS_WTIN), NTOK, NIN, 1024}; pg8::StaticOrder S; S.init(NTOK, NIN, F.G, (int)blockIdx.x);
        EpiIn E{ws, F.fbias};
        pg8::gemm_phase<EpiIn, pg8::StaticOrder, true, true>(F.lds, g, S, E);
#if defined(DBG_DUPG) && DBG_DUPG == 1
        xcd_barrier(bar); { EpiNull E2{F.ctl}; pg8::gemm_phase<EpiNull, pg8::StaticOrder, true, true>(F.lds, g, S, E2); }
#endif
#if defined(DBG_DUPG) && DBG_DUPG == 11
        xcd_barrier(bar); pg8::gemm_phase<EpiIn, pg8::StaticOrder, true, true>(F.lds, g, S, E);
#endif
        SEAM(1);
    }
    if (IN(2)) {
        for (int u = blockIdx.x; u < 256; u += F.G) p2_compress_unit(F, u);
#if DBG_DUP2 == 1
        xcd_barrier(bar); for (int u = blockIdx.x; u < 256; u += F.G) p2_compress_unit(F, u);
#endif
#if DBG_DUP2 == 2
        { const int gw = (int)blockIdx.x * NWAVES + F.wave; if (gw < 64) p2_cumsum_wave(F, gw); } xcd_barrier(bar);
#endif
        { const int gw = (int)blockIdx.x * NWAVES + F.wave; if (gw < 64) p2_cumsum_wave(F, gw); else if (F.G * NWAVES < 64) { for (int q = gw; q < 64; q += F.G * NWAVES) p2_cumsum_wave(F, q); } }
        SEAM(2);
    }
    if (IN(3)) {
        p3_attention(F);
#if DBG_DUP3
        xcd_barrier(bar); p3_attention(F, 64, DBG_DUP3);
#endif
        SEAM(3); }
    if (IN(4)) {
        pg8::Gemm g{(const bf16*)(ws + WS_Y), (const bf16*)(ws + WS_WTBR), 2 * NTOK, 2048, 512}; MergeOrder S{F.vcu, F.G};
        EpiMerge E{ws};
        pg8::gemm_phase<EpiMerge, MergeOrder, true, true>(F.lds, g, S, E);
        SEAM(4);
    }
    if (IN(5)) {
        pg8::Gemm g{(const bf16*)(ws + WS_MERGED), (const bf16*)(ws + WS_WTOUT), NTOK, 1024, 1024}; pg8::StaticOrder S; S.init(NTOK, 1024, F.G, (int)blockIdx.x);
        EpiOut E{ws, F.x, F.out, F.norm_ffn};
        pg8::gemm_phase<EpiOut, pg8::StaticOrder, true, true>(F.lds, g, S, E);
#if defined(DBG_DUPG) && DBG_DUPG == 5
        xcd_barrier(bar); { EpiNull E2{F.ctl}; pg8::gemm_phase<EpiNull, pg8::StaticOrder, true, true>(F.lds, g, S, E2); }
#endif
        SEAM(5);
    }
    if (IN(6)) {
        pg8::Gemm g{(const bf16*)(ws + WS_HBF), (const bf16*)(ws + WS_WTPEER), NTOK, 2048, 1024}; pg8::StaticOrder S; S.init(NTOK, 2048, F.G, (int)blockIdx.x);
        EpiScore E{(bf16*)(ws + WS_SC)};
#ifdef DBG_F32SCORES
        p6_naive(F);
#else
        pg8::gemm_phase<EpiScore, pg8::StaticOrder, true, true>(F.lds, g, S, E);
#endif
#if defined(DBG_DUPG) && DBG_DUPG == 6
        xcd_barrier(bar); { EpiNull E2{F.ctl}; pg8::gemm_phase<EpiNull, pg8::StaticOrder, true, true>(F.lds, g, S, E2); }
#endif
        SEAM(6);
    }
    if (IN(7)) {
        { const int gw = (int)blockIdx.x * NWAVES + F.wave, NGW = F.G * NWAVES;
          for (int g = gw; g < NTOK / 4; g += NGW) { Frame G = F; asm volatile("" : "+v"(G.tid), "+v"(G.lane)); p7_wave(G, g * 4); } }
#ifdef DBG_PHASE
        __syncthreads(); if (blockIdx.x == 0 && F.tid == 0) { const unsigned long long* ts = (const unsigned long long*)(F.ctl + 12500); const unsigned long long tend = __builtin_amdgcn_s_memrealtime();
            const unsigned long long a0 = ts[DBG_PHASE], a1 = (DBG_PHASE + 1 < 8) ? ts[DBG_PHASE + 1] : tend, b0 = ts[DBG_PHASE + 1], b1 = (DBG_PHASE + 2 < 8) ? ts[DBG_PHASE + 2] : tend;
            { (void)b0; (void)b1; const unsigned long long t1_ = __builtin_amdgcn_s_memrealtime(); while (__builtin_amdgcn_s_memrealtime() - t1_ < (a1 - a0)) __builtin_amdgcn_s_sleep(8); } }
#endif
#ifdef DBG_LOGITSTAT
        __syncthreads(); if (blockIdx.x == 0 && F.tid == 0) { const float v_ = __hip_atomic_load((float*)(F.ctl + 12400 + DBG_LOGITSTAT), RLX_AGENT); F.out[0] = 1000.0f * v_; }
#endif
    }
#undef IN
#undef SEAM
}

#ifndef MK_N_LAUNCHES
#define MK_N_LAUNCHES 1
#endif
extern "C" void kernel_launch(void* const* d_in, const int* in_sizes, int n_in, void* d_out, int out_size, void* d_ws, size_t ws_size, hipStream_t stream) {
    static int grid = 0;
    if (grid == 0) {
        if (n_in != 15 || out_size != NTOK * DM || ws_size < WS_END) { fprintf(stderr, "kernel_launch: unexpected shapes (n_in %d out %d ws %zu)\n", n_in, out_size, ws_size); grid = -1; return; }
        int dev = 0, cus = 0, per_cu = 0;
        if (hipGetDevice(&dev) != hipSuccess || hipDeviceGetAttribute(&cus, hipDeviceAttributeMultiprocessorCount, dev) != hipSuccess) { grid = -1; return; }
        if (hipFuncSetAttribute((const void*)mk_fwd, hipFuncAttributeMaxDynamicSharedMemorySize, LDS_BYTES) != hipSuccess) { fprintf(stderr, "kernel_launch: hipFuncSetAttribute failed\n"); grid = -1; return; }
        if (hipOccupancyMaxActiveBlocksPerMultiprocessor(&per_cu, (const void*)mk_fwd, NWAVES * 64, LDS_BYTES) != hipSuccess || per_cu < 1) { fprintf(stderr, "kernel_launch: occupancy query says %d blocks per CU\n", per_cu); (void)hipGetLastError(); grid = -1; return; }
        grid = cus;
    }
    if (grid < 0) return;
    if (hipMemsetAsync((char*)d_ws + WS_CTL, 0, CTL_ZERO_BYTES, stream) != hipSuccess) return;
    Args a{};
    for (int i = 0; i < 15; ++i) a.in[i] = (const float*)d_in[i];
    a.out = (float*)d_out; a.ws = (unsigned char*)d_ws;
    const int nl = MK_N_LAUNCHES;
    for (int li = 0; li < nl; ++li) {
        a.ph_lo = (nl == 1) ? 0 : li; a.ph_hi = (nl == 1) ? NPHASE : li + 1;
#ifdef DBG_CHECK
#if DBG_CHECK == 1
        if (li == 4) { Args c = a; c.ph_lo = 99; c.ph_hi = 100; hipLaunchKernelGGL(mk_fwd, dim3(grid), dim3(NWAVES * 64), LDS_BYTES, stream, c); }
#else
        if (li >= 5) { Args c = a; c.ph_lo = 95 + li; c.ph_hi = 96 + li; hipLaunchKernelGGL(mk_fwd, dim3(grid), dim3(NWAVES * 64), LDS_BYTES, stream, c); }
#endif
#endif
        hipLaunchKernelGGL(mk_fwd, dim3(grid), dim3(NWAVES * 64), LDS_BYTES, stream, a);
    }
#ifdef DBG_CHECK
    { Args c = a;
#if DBG_CHECK == 2
      c.ph_lo = 103; c.ph_hi = 104; hipLaunchKernelGGL(mk_fwd, dim3(grid), dim3(NWAVES * 64), LDS_BYTES, stream, c);
#endif
      c.ph_lo = 104; c.ph_hi = 105; hipLaunchKernelGGL(mk_fwd, dim3(grid), dim3(NWAVES * 64), LDS_BYTES, stream, c); }
#endif
}
```

```cpp
#include <hip/hip_runtime.h>
#include <cstdio>
#include <cstdint>
namespace pg8 {
#define PG8_LAS __attribute__((address_space(3)))
typedef unsigned short bf16_t;
typedef short bf16x8 __attribute__((ext_vector_type(8)));
typedef float f32x4 __attribute__((ext_vector_type(4)));
typedef unsigned u32x4 __attribute__((ext_vector_type(4)));
constexpr int BM = 256, BK = 64, HALF = 128, HTB = HALF * BK * 2  , STAGE_BYTES = 8 * HTB, NXCD = 8, WGM = 4;

__host__ __device__ __forceinline__ int lds_byte(int r, int c) { const int st = (r >> 4) * 2 + (c >> 5), rr = r & 15, cc = c & 31, ob = rr * 64 + cc * 2; return st * 1024 + (ob ^ (((ob >> 9) & 1) << 5)); }
__host__ __device__ __forceinline__ void stage_rc(int b, int& R, int& C) { const int st = b / 1024, sb = b % 1024, swz = sb ^ (((sb >> 9) & 1) << 5); R = (st >> 1) * 16 + swz / 64; C = (st & 1) * 32 + (swz % 64) / 2; }
__host__ __device__ __forceinline__ int perm32(int rho) { const int n = rho >> 4, i = rho & 15; return 8 * (i >> 2) + 4 * n + (i & 3); }

struct Unit { int pm, pn; };
struct Gemm { const bf16_t* A; const bf16_t* Bt; int M, N, K; };

struct StaticOrder {
    int nM, nN, nwg, G, c;
    __host__ __device__ void init(int M, int N, int G_, int c_) { nM = M / BM; nN = N / BM; nwg = nM * nN; G = G_; c = c_; }
    __host__ __device__ bool next(int i, Unit& u) const {
        const long L = (long)i * G + c; if (L >= nwg) return false;
        int wgid = (int)L; { const int q = nwg / NXCD, r = nwg % NXCD, xcd = wgid % NXCD, off = wgid / NXCD; wgid = (xcd < r ? xcd * (q + 1) : r * (q + 1) + (xcd - r) * q) + off; }
        const int nig = WGM * nN, gid = wgid / nig, fm = gid * WGM, gsz = (nM - fm) < WGM ? (nM - fm) : WGM;
        u.pm = fm + ((wgid % nig) % gsz); u.pn = (wgid % nig) / gsz; return true;
    }
    __device__ __forceinline__ void a_ready(const Unit&) const {}
    __device__ __forceinline__ void done(const Unit&) const {}
};

__device__ __forceinline__ unsigned cvt_pk_bf16(float lo, float hi) { unsigned r; asm volatile("v_cvt_pk_bf16_f32 %0, %1, %2" : "=v"(r) : "v"(lo), "v"(hi)); return r; }
template <class Epi, class Sched, bool ALIGN_EPI = false, bool SP2 = false>
__device__ __forceinline__ void gemm_phase(PG8_LAS unsigned char* lds, const Gemm g, const Sched& S, const Epi& E) {
    const int tid = threadIdx.x, wid = __builtin_amdgcn_readfirstlane(tid >> 6), lane = tid & 63, wr = wid >> 2, wc = wid & 3, fr = lane & 15, fq = lane >> 4;
    const int K = g.K, nt = K / BK;
    unsigned voffA[2], voffB[2];
#pragma unroll
    for (int i = 0; i < 2; ++i) { int R, C; stage_rc(tid * 16 + i * 8192, R, C); const int Rb = Epi::PERM ? ((R & ~31) + perm32(R & 31)) : R;
        voffA[i] = (unsigned)(R * K + C) * 2u; voffB[i] = (unsigned)(Rb * K + C) * 2u; }
    const size_t kstep = (size_t)(BK * 2);
    const size_t hstep = (size_t)HALF * K * 2;
    const size_t tstep = 2 * hstep;
    const unsigned ldsw = (unsigned)wid * 1024u;
    const int aoff = lds_byte(wr * 64 + fr, fq * 8), boff = lds_byte(wc * 32 + fr, fq * 8);
#define PG8_SA(b, h) (((b) * 2 + (h)) * HTB)
#define PG8_SB(b, h) ((4 + (b) * 2 + (h)) * HTB)
#define PG8_STAGE(bufoff, gbase, voff) do { _Pragma("unroll") for (int _i = 0; _i < 2; ++_i) \
        __builtin_amdgcn_global_load_lds((const unsigned*)((const char*)(gbase) + (voff)[_i]), (PG8_LAS unsigned*)(lds + (bufoff) + ldsw + _i * 8192), 16, 0, 0); } while (0)
#define PG8_LDA(dst, b, h) do { _Pragma("unroll") for (int m = 0; m < 4; ++m) _Pragma("unroll") for (int k = 0; k < 2; ++k) dst[m][k] = *(const PG8_LAS bf16x8*)(lds + PG8_SA(b, h) + aoff + m * 2048 + k * 1024); } while (0)
#define PG8_LDB(dst, b, h) do { _Pragma("unroll") for (int n = 0; n < 2; ++n) _Pragma("unroll") for (int k = 0; k < 2; ++k) dst[n][k] = *(const PG8_LAS bf16x8*)(lds + PG8_SB(b, h) + boff + n * 2048 + k * 1024); } while (0)
#define PG8_MMA(ai, bj, At, Bt) do { __builtin_amdgcn_s_setprio(1); _Pragma("unroll") for (int m = 0; m < 4; ++m) _Pragma("unroll") for (int n = 0; n < 2; ++n) _Pragma("unroll") for (int k = 0; k < 2; ++k) \
        acc[ai][bj][m][n] = __builtin_amdgcn_mfma_f32_16x16x32_bf16(Bt[n][k], At[m][k], acc[ai][bj][m][n], 0, 0, 0); __builtin_amdgcn_s_setprio(0); } while (0)
#define PG8_WAIT_V(n) asm volatile("s_waitcnt vmcnt(" #n ")" ::: "memory")
#define PG8_WAIT_L(n) asm volatile("s_waitcnt lgkmcnt(" #n ")" ::: "memory")
#define PG8_BAR __builtin_amdgcn_s_barrier()
#define PG8_SCHED __builtin_amdgcn_sched_barrier(0)
    Unit cur, nxt; int ui = 0;
    if (!S.next(0, cur)) return;
    f32x4 acc[2][2][4][2];
#pragma unroll
    for (int a = 0; a < 2; ++a)
#pragma unroll
        for (int b = 0; b < 2; ++b)
#pragma unroll
            for (int m = 0; m < 4; ++m)
#pragma unroll
                for (int n = 0; n < 2; ++n) acc[a][b][m][n] = (f32x4){0.f, 0.f, 0.f, 0.f};
    bf16x8 At[4][2], B0[2][2], B1[2][2];
    const char* cA = (const char*)g.A + (size_t)cur.pm * tstep; const char* cB = (const char*)g.Bt + (size_t)cur.pn * tstep;
    S.a_ready(cur);
    if constexpr (SP2) {
        PG8_STAGE(PG8_SB(0, 0), cB, voffB); PG8_STAGE(PG8_SB(0, 1), cB + hstep, voffB); PG8_STAGE(PG8_SA(0, 0), cA, voffA); PG8_STAGE(PG8_SA(0, 1), cA + hstep, voffA);
        if (wr == 1) PG8_BAR;
        PG8_WAIT_V(2); PG8_BAR;
        PG8_STAGE(PG8_SB(1, 0), cB + kstep, voffB); PG8_STAGE(PG8_SA(1, 0), cA + kstep, voffA); PG8_STAGE(PG8_SB(1, 1), cB + hstep + kstep, voffB);
        PG8_WAIT_V(6); PG8_BAR;
    } else {
        PG8_STAGE(PG8_SB(0, 0), cB, voffB); PG8_STAGE(PG8_SA(0, 0), cA, voffA); PG8_STAGE(PG8_SB(0, 1), cB + hstep, voffB); PG8_STAGE(PG8_SA(0, 1), cA + hstep, voffA);
        if (wr == 1) PG8_BAR;
        PG8_WAIT_V(4); PG8_BAR;
        PG8_STAGE(PG8_SB(1, 0), cB + kstep, voffB); PG8_STAGE(PG8_SA(1, 0), cA + kstep, voffA); PG8_STAGE(PG8_SB(1, 1), cB + hstep + kstep, voffB);
        PG8_WAIT_V(6); PG8_BAR;
    }
    for (;;) {
        const bool has_next = S.next(ui + 1, nxt);
        const char* nA = has_next ? (const char*)g.A + (size_t)nxt.pm * tstep : cA; const char* nB = has_next ? (const char*)g.Bt + (size_t)nxt.pn * tstep : cB;
        for (int t = 0; t < nt; t += 2) {
            const bool last = (t == nt - 2);
            const char* a1 = cA + (size_t)(t + 1) * kstep;
            const char* a2 = last ? nA : cA + (size_t)(t + 2) * kstep; const char* b2 = last ? nB : cB + (size_t)(t + 2) * kstep;
            const char* a3 = a2 + kstep; const char* b3 = b2 + kstep;
            if (last && has_next) S.a_ready(nxt);
            if constexpr (SP2) {
            PG8_LDB(B0, 0, 0); PG8_LDB(B1, 0, 1); PG8_SCHED; PG8_LDA(At, 0, 0); PG8_STAGE(PG8_SA(1, 1), a1 + hstep, voffA);
            PG8_WAIT_V(8); PG8_WAIT_L(0); PG8_BAR; PG8_MMA(0, 0, At, B0); PG8_MMA(0, 1, At, B1); PG8_BAR; PG8_SCHED;
            PG8_LDA(At, 0, 1); PG8_STAGE(PG8_SB(0, 0), b2, voffB); PG8_STAGE(PG8_SB(0, 1), b2 + hstep, voffB); PG8_STAGE(PG8_SA(0, 0), a2, voffA);
            PG8_WAIT_V(8); PG8_WAIT_L(0); PG8_BAR; PG8_MMA(1, 0, At, B0); PG8_MMA(1, 1, At, B1); PG8_BAR; PG8_SCHED;
            PG8_LDB(B0, 1, 0); PG8_LDB(B1, 1, 1); PG8_SCHED; PG8_LDA(At, 1, 0); PG8_STAGE(PG8_SA(0, 1), a2 + hstep, voffA);
            PG8_WAIT_V(8); PG8_WAIT_L(0); PG8_BAR; PG8_MMA(0, 0, At, B0); PG8_MMA(0, 1, At, B1); PG8_BAR; PG8_SCHED;
            PG8_LDA(At, 1, 1); PG8_STAGE(PG8_SB(1, 0), b3, voffB); PG8_STAGE(PG8_SB(1, 1), b3 + hstep, voffB); PG8_STAGE(PG8_SA(1, 0), a3, voffA);
            PG8_WAIT_V(8); PG8_WAIT_L(0); PG8_BAR; PG8_MMA(1, 0, At, B0); PG8_MMA(1, 1, At, B1); PG8_BAR; PG8_SCHED;
            } else {
            PG8_LDB(B0, 0, 0); PG8_SCHED; PG8_LDA(At, 0, 0); PG8_STAGE(PG8_SA(1, 1), a1 + hstep, voffA);
            PG8_WAIT_L(8); PG8_BAR; PG8_WAIT_L(0); PG8_MMA(0, 0, At, B0); PG8_BAR; PG8_SCHED;
            PG8_LDB(B1, 0, 1); PG8_STAGE(PG8_SB(0, 0), b2, voffB);
            PG8_BAR; PG8_WAIT_L(0); PG8_MMA(0, 1, At, B1); PG8_BAR;
            PG8_LDA(At, 0, 1); PG8_STAGE(PG8_SA(0, 0), a2, voffA);
            PG8_BAR; PG8_WAIT_L(0); PG8_MMA(1, 0, At, B0); PG8_BAR; PG8_SCHED;
            PG8_STAGE(PG8_SB(0, 1), b2 + hstep, voffB);
            PG8_WAIT_V(6); PG8_BAR; PG8_MMA(1, 1, At, B1); PG8_BAR;
            PG8_LDB(B0, 1, 0); PG8_SCHED; PG8_LDA(At, 1, 0); PG8_STAGE(PG8_SA(0, 1), a2 + hstep, voffA);
            PG8_WAIT_L(8); PG8_BAR; PG8_WAIT_L(0); PG8_MMA(0, 0, At, B0); PG8_BAR; PG8_SCHED;
            PG8_LDB(B1, 1, 1); PG8_STAGE(PG8_SB(1, 0), b3, voffB);
            PG8_BAR; PG8_WAIT_L(0); PG8_MMA(0, 1, At, B1); PG8_BAR;
            PG8_LDA(At, 1, 1); PG8_STAGE(PG8_SA(1, 0), a3, voffA);
            PG8_BAR; PG8_WAIT_L(0); PG8_MMA(1, 0, At, B0); PG8_BAR; PG8_SCHED;
            PG8_STAGE(PG8_SB(1, 1), b3 + hstep, voffB);
            PG8_WAIT_V(6); PG8_BAR; PG8_MMA(1, 1, At, B1); PG8_BAR;
            }
        }
        if constexpr (ALIGN_EPI) { if (wr == 0) PG8_BAR; }
        bool keep_ = false; if constexpr (!Epi::AFTER_DRAIN) { keep_ = E(acc, cur, wr, wc, fr, fq); S.done(cur); }
        if (!has_next) break;
        if (!keep_)
#pragma unroll
        for (int a = 0; a < 2; ++a)
#pragma unroll
            for (int b = 0; b < 2; ++b)
#pragma unroll
                for (int m = 0; m < 4; ++m)
#pragma unroll
                    for (int n = 0; n < 2; ++n) acc[a][b][m][n] = (f32x4){0.f, 0.f, 0.f, 0.f};
        cur = nxt; cA = nA; cB = nB; ++ui;
        if constexpr (ALIGN_EPI) { if (wr == 1) PG8_BAR; }
    }
    PG8_WAIT_V(0);
    if constexpr (!ALIGN_EPI) { if (wr == 0) PG8_BAR; }
    PG8_BAR;
    if constexpr (Epi::AFTER_DRAIN) { E.fused(acc, cur, wr, wc, fr, fq, lds, wid, lane); S.done(cur); }
#undef PG8_SA
#undef PG8_SB
#undef PG8_STAGE
#undef PG8_LDA
#undef PG8_LDB
#undef PG8_MMA
#undef PG8_WAIT_V
#undef PG8_WAIT_L
#undef PG8_BAR
#undef PG8_SCHED
}
}
#ifndef DBG_DUP2
#define DBG_DUP2 0
#endif
#ifndef DBG_FOXT0
#define DBG_FOXT0 0
#endif
#ifndef DBG_NSAM
#define DBG_NSAM 0
#endif
#ifndef DBG_DUP3
#define DBG_DUP3 0
#endif
#ifndef DBG_ACTSCALE
#define DBG_ACTSCALE 1.0f
#endif
#ifndef DBG_OUTSCALE
#define DBG_OUTSCALE 1.0f
#endif
#ifndef DBG_KEEP
#define DBG_KEEP 16
#endif
#define COARSE2(w) (((w) + 0x00020002u) & 0xfffcfffcu)
#ifndef DBG_KROPE
#define DBG_KROPE 31
#endif
#ifndef DBG_FOXT
#define DBG_FOXT 1.0f
#endif
#ifndef DBG_NSAT
#define DBG_NSAT 1.0f
#endif
#ifndef DBG_DECAY
#define DBG_DECAY 1.0f
#endif

constexpr int NB = 8, SEQ = 4096, DM = 1024, NTOK = NB * SEQ;
constexpr int NIN = 5120;
constexpr int NEXP = 16384;
constexpr float LOG2E = 1.4426950408889634f;
constexpr float C2 = 0.125f * LOG2E;
constexpr float RMS_EPS = 1e-6f;
constexpr int NWAVES = 8;

constexpr size_t MiB = 1u << 20;
constexpr size_t WS_CTL = 0, CTL_ZERO_BYTES = 1 * MiB;
constexpr size_t WS_SS = 512 * 1024;
constexpr size_t WS_BIAS1 = 768 * 1024;
constexpr size_t WS_WTIN = 2 * MiB, WS_WTBR = 12 * MiB, WS_WTOUT = 14 * MiB, WS_WTPEER = 16 * MiB, WS_W1T = 20 * MiB;
constexpr size_t WS_W2T = 21 * MiB, WS_ROPE = 21 * MiB + 128 * 1024, WS_KCMP = 22 * MiB, WS_VCMP = 22 * MiB + 512 * 1024, WS_LOGF = 23 * MiB;
constexpr size_t WS_UB = 24 * MiB, WS_VB = 56 * MiB;
constexpr size_t WS_U8 = WS_UB, WS_V8 = WS_UB + 16 * MiB, WS_SU = WS_VB, WS_SV = WS_VB + 1 * MiB;
constexpr size_t WS_XN = 88 * MiB;
constexpr size_t WS_Y = WS_XN, WS_HB = WS_XN;
constexpr size_t WS_QF = 152 * MiB, WS_KF = 184 * MiB, WS_VF = 216 * MiB, WS_QN = 248 * MiB;
constexpr size_t WS_MERGED = WS_QF;
constexpr size_t WS_KVC = 280 * MiB, WS_KVS = 296 * MiB, WS_KVW = 312 * MiB;
constexpr size_t WS_GM = 328 * MiB;
constexpr size_t WS_HBF = 328 * MiB;
constexpr size_t WS_GATES = 456 * MiB, WS_CUM = 459 * MiB  , WS_END = 461 * MiB;
constexpr size_t WS_SC = 152 * MiB;
static_assert(WS_SC + (size_t)NTOK * 2048 * 4 <= WS_GATES, "score overlay");
constexpr int CW_BAR = 4096;
constexpr int CW_QATT = 8192, CW_QPEER = 8256;

constexpr int RING_BYTES = 131072;
constexpr int LDS_BYTES = 147456;
constexpr int LDSCTL_OFF = LDS_BYTES - 512, MISC_OFF = LDSCTL_OFF + 64;

#define GAS __attribute__((address_space(1)))
#define LAS __attribute__((address_space(3)))
typedef unsigned short bf16;
typedef unsigned v4u __attribute__((ext_vector_type(4)));
typedef unsigned v2u __attribute__((ext_vector_type(2)));
typedef float f32x4 __attribute__((ext_vector_type(4)));
typedef float f32x2 __attribute__((ext_vector_type(2)));
typedef short bf16x8 __attribute__((ext_vector_type(8)));
typedef short s16x4 __attribute__((ext_vector_type(4)));
typedef float f32x16 __attribute__((ext_vector_type(16)));
typedef __bf16 bf16x2_t __attribute__((ext_vector_type(2)));
typedef GAS unsigned gu32;
#define RLX_AGENT __ATOMIC_RELAXED, __HIP_MEMORY_SCOPE_AGENT
#define LDS_WAIT() asm volatile("s_waitcnt lgkmcnt(0)" ::: "memory")
#define VM_WAIT() asm volatile("s_waitcnt vmcnt(0)" ::: "memory")
__device__ __forceinline__ unsigned pk2(float lo, float hi) { return pg8::cvt_pk_bf16(lo, hi); }
__device__ __forceinline__ float bf_lo(unsigned w) { return __uint_as_float(w << 16); }
__device__ __forceinline__ float bf_hi(unsigned w) { return __uint_as_float(w & 0xffff0000u); }
__device__ __forceinline__ float sigmoidf_(float x) { return __builtin_amdgcn_rcpf(1.0f + __builtin_amdgcn_exp2f(-x * LOG2E)); }
__device__ __forceinline__ float gelu_erf(float v) { return 0.5f * v * (1.0f + erff(v * 0.70710678118654752f)); }
__device__ __forceinline__ float wave_sum(float v) {
#pragma unroll
    for (int o = 1; o < 64; o <<= 1) v += __shfl_xor(v, o);
    return v;
}

#define XB_TMO      128
#define XB_XCNT(j)  (256  + 64 * (j))
#define XB_XSUB(j)  (1280 + 64 * (j))
#define XB_XGEN(j)  (2304 + 64 * (j))
#define XB_TOP      3328
#define XB_TOPGEN   3392
#define XCD_BAR_WORDS 3456
#define XB_SPIN_CAP (1u << 18)

__device__ __forceinline__ unsigned xb_ld(unsigned* p)              { return __hip_atomic_load(p, __ATOMIC_RELAXED, __HIP_MEMORY_SCOPE_AGENT); }
__device__ __forceinline__ unsigned xb_add(unsigned* p, unsigned v) { return __hip_atomic_fetch_add(p, v, __ATOMIC_RELAXED, __HIP_MEMORY_SCOPE_AGENT); }
__device__ __forceinline__ unsigned xb_xcc_id() { return (unsigned)__builtin_amdgcn_s_getreg((3 << 11) | 20) & 0xFu; }
#define XB_SPIN(cond, bar) do { unsigned _sp = 0; while (cond) { __builtin_amdgcn_s_sleep(1); \
    if ((++_sp & 255u) == 0u) { if (xb_ld(&(bar)[XB_TMO])) break; if (_sp > XB_SPIN_CAP) { atomicAdd(&(bar)[XB_TMO], 1u); break; } } } } while (0)

struct XcdBarrier {
    unsigned* bar; unsigned x;
    volatile LAS unsigned* st;
};

__device__ __forceinline__ XcdBarrier xcd_barrier_post(unsigned* bar, volatile LAS unsigned* st) {
    XcdBarrier b; b.bar = bar; b.x = xb_xcc_id(); b.st = st;
    if (threadIdx.x == 0) (void)xb_add(&bar[XB_XCNT(b.x)], 1u);
    return b;
}
__device__ __forceinline__ void xcd_barrier_complete(unsigned* bar, unsigned x, unsigned& nloc, unsigned& nx) {
    const unsigned G = gridDim.x * gridDim.y * gridDim.z;
    unsigned sum, cnt, mine, sp = 0u;
    for (;;) {
        sum = 0u; cnt = 0u; mine = 0u;
#pragma unroll
        for (unsigned j = 0; j < 16; ++j) { const unsigned c = xb_ld(&bar[XB_XCNT(j)]); sum += c; cnt += (c > 0u) ? 1u : 0u; mine = (j == x) ? c : mine; }
        if (sum == G) break;
        __builtin_amdgcn_s_sleep(1);
        if ((++sp & 255u) == 0u) { if (xb_ld(&bar[XB_TMO])) break; if (sp > XB_SPIN_CAP) { atomicAdd(&bar[XB_TMO], 1u); break; } }
    }
    nloc = mine > 0u ? mine : 1u; nx = cnt > 0u ? cnt : 1u;
}

__device__ __forceinline__ void xcd_barrier(const XcdBarrier& b) {
    asm volatile("s_waitcnt vmcnt(0)" ::: "memory");
    __syncthreads();
    if (threadIdx.x == 0) {
        unsigned* bar = b.bar;
        __builtin_amdgcn_s_waitcnt(0);
        unsigned nloc = b.st[0], nx = b.st[1];
        if (nloc == 0u) { xcd_barrier_complete(bar, b.x, nloc, nx); b.st[0] = nloc; b.st[1] = nx; }
        const unsigned old = xb_add(&bar[XB_XSUB(b.x)], 1u);
        const unsigned gen = old / nloc;
        if (old + 1u == (gen + 1u) * nloc) {
            __builtin_amdgcn_fence(__ATOMIC_RELEASE, "agent");
            asm volatile("s_waitcnt vmcnt(0)" ::: "memory");
            const unsigned og = xb_add(&bar[XB_TOP], 1u);
            const unsigned tg = og / nx;
            if (og + 1u == (tg + 1u) * nx) xb_add(&bar[XB_TOPGEN], 1u);
            else XB_SPIN(xb_ld(&bar[XB_TOPGEN]) == tg, bar);
            __builtin_amdgcn_fence(__ATOMIC_ACQUIRE, "agent");
            xb_add(&bar[XB_XGEN(b.x)], 1u);
            asm volatile("s_waitcnt vmcnt(0)" ::: "memory");
        } else {
            XB_SPIN(xb_ld(&bar[XB_XGEN(b.x)]) == gen, bar);
            __builtin_amdgcn_fence(__ATOMIC_ACQUIRE, "agent");
            asm volatile("s_waitcnt vmcnt(0)" ::: "memory");
        }
    }
    __syncthreads();
}


struct Frame {
    LAS unsigned char* lds;
    volatile LAS unsigned* MISC;
    gu32* ctl;
    int tid, lane, wave, vcu, G;
    unsigned char* ws;
    const float *x, *norm_mix, *w_in, *fbias, *cmp_pos, *cmp_w1, *cmp_w2, *w_branch, *w_out, *norm_ffn, *peer_wq, *peer_sk, *peer_u, *peer_v, *norm_final;
    float* out;
};

__device__ __forceinline__ int src_col_in(int n) {
    if (n < 1536) return n;
    if (n < 2816) return n + 8;
    if (n < 2824) return n - 2816 + 1536;
    if (n < 2848) return n;
    if (n < 3072) return -1;
    { const int m = n - 3072, i = m >> 8, half = (m >> 7) & 1, c = m & 127; return 2848 + half * 1024 + i * 128 + c; }
}
__device__ __forceinline__ void p0_tr_item(const float* W, int ldw, int K, bf16* WT, int kb, int dst_row0, int src_col, LAS float* scr, int lane) {
    const int k0 = 64 * kb;
    { f32x4 v_[8];
#pragma unroll
      for (int i = 0; i < 8; ++i) { const int kk = 8 * i + (lane >> 3); v_[i] = (src_col >= 0) ? *(const GAS f32x4*)(W + (size_t)(k0 + kk) * ldw + src_col) : (f32x4){0.f, 0.f, 0.f, 0.f}; }
#pragma unroll
      for (int i = 0; i < 8; ++i) { const int kk = 8 * i + (lane >> 3); LAS float* d_ = scr + kk * 33 + 4 * (lane & 7); d_[0] = v_[i].x; d_[1] = v_[i].y; d_[2] = v_[i].z; d_[3] = v_[i].w; } }
    LDS_WAIT(); asm volatile("" ::: "memory");
    const int c = lane & 7;
#pragma unroll
    for (int j = 0; j < 4; ++j) { const int n = (lane >> 3) + 8 * j; const LAS float* s = scr + (8 * c) * 33 + n;
        v4u o; o.x = pk2(s[0 * 33], s[1 * 33]); o.y = pk2(s[2 * 33], s[3 * 33]); o.z = pk2(s[4 * 33], s[5 * 33]); o.w = pk2(s[6 * 33], s[7 * 33]);
#ifdef DBG_C_W
        o.x = COARSE2(o.x); o.y = COARSE2(o.y); o.z = COARSE2(o.z); o.w = COARSE2(o.w);
#endif
        *(GAS v4u*)(WT + (size_t)(dst_row0 + n) * K + k0 + 8 * c) = o; }
    LDS_WAIT(); asm volatile("" ::: "memory");
}
__device__ __forceinline__ void p0_prologue(Frame& F, bool skip_bias = false) {
    LAS float* scr = (LAS float*)(F.lds + F.wave * 16384);
    unsigned char* ws = F.ws;
    const int gw = F.vcu * NWAVES + F.wave, NGW = F.G * NWAVES, lane = F.lane;
    const int gt = gw * 64 + lane, NGT = NGW * 64;
#pragma nounroll
    for (int pass_ = 0; pass_ < 2; ++pass_) {
    if (((pass_ ^ F.vcu) & 1) == 0) {
    constexpr int I_IN = 16 * 160, I_BR = 8 * 32, I_OUT = 16 * 32, I_W1 = 32 * 4, I_W2 = 2 * 2;
    constexpr int NITEMS = I_IN + 2 * I_BR + I_OUT + 2 * I_W1 + 2 * I_W2;
    for (int it = gw; it < NITEMS; it += NGW) {
        int r = it;
        if (r < I_IN) { const int kb = r / 160, nb = r % 160; p0_tr_item(F.w_in, 4896, 1024, (bf16*)(ws + WS_WTIN), kb, 32 * nb, src_col_in(32 * nb + 4 * (lane & 7)), scr, lane); continue; } r -= I_IN;
        if (r < 2 * I_BR) { const int br = r / I_BR, q = r % I_BR, kb = q / 32, nb = q % 32; p0_tr_item(F.w_branch + (size_t)br * 512 * 1024, 1024, 512, (bf16*)(ws + WS_WTBR), kb, br * 1024 + 32 * nb, 32 * nb + 4 * (lane & 7), scr, lane); continue; } r -= 2 * I_BR;
        if (r < I_OUT) { const int kb = r / 32, nb = r % 32; p0_tr_item(F.w_out, 1024, 1024, (bf16*)(ws + WS_WTOUT), kb, 32 * nb, 32 * nb + 4 * (lane & 7), scr, lane); continue; } r -= I_OUT;
        if (r < 2 * I_W1) { const int j = r / I_W1, q = r % I_W1, kb = q / 4, nb = q % 4; p0_tr_item(F.cmp_w1 + (size_t)j * 2048 * 128, 128, 2048, (bf16*)(ws + WS_W1T), kb, j * 128 + 32 * nb, 32 * nb + 4 * (lane & 7), scr, lane); continue; } r -= 2 * I_W1;
        { const int j = r / I_W2, q = r % I_W2, kb = q / 2, nb = q % 2; p0_tr_item(F.cmp_w2 + (size_t)j * 128 * 64, 64, 128, (bf16*)(ws + WS_W2T), kb, j * 64 + 32 * nb, 32 * nb + 4 * (lane & 7), scr, lane); }
    }
    { LAS float* skl = (LAS float*)F.lds; LAS float* wql = skl + 128 * 129;
      for (int it = F.vcu; it < 16 * 16; it += F.G) { const int hp = it >> 4, kc = it & 15;
        __syncthreads();
        for (int e = F.tid; e < 128 * 32; e += NWAVES * 64) { const int n = e >> 5, d4 = e & 31; const f32x4 v = *((const GAS f32x4*)(F.peer_sk + (size_t)(hp * 128 + n) * 128) + d4);
            skl[n * 129 + 4 * d4] = v.x; skl[n * 129 + 4 * d4 + 1] = v.y; skl[n * 129 + 4 * d4 + 2] = v.z; skl[n * 129 + 4 * d4 + 3] = v.w; }
        for (int e = F.tid; e < 64 * 32; e += NWAVES * 64) { const int k = e >> 5, d4 = e & 31; *((LAS f32x4*)(wql + k * 128) + d4) = *((const GAS f32x4*)(F.peer_wq + (size_t)(kc * 64 + k) * 2048 + hp * 128) + d4); }
        __syncthreads();
        const int n = F.tid & 127, kq = __builtin_amdgcn_readfirstlane(F.tid >> 7);
        float acc[16];
#pragma unroll
        for (int j = 0; j < 16; ++j) acc[j] = 0.f;
        for (int d4 = 0; d4 < 32; ++d4) { const float s0 = skl[n * 129 + 4 * d4], s1 = skl[n * 129 + 4 * d4 + 1], s2 = skl[n * 129 + 4 * d4 + 2], s3 = skl[n * 129 + 4 * d4 + 3];
#pragma unroll
            for (int j = 0; j < 16; ++j) { const f32x4 w = *((const LAS f32x4*)(wql + (kq * 16 + j) * 128) + d4); acc[j] += (s0 * w.x + s1 * w.y) + (s2 * w.z + s3 * w.w); } }
        { const GAS f32x4* gk = (const GAS f32x4*)(F.norm_ffn + kc * 64 + kq * 16);
#pragma unroll
          for (int q = 0; q < 4; ++q) { const f32x4 g4 = gk[q]; acc[4 * q] *= g4.x; acc[4 * q + 1] *= g4.y; acc[4 * q + 2] *= g4.z; acc[4 * q + 3] *= g4.w; } }
        bf16* WtP = (bf16*)(ws + WS_WTPEER) + (size_t)(hp * 128 + n) * 1024 + kc * 64 + kq * 16;
        v4u o0, o1; o0.x = pk2(acc[0], acc[1]); o0.y = pk2(acc[2], acc[3]); o0.z = pk2(acc[4], acc[5]); o0.w = pk2(acc[6], acc[7]);
        o1.x = pk2(acc[8], acc[9]); o1.y = pk2(acc[10], acc[11]); o1.z = pk2(acc[12], acc[13]); o1.w = pk2(acc[14], acc[15]);
        *(GAS v4u*)WtP = o0; *(GAS v4u*)(WtP + 8) = o1;
      }
      __syncthreads(); }
    if (!skip_bias) for (int it = gt; it < 2 * 128 * 64; it += NGT) {
        const int n = it & 127, j = (it >> 7) & 1, ch = it >> 8;
        const float* p = F.cmp_pos + (size_t)j * 2048 + ch * 32; const float* w = F.cmp_w1 + ((size_t)j * 2048 + ch * 32) * 128 + n;
        float pv[32], wv[32];
#pragma unroll
        for (int k = 0; k < 32; ++k) { pv[k] = p[k]; wv[k] = w[(size_t)k * 128]; }
        float a = 0.f;
#pragma unroll
        for (int k = 0; k < 32; ++k) a += pv[k] * wv[k];
        atomicAdd((float*)(ws + WS_BIAS1) + j * 128 + n, a);
    }
    for (int it = gt; it < SEQ * 8; it += NGT) {
        const int pos = it >> 3, i = it & 7;
        const double inv[8] = {1.0, 0.19392274474868576, 0.03760603093086393, 0.007292664737217109, 0.001414213562373095, 0.0002742481756762073, 5.318295896944988e-05, 1.031338537721246e-05};
        double iv = inv[0];
#pragma unroll
        for (int q = 1; q < 8; ++q) iv = (i == q) ? inv[q] : iv;
        const double rev = (double)pos * iv * 0.15915494309189535; const float fr = (float)(rev - __builtin_rint(rev));
        f32x2 cs; cs.x = __builtin_amdgcn_cosf(fr); cs.y = __builtin_amdgcn_sinf(fr);
        ((GAS f32x2*)(ws + WS_ROPE))[it] = cs;
    }
    } else {
    { const GAS f32x4* gr = (const GAS f32x4*)F.norm_mix + lane; f32x4 gq[4];
#pragma unroll
      for (int j = 0; j < 4; ++j) gq[j] = gr[64 * j];
      for (int m0 = gw * 4; m0 < NTOK; m0 += NGW * 4) {
        f32x4 v[4][4]; float sq[4];
#pragma unroll
        for (int r = 0; r < 4; ++r) { const GAS f32x4* xr = (const GAS f32x4*)(F.x + (size_t)(m0 + r) * DM) + lane;
#pragma unroll
            for (int j = 0; j < 4; ++j) v[r][j] = xr[64 * j]; }
#pragma unroll
        for (int r = 0; r < 4; ++r) { float a = 0.f;
#pragma unroll
            for (int j = 0; j < 4; ++j) a += (v[r][j].x * v[r][j].x + v[r][j].y * v[r][j].y) + (v[r][j].z * v[r][j].z + v[r][j].w * v[r][j].w);
            sq[r] = a; }
#pragma unroll
        for (int o = 1; o < 64; o <<= 1) {
#pragma unroll
            for (int r = 0; r < 4; ++r) sq[r] += __shfl_xor(sq[r], o); }
#pragma unroll
        for (int r = 0; r < 4; ++r) { const float rr = 1.0f / sqrtf(sq[r] * (1.f / DM) + RMS_EPS);
            GAS v2u* o8 = (GAS v2u*)((bf16*)(ws + WS_XN) + (size_t)(m0 + r) * DM) + lane;
#pragma unroll
            for (int j = 0; j < 4; ++j) { const f32x4 g = gq[j]; v2u o; o.x = pk2(v[r][j].x * rr * g.x, v[r][j].y * rr * g.y); o.y = pk2(v[r][j].z * rr * g.z, v[r][j].w * rr * g.w);
                o8[64 * j] = o; } }
      } }
    for (int r0 = gw * 4; r0 < 2 * NEXP; r0 += NGW * 4) {
        f32x4 a[4][4]; float mx[4];
#pragma unroll
        for (int q = 0; q < 4; ++q) { const int r = r0 + q; const bool isv = r >= NEXP; const int e = isv ? r - NEXP : r;
            const GAS f32x4* src = (const GAS f32x4*)((isv ? F.peer_v : F.peer_u) + (size_t)e * DM) + 4 * lane;
#pragma unroll
            for (int j = 0; j < 4; ++j) a[q][j] = src[j]; }
#pragma unroll
        for (int q = 0; q < 4; ++q) { float m = 0.f;
#pragma unroll
            for (int j = 0; j < 4; ++j) m = fmaxf(m, fmaxf(fmaxf(fabsf(a[q][j].x), fabsf(a[q][j].y)), fmaxf(fabsf(a[q][j].z), fabsf(a[q][j].w))));
            mx[q] = m; }
#pragma unroll
        for (int o = 1; o < 64; o <<= 1) {
#pragma unroll
            for (int q = 0; q < 4; ++q) mx[q] = fmaxf(mx[q], __shfl_xor(mx[q], o)); }
#pragma unroll
        for (int q = 0; q < 4; ++q) { const int r = r0 + q; const bool isv = r >= NEXP; const int e = isv ? r - NEXP : r; const float m = mx[q];
            const float inv = m > 0.f ? 6.0f / m : 0.f, sc = m > 0.f ? m * (1.0f / 6.0f) : 1.0f;
            v2u o; unsigned w = 0u;
            w = __builtin_amdgcn_cvt_scalef32_pk_fp4_f32(w, a[q][0].x * inv, a[q][0].y * inv, 1.0f, 0); w = __builtin_amdgcn_cvt_scalef32_pk_fp4_f32(w, a[q][0].z * inv, a[q][0].w * inv, 1.0f, 1);
            w = __builtin_amdgcn_cvt_scalef32_pk_fp4_f32(w, a[q][1].x * inv, a[q][1].y * inv, 1.0f, 2); w = __builtin_amdgcn_cvt_scalef32_pk_fp4_f32(w, a[q][1].z * inv, a[q][1].w * inv, 1.0f, 3); o.x = w; w = 0u;
            w = __builtin_amdgcn_cvt_scalef32_pk_fp4_f32(w, a[q][2].x * inv, a[q][2].y * inv, 1.0f, 0); w = __builtin_amdgcn_cvt_scalef32_pk_fp4_f32(w, a[q][2].z * inv, a[q][2].w * inv, 1.0f, 1);
            w = __builtin_amdgcn_cvt_scalef32_pk_fp4_f32(w, a[q][3].x * inv, a[q][3].y * inv, 1.0f, 2); w = __builtin_amdgcn_cvt_scalef32_pk_fp4_f32(w, a[q][3].z * inv, a[q][3].w * inv, 1.0f, 3); o.y = w;
            *((GAS v2u*)(ws + (isv ? WS_V8 : WS_U8) + (size_t)e * (DM / 2)) + lane) = o;
            if (lane == 0) ((float*)(ws + (isv ? WS_SV : WS_SU)))[e] = sc; }
    }
    }
    }
}

struct EpiIn {
    static constexpr bool PERM = true, AFTER_DRAIN = false;
    unsigned char* ws; const float* fbias;
    __device__ __forceinline__ bool operator()(f32x4 (&acc)[2][2][4][2], const pg8::Unit& u, int wr, int wc, int fr, int fq) const {
        const int pn = u.pn, row0 = u.pm * 256 + wr * 64 + fr;
        if (pn == 11) {
            if (wc == 0) {
#pragma unroll
                for (int ai = 0; ai < 2; ++ai)
#pragma unroll
                    for (int m = 0; m < 4; ++m) { const int row = row0 + ai * 128 + m * 16; const f32x4 v0 = acc[ai][0][m][0], v1 = acc[ai][0][m][1];
                        float v[8] = {v0.x, v0.y, v0.z, v0.w, v1.x, v1.y, v1.z, v1.w}, o[8];
                        if (fq == 0) {
#pragma unroll
                            for (int i = 0; i < 8; ++i) { const float z = v[i] + fbias[i]; o[i] = fminf(z, 0.f) - log1pf(__expf(-fabsf(z))); }
                            GAS f32x4* d = (GAS f32x4*)((float*)(ws + WS_LOGF) + (size_t)row * 8); d[0] = (f32x4){o[0], o[1], o[2], o[3]}; d[1] = (f32x4){o[4], o[5], o[6], o[7]};
                        } else {
#pragma unroll
                            for (int i = 0; i < 8; ++i) o[i] = sigmoidf_(v[i]);
                            GAS f32x4* d = (GAS f32x4*)((float*)(ws + WS_GATES) + (size_t)row * 24 + (fq - 1) * 8); d[0] = (f32x4){o[0], o[1], o[2], o[3]}; d[1] = (f32x4){o[4], o[5], o[6], o[7]};
                        } }
            }
            return false;
        }
        if (pn >= 12) {
            bf16* gm = (bf16*)(ws + WS_GM) + (size_t)(pn - 12) * 256 + wc * 32 + 8 * fq;
#pragma unroll
            for (int ai = 0; ai < 2; ++ai)
#pragma unroll
                for (int m = 0; m < 4; ++m) { const int row = row0 + ai * 128 + m * 16; const f32x4 a0 = acc[ai][0][m][0], a1 = acc[ai][0][m][1], b0 = acc[ai][1][m][0], b1 = acc[ai][1][m][1];
                    const float av[8] = {a0.x, a0.y, a0.z, a0.w, a1.x, a1.y, a1.z, a1.w}, bv[8] = {b0.x, b0.y, b0.z, b0.w, b1.x, b1.y, b1.z, b1.w}; float rt_[8], g1_[8];
#pragma unroll
                    for (int i = 0; i < 8; ++i) { const float ea = __builtin_amdgcn_exp2f(-av[i] * LOG2E), eb = __builtin_amdgcn_exp2f(-bv[i] * LOG2E), d1 = 1.0f + eb;
                        g1_[i] = __builtin_amdgcn_rcpf(d1); rt_[i] = (d1 < 1e30f) ? d1 * __builtin_amdgcn_rcpf(1.0f + ea) : 0.f; }
                    v4u wr_, wg_; wr_.x = pk2(rt_[0], rt_[1]); wr_.y = pk2(rt_[2], rt_[3]); wr_.z = pk2(rt_[4], rt_[5]); wr_.w = pk2(rt_[6], rt_[7]);
                    wg_.x = pk2(g1_[0], g1_[1]); wg_.y = pk2(g1_[2], g1_[3]); wg_.z = pk2(g1_[4], g1_[5]); wg_.w = pk2(g1_[6], g1_[7]);
                    *(GAS v4u*)(gm + (size_t)row * 2048) = wr_; *(GAS v4u*)(gm + (size_t)row * 2048 + 128) = wg_; }
            return false;
        }
        bf16* dst; int pitch, colt; float sc = 1.f; int mode = 0;
        bool rope_bj1 = false; int kvt = 0, nh = 8;
        if (pn < 2)       { dst = (bf16*)(ws + WS_QF); pitch = 512; colt = pn * 256; sc = C2 * DBG_FOXT; }
        else if (pn < 4)  { dst = (bf16*)(ws + WS_KF); pitch = 512; colt = (pn - 2) * 256; kvt = 1; }
        else if (pn < 6)  { dst = (bf16*)(ws + WS_VF); pitch = 512; colt = (pn - 4) * 256; kvt = 2; }
        else if (pn < 8)  { dst = (bf16*)(ws + WS_QN); pitch = 512; colt = (pn - 6) * 256; sc = C2 * DBG_NSAT; mode = 1; rope_bj1 = true; }
        else if (pn == 8) { dst = (bf16*)(ws + WS_KVC); pitch = 256; colt = 0; }
        else if (pn == 9) { dst = (bf16*)(ws + WS_KVS); pitch = 256; colt = 0; mode = 1; kvt = 3; nh = 2; }
        else if (pn == 10){ dst = (bf16*)(ws + WS_KVW); pitch = 256; colt = 0; mode = 1; kvt = 3; nh = 2; }
        else              { dst = (bf16*)(ws + WS_GM); pitch = 2048; colt = (pn - 12) * 256; mode = 2; }
        const int cb0 = wc * 32 + 8 * fq;
        const bool ropelane = ((wc & 1) == 0) && (fq < 2);
        const GAS f32x2* rt = (const GAS f32x2*)(ws + WS_ROPE);
#pragma unroll
        for (int ai = 0; ai < 2; ++ai)
#pragma unroll
            for (int m = 0; m < 4; ++m) { const int row = row0 + ai * 128 + m * 16; bf16* rowp = dst + (size_t)row * pitch + colt + cb0;
#pragma unroll
                for (int bj = 0; bj < 2; ++bj) { const f32x4 a0 = acc[ai][bj][m][0], a1 = acc[ai][bj][m][1];
                    float v[8] = {a0.x, a0.y, a0.z, a0.w, a1.x, a1.y, a1.z, a1.w};
                    if (mode == 1 && (bj == 0 || rope_bj1) && ((wc & 1) == 0)) {
                        const int pos = row & (SEQ - 1);
#pragma unroll
                        for (int i = 0; i < 8; ++i) { const float pv = __shfl_xor(v[i], 16); if (ropelane) { const f32x2 cs = rt[pos * 8 + i];
                                v[i] = (fq == 0) ? (v[i] * cs.x - pv * cs.y) : (pv * cs.y + v[i] * cs.x); } }
                    }
                    if (mode == 2) {
#pragma unroll
                        for (int i = 0; i < 8; ++i) v[i] = sigmoidf_(v[i]);
                    }
                    v4u w; w.x = pk2(v[0] * sc, v[1] * sc); w.y = pk2(v[2] * sc, v[3] * sc); w.z = pk2(v[4] * sc, v[5] * sc); w.w = pk2(v[6] * sc, v[7] * sc);
#ifdef DBG_C_INPROJ
                    w.x = COARSE2(w.x); w.y = COARSE2(w.y); w.z = COARSE2(w.z); w.w = COARSE2(w.w);
#endif
                    if (kvt == 0) *(GAS v4u*)(rowp + bj * 128) = w;
                    else {
                        const int bb = row >> 12, sq = row & (SEQ - 1), tile = sq >> 6, r = sq & 63;
                        const int col = (kvt == 3) ? cb0 : (colt + cb0 + bj * 128);
                        const int hh = col >> 6, d = col & 63; const bool isv = (kvt == 2) || (kvt == 3 && bj == 1);
                        unsigned char* img = (unsigned char*)dst + (isv && kvt == 3 ? 8 * MiB : 0) + ((size_t)((bb * nh + hh) * 64 + tile) << 13);
                        const int off = isv ? ((d >> 5) * 4096 + (r >> 4) * 1024 + (r & 15) * 64 + (d & 31) * 2) : ((d >> 3) * 1024 + r * 16);
                        *(GAS v4u*)(img + off) = w; } } }
        return false;
    }
};

__device__ __forceinline__ void p2_compress_unit(Frame& F, int uidx) {
    unsigned char* ws = F.ws; const int lane = F.lane, wid = F.wave, tid = F.tid;
    const int j = uidx & 1, nb = (uidx >> 1) & 15, g = (uidx >> 5) & 1, b = uidx >> 6;
    const bf16* KVC = (const bf16*)(ws + WS_KVC); const bf16* W1T = (const bf16*)(ws + WS_W1T) + (size_t)j * 128 * 2048; const bf16* W2T = (const bf16*)(ws + WS_W2T) + (size_t)j * 64 * 128;
    constexpr int APITCH = 4096 + 16;
    LAS unsigned char* aimg = F.lds;
    LAS bf16* h1b = (LAS bf16*)(F.lds + 32 * APITCH);
    const int fr = lane & 15, fq = lane >> 4;
    { v4u pc[16];
#pragma unroll
      for (int i = 0; i < 16; ++i) { const int p = tid + 512 * i, bs = p >> 12, n = (p >> 8) & 15, l = (p >> 3) & 31, c8 = p & 7; int nn = nb * 16 + n; nn = nn > 254 ? 254 : nn;
          pc[i] = *(const GAS v4u*)(KVC + ((size_t)(b + 4 * bs) * SEQ + 16 * nn + l) * 256 + j * 128 + g * 64 + c8 * 8); }
#pragma unroll
      for (int i = 0; i < 16; ++i) { const int p = tid + 512 * i, bs = p >> 12, n = (p >> 8) & 15, l = (p >> 3) & 31, c8 = p & 7;
          *(LAS v4u*)(aimg + (bs * 16 + n) * APITCH + l * 128 + c8 * 16) = pc[i]; } }
    const bf16* wrow = W1T + (size_t)(wid * 16 + fr) * 2048 + 8 * fq;
    bf16x8 bw[16];
#pragma unroll
    for (int s = 0; s < 16; ++s) bw[s] = *(const GAS bf16x8*)(wrow + 32 * s);
    bf16x8 w2f[4];
#pragma unroll
    for (int k2 = 0; k2 < 4; ++k2) w2f[k2] = *(const GAS bf16x8*)(W2T + (size_t)((wid & 3) * 16 + fr) * 128 + k2 * 32 + 8 * fq);
    __syncthreads();
    f32x4 acc0 = (f32x4){0.f, 0.f, 0.f, 0.f}, acc1 = acc0;
    const LAS unsigned char* ap0 = aimg + fr * APITCH + fq * 16; const LAS unsigned char* ap1 = ap0 + 16 * APITCH;
#pragma unroll
    for (int s0 = 0; s0 < 64; s0 += 16) {
#pragma unroll
        for (int q = 0; q < 16; ++q) { const int s = s0 + q;
            const bf16x8 a0 = *(const LAS bf16x8*)(ap0 + (s >> 1) * 128 + (s & 1) * 64), a1 = *(const LAS bf16x8*)(ap1 + (s >> 1) * 128 + (s & 1) * 64);
            acc0 = __builtin_amdgcn_mfma_f32_16x16x32_bf16(a0, bw[q], acc0, 0, 0, 0); acc1 = __builtin_amdgcn_mfma_f32_16x16x32_bf16(a1, bw[q], acc1, 0, 0, 0);
            if (s0 + 16 < 64) bw[q] = *(const GAS bf16x8*)(wrow + 32 * (s + 16)); } }
    { const float bias = ((const float*)(ws + WS_BIAS1))[j * 128 + wid * 16 + fr];
#pragma unroll
      for (int r = 0; r < 4; ++r) { h1b[(4 * fq + r) * 128 + wid * 16 + fr] = (bf16)(pk2(gelu_erf(acc0[r] + bias), 0.f) & 0xffffu); h1b[2048 + (4 * fq + r) * 128 + wid * 16 + fr] = (bf16)(pk2(gelu_erf(acc1[r] + bias), 0.f) & 0xffffu); } }
    __syncthreads();
    {
        const int u = wid >> 2, wq = wid & 3, bb = b + 4 * u;
        f32x4 a2 = (f32x4){0.f, 0.f, 0.f, 0.f};
#pragma unroll
        for (int k2 = 0; k2 < 4; ++k2) { const bf16x8 a = *(const LAS bf16x8*)(h1b + u * 2048 + fr * 128 + k2 * 32 + 8 * fq);
            a2 = __builtin_amdgcn_mfma_f32_16x16x32_bf16(a, w2f[k2], a2, 0, 0, 0); }
        bf16* dstb = (bf16*)(ws + (j == 0 ? WS_KCMP : WS_VCMP));
        const GAS f32x2* rt = (const GAS f32x2*)(ws + WS_ROPE);
#pragma unroll
        for (int r = 0; r < 4; ++r) { const int nrow = nb * 16 + 4 * fq + r; float v = a2[r];
            if (j == 0 && wq == 0 && DBG_KROPE >= 0) { const float pv = __shfl_xor(v, 8); const int pos = (16 * nrow + DBG_KROPE) & (SEQ - 1); const f32x2 cs = rt[pos * 8 + (fr & 7)];
                v = (fr < 8) ? (v * cs.x - pv * cs.y) : (pv * cs.y + v * cs.x); }
            if (nrow > 254) v = 0.f;
            dstb[((size_t)bb * 256 + nrow) * 128 + g * 64 + wq * 16 + fr] = (bf16)(pk2(v, 0.f) & 0xffffu); }
    }
    __syncthreads();
}
__device__ __forceinline__ void p2_cumsum_wave(Frame& F, int bh) {
    const int b = bh >> 3, h = bh & 7, lane = F.lane;
    const float* lf = (const float*)(F.ws + WS_LOGF) + ((size_t)b * SEQ + lane) * 8 + h;
    float v[64];
#pragma unroll
    for (int i = 0; i < 64; ++i) v[i] = lf[(size_t)i * 64 * 8];
    v2u* cum = (v2u*)(F.ws + WS_CUM) + (size_t)bh * SEQ + lane;
#pragma unroll
    for (int o = 1; o < 64; o <<= 1) { float t[64];
#pragma unroll
        for (int i = 0; i < 64; ++i) t[i] = __shfl_up(v[i], o);
        const bool take = lane >= o;
#pragma unroll
        for (int i = 0; i < 64; ++i) v[i] += take ? t[i] : 0.f; }
    float carry = 0.f;
#pragma unroll
    for (int i = 0; i < 64; ++i) { const float rowtot = __uint_as_float(__builtin_amdgcn_readlane(__float_as_uint(v[i]), 63)); const float x = v[i] + carry; carry += rowtot;
        { const float c = -LOG2E * DBG_DECAY * x; const unsigned h_ = pk2(c, 0.f) & 0xffffu; const float r1 = c - __uint_as_float(h_ << 16);
            const unsigned m_ = pk2(r1, 0.f) & 0xffffu; const float r2 = r1 - __uint_as_float(m_ << 16); const unsigned l_ = pk2(r2, 0.f) & 0xffffu;
            v2u w; w.x = h_ | (m_ << 16); w.y = l_ | 0x3F800000u; cum[i * 64] = w; } }
}

#include <hip/hip_bf16.h>
#include <cmath>
namespace fa {
using bf16=__hip_bfloat16;
using bf16x8=__attribute__((ext_vector_type(8)))short;
using s16x4=__attribute__((ext_vector_type(4)))short;
using f32x16=__attribute__((ext_vector_type(16)))float;
using u32x4=__attribute__((ext_vector_type(4)))unsigned;
typedef float f32x4_t __attribute__((ext_vector_type(4)));
constexpr int D=64;
constexpr int NW=8,QBLK=32,KVBLK=64;
__device__ __forceinline__ int crow(int r,int hi){return (r&3)+8*(r>>2)+4*hi;}
#define SBAR() __builtin_amdgcn_sched_barrier(0)
__device__ __forceinline__ void cmask(f32x16&p0,f32x16&p1,int jb,int qrel,int hi){
  const float NEG=-INFINITY; int kb=64*jb+4*hi;
  #pragma unroll
  for(int r=0;r<16;++r){int kv=kb+(r&3)+8*(r>>2); if(kv>qrel)p0[r]=NEG; if(kv+32>qrel)p1[r]=NEG;}
}

constexpr int NSLOT=3, SLOTB=8192;
constexpr int LDS_K=0, LDS_V=NSLOT*SLOTB, LDS_WS=2*NSLOT*SLOTB;
constexpr float C2=0.125f*1.4426950408889634f;
__device__ __forceinline__ void glds16(const void*gsrc,unsigned lds_dst){unsigned keep;
  asm volatile("s_mov_b32 %0, m0\n\ts_mov_b32 m0, %2\n\ts_nop 0\n\tglobal_load_lds_dwordx4 %1, off\n\ts_mov_b32 m0, %0":"=&s"(keep):"v"(gsrc),"s"(lds_dst):"memory");}
__device__ __forceinline__ float max3f(float a,float b,float c){float r;asm("v_max3_f32 %0, %1, %2, %3":"=v"(r):"v"(a),"v"(b),"v"(c));return r;}
__device__ __forceinline__ float max2f(float a,float b){float r;asm("v_max_f32_e32 %0, %1, %2":"=v"(r):"v"(a),"v"(b));return r;}
__device__ __forceinline__ float fadd_s(float a,float b){float r;asm("v_add_f32_e32 %0, %1, %2":"=v"(r):"v"(a),"v"(b));return r;}
__device__ __forceinline__ float fsub_s(float a,float b){float r;asm("v_sub_f32_e32 %0, %1, %2":"=v"(r):"v"(a),"v"(b));return r;}
typedef float f32x2_t __attribute__((ext_vector_type(2))); typedef __bf16 bf16x2_t __attribute__((ext_vector_type(2)));
__device__ __forceinline__ unsigned cvtpk_s(float lo,float hi){f32x2_t v={lo,hi};bf16x2_t b=__builtin_convertvector(v,bf16x2_t);return __builtin_bit_cast(unsigned,b);}
#define WAIT_BAR(N) asm volatile("s_waitcnt vmcnt(" #N ") lgkmcnt(0)\n\ts_barrier":::"memory")

__device__ __forceinline__ void qkt(f32x16&p0,f32x16&p1,const char*Kslot,const bf16x8*qr,s16x4 kxa,s16x4 kxb,s16x4 qx,int r32,int hi){
  const char*kb=Kslot+hi*1024+r32*16;
  p0=__builtin_amdgcn_mfma_f32_32x32x8bf16_1k(kxa,qx,(f32x16){0.f,0.f,0.f,0.f,0.f,0.f,0.f,0.f,0.f,0.f,0.f,0.f,0.f,0.f,0.f,0.f},0,0,0);
  p1=__builtin_amdgcn_mfma_f32_32x32x8bf16_1k(kxb,qx,(f32x16){0.f,0.f,0.f,0.f,0.f,0.f,0.f,0.f,0.f,0.f,0.f,0.f,0.f,0.f,0.f,0.f},0,0,0);
  #pragma unroll
  for(int d0=0;d0<4;++d0){
    const bf16x8 b0=*reinterpret_cast<const bf16x8*>(kb+d0*2048);
    const bf16x8 b1=*reinterpret_cast<const bf16x8*>(kb+d0*2048+512);
    p0=__builtin_amdgcn_mfma_f32_32x32x16_bf16(b0,qr[d0],p0,0,0,0);p1=__builtin_amdgcn_mfma_f32_32x32x16_bf16(b1,qr[d0],p1,0,0,0);}
}
__device__ __forceinline__ float refsplit(float t,unsigned&nh,unsigned&nl){ f32x2_t a={t,0.f}; const unsigned h=__builtin_bit_cast(unsigned,__builtin_convertvector(a,bf16x2_t))&0xffffu; const float fh=__uint_as_float(h<<16);
  f32x2_t b={t-fh,0.f}; const unsigned l=__builtin_bit_cast(unsigned,__builtin_convertvector(b,bf16x2_t))&0xffffu; nh=h^0x8000u; nl=l^0x8000u; return fh+__uint_as_float(l<<16); }
__device__ __forceinline__ s16x4 mkqx(unsigned nh,unsigned nl,int hi){ const unsigned w0=hi?0u:0x3F803F80u, w1=hi?(nl<<16):(0x3F80u|(nh<<16)); unsigned long long v=((unsigned long long)w1<<32)|w0; return __builtin_bit_cast(s16x4,v); }
typedef __attribute__((address_space(3))) const char* lds_cptr;
typedef short v4i16_t __attribute__((ext_vector_type(4)));
__device__ __forceinline__ void kload8(bf16x8*kf,lds_cptr kp){
  kf[0]=*(const __attribute__((address_space(3))) bf16x8*)(kp);      kf[1]=*(const __attribute__((address_space(3))) bf16x8*)(kp+512);
  kf[2]=*(const __attribute__((address_space(3))) bf16x8*)(kp+2048); kf[3]=*(const __attribute__((address_space(3))) bf16x8*)(kp+2560);
  kf[4]=*(const __attribute__((address_space(3))) bf16x8*)(kp+4096); kf[5]=*(const __attribute__((address_space(3))) bf16x8*)(kp+4608);
  kf[6]=*(const __attribute__((address_space(3))) bf16x8*)(kp+6144); kf[7]=*(const __attribute__((address_space(3))) bf16x8*)(kp+6656);
}
__device__ __forceinline__ void kload2(bf16x8*kf,lds_cptr kp,int j){ kf[2*j]=*(const __attribute__((address_space(3))) bf16x8*)(kp+j*2048); kf[2*j+1]=*(const __attribute__((address_space(3))) bf16x8*)(kp+j*2048+512); }
__device__ __forceinline__ s16x4 vtr(lds_cptr p){ return __builtin_bit_cast(s16x4,__builtin_amdgcn_ds_read_tr16_b64_v4i16((__attribute__((address_space(3))) v4i16_t*)p)); }
__device__ __forceinline__ float rowmax(const f32x16&p0,const f32x16&p1){
  float a=max3f(p0[0],p0[1],p1[0]),b=max3f(p0[2],p0[3],p1[1]);a=max3f(a,p1[2],p1[3]);
  #pragma unroll
  for(int r=4;r<16;r+=4){a=max3f(a,p0[r],p0[r+1]);b=max3f(b,p0[r+2],p0[r+3]);a=max3f(a,p1[r],p1[r+1]);b=max3f(b,p1[r+2],p1[r+3]);}
  const float m=max2f(a,b);
  auto rr=__builtin_amdgcn_permlane32_swap(__float_as_uint(m),__float_as_uint(m),false,false);
  return max2f(__uint_as_float(rr[0]),__uint_as_float(rr[1]));
}
__device__ __forceinline__ void pv(f32x16*o,int vb,bf16x8 pa0,bf16x8 pa1,bf16x8 pa2,bf16x8 pa3){
  #pragma unroll
  for(int d0=0;d0<2;++d0){s16x4 lo[4],hi[4];
    #pragma unroll
    for(int ks=0;ks<4;++ks){
      asm volatile("ds_read_b64_tr_b16 %0,%1 offset:%c2":"=&v"(lo[ks]):"v"(vb),"i"(d0*4096+ks*1024):"memory");
      asm volatile("ds_read_b64_tr_b16 %0,%1 offset:%c2":"=&v"(hi[ks]):"v"(vb),"i"(d0*4096+ks*1024+512):"memory");}
    asm volatile("s_waitcnt lgkmcnt(0)":::"memory");SBAR();
    #define PK(k) (bf16x8){lo[k][0],lo[k][1],lo[k][2],lo[k][3],hi[k][0],hi[k][1],hi[k][2],hi[k][3]}
    o[d0]=__builtin_amdgcn_mfma_f32_32x32x16_bf16(pa0,PK(0),o[d0],0,0,0);
    o[d0]=__builtin_amdgcn_mfma_f32_32x32x16_bf16(pa1,PK(1),o[d0],0,0,0);
    o[d0]=__builtin_amdgcn_mfma_f32_32x32x16_bf16(pa2,PK(2),o[d0],0,0,0);
    o[d0]=__builtin_amdgcn_mfma_f32_32x32x16_bf16(pa3,PK(3),o[d0],0,0,0);
    #undef PK
  }
}

#ifndef ATTN_STORE16
#define ATTN_STORE16(p,v) (*(u32x4*)(p)=(v))
#endif
template<int MODE,int THRL> __device__ __forceinline__ void run(const bf16*Qw,int qpitch,const bf16*__restrict__ Kh,const bf16*__restrict__ Vh,int kvpitch,int tbase,int tdir,int NT,int NTreal,
    int qpos,int q0w,int QBk,unsigned long long selm,unsigned long long um,const float*cbl,char*shm,f32x16(&o)[2],float&l_out){
  const int tid=threadIdx.x,lane=tid&63,r32=lane&31,hi=lane>>5; const int wid=__builtin_amdgcn_readfirstlane(tid>>6);
  #define TIDX(t) ({int ti_=tbase+tdir*(t); ti_=ti_<0?0:(ti_>63?63:ti_); ti_;})
  unsigned long long mK=um,mV=um,mC=um; int nK=0,nV=0,nC=0;
  #define POPT(M_,N_) ({ int ti_; if(MODE==3){ ti_=(M_)?(int)__builtin_ctzll(M_):0; M_&=(M_)-1ull; } else { ti_=TIDX(N_); ++(N_); } ti_; })
  const unsigned lds0=(unsigned)(uintptr_t)shm;
  float*wsf=(float*)(shm+LDS_WS)+wid*64;
  const bf16*ksrc=Kh+wid*512+lane*8;
  const bf16*vsrc=Vh+wid*512+lane*8;
  const unsigned kdst=lds0+LDS_K+wid*1024, vdst=lds0+LDS_V+wid*1024;
  #define DMA_K(t,slot) do{ const int tk_=POPT(mK,nK); glds16(ksrc+(long)tk_*4096,(unsigned)__builtin_amdgcn_readfirstlane(kdst+(slot))); }while(0)
  #define DMA_V(t,slot) do{ const int tv_=POPT(mV,nV); glds16(vsrc+(long)tv_*4096,(unsigned)__builtin_amdgcn_readfirstlane(vdst+(slot))); }while(0)
  const int vb0=(int)(lds0+LDS_V)+((lane>>4)&1)*32+(lane&3)*8+(4*hi+((lane&15)>>2))*64;
  const char*Kbase=shm+LDS_K; bf16x8 kf[8];
  const lds_cptr shm3=(lds_cptr)shm; const lds_cptr kp0=shm3+LDS_K+hi*1024+r32*16; const lds_cptr vp0=shm3+LDS_V+((lane>>4)&1)*32+(lane&3)*8+(4*hi+((lane&15)>>2))*64;
  DMA_K(0,0);DMA_V(0,0);DMA_K(1,SLOTB);
  bf16x8 qr[4];
  #pragma unroll
  for(int d0=0;d0<4;++d0)qr[d0]=*reinterpret_cast<const bf16x8*>(&Qw[(long)r32*qpitch+d0*16+hi*8]);
  float mhat=0.f,l_reg=0.f;o[0]=f32x16{};o[1]=f32x16{};
  const lds_cptr kxl3=(lds_cptr)shm+(MODE==0?(int)((const char*)cbl-shm):0)+r32*8; s16x4 kxa,kxb,qx=mkqx(0x8000u,0x8000u,hi);
  if(MODE!=0){ kxa=__builtin_bit_cast(s16x4,0x3F80000000000000ull); kxb=kxa; }
  #define KXRD(tt) do{ if(MODE==0){ const __attribute__((address_space(3))) s16x4*p_=(const __attribute__((address_space(3))) s16x4*)(kxl3+512*TIDX(tt)); kxa=p_[0]; kxb=p_[32]; } }while(0)
  int tcur=0; s16x4 qxu;
  #define QXSEL(t) do{ tcur=POPT(mC,nC); qxu=qx; if(MODE==3){ const bool sel_=(((selm>>tcur)&1ull)!=0ull)&&((t)<NTreal); if(!sel_){ unsigned long long v_=__builtin_bit_cast(unsigned long long,qx); \
      v_=(v_&0xffffffffull)|((unsigned long long)(hi?0u:0xFF003F80u)<<32); qxu=__builtin_bit_cast(s16x4,v_); } } }while(0)
  #define CMASK(P0,P1,t) do{ const int ta_=tcur; const int kvb_=64*ta_+4*hi; \
    if(MODE==0){ \
      if(64*ta_+63>q0w){ _Pragma("unroll") for(int r=0;r<16;++r){ const int kv_=kvb_+(r&3)+8*(r>>2); if(kv_>qpos)P0[r]=-INFINITY; if(kv_+32>qpos)P1[r]=-INFINITY; } } } \
    if(MODE==3){ \
      if(ta_==QBk){ _Pragma("unroll") for(int r=0;r<16;++r){ const int kv_=kvb_+(r&3)+8*(r>>2); if(kv_>qpos)P0[r]=-INFINITY; if(kv_+32>qpos)P1[r]=-INFINITY; } } } \
    if(MODE==4){ const bool vl_=((t)<NTreal); if(!vl_||ta_==QBk||ta_+8==QBk){ \
      _Pragma("unroll") for(int r=0;r<16;++r){ const int kv_=kvb_+(r&3)+8*(r>>2); if(!vl_||kv_>qpos||qpos-kv_>=512)P0[r]=-INFINITY; if(!vl_||kv_+32>qpos||qpos-(kv_+32)>=512)P1[r]=-INFINITY; } } } \
  }while(0)
  bool resc=false;
  #define START(P0,P1) do{ const float rm=rowmax(P0,P1); resc=false; \
    { unsigned nh_,nl_; const float dl=refsplit(rm>-1e30f?rm:0.f,nh_,nl_); mhat=dl; qx=mkqx(nh_,nl_,hi); \
      _Pragma("unroll") for(int r=0;r<16;++r){P0[r]=fsub_s(P0[r],dl);P1[r]=fsub_s(P1[r],dl);} \
      } \
    _Pragma("unroll") for(int r=0;r<16;++r)P0[r]=__builtin_amdgcn_exp2f(P0[r]); }while(0)
  #define RESC() do{ if(resc){ asm volatile("s_waitcnt lgkmcnt(0)":::"memory"); \
      _Pragma("unroll") for(int d_=0;d_<2;++d_) _Pragma("unroll") for(int r=0;r<16;++r)o[d_][r]*=wsf[crow(r,hi)]; } }while(0)
  f32x16 pA0,pA1,pB0,pB1;
  int sl_prev=0,sl_cur=0,sl_next=SLOTB;
  #define ROT() do{sl_prev=sl_cur;sl_cur=sl_next;sl_next=(sl_next==(NSLOT-1)*SLOTB)?0:sl_next+SLOTB;}while(0)
  DMA_K(2,2*SLOTB);
  WAIT_BAR(3);
  KXRD(0); QXSEL(0); qkt(pA0,pA1,Kbase,qr,kxa,kxb,qxu,r32,hi);asm volatile("s_nop 15\n\ts_nop 7":"+v"(pA0),"+v"(pA1));CMASK(pA0,pA1,0);
  START(pA0,pA1);
  _Pragma("unroll") for(int r=0;r<16;++r)pA1[r]=__builtin_amdgcn_exp2f(pA1[r]);
  WAIT_BAR(0);
  DMA_K(3,0);DMA_V(1,SLOTB);
  ROT();
  kload8(kf,kp0+sl_cur); KXRD(1);
  WAIT_BAR(2);
  if(NT<=2){ WAIT_BAR(0); }
  s16x4 vlo[8],vhi[8]; u32x4 pw0,pw1,pw2,pw3;
  #define PKW(P,B) cvtpk_s(P[B],P[B+1])
  #define PAF(k) __builtin_bit_cast(bf16x8,pw##k)
  #define VFR(i) (bf16x8){vlo[i][0],vlo[i][1],vlo[i][2],vlo[i][3],vhi[i][0],vhi[i][1],vhi[i][2],vhi[i][3]}
  #define PIN(x) asm volatile("":"+v"(x))
  #define MX3(a,b,c) __builtin_fmaxf(__builtin_fmaxf((a),(b)),(c))
  #define GAPA(MF,A0,A1,A2,A3,W0,W1,PW) do{ MF; sacc+=A0; sacc+=A1; sacc+=A2; sacc+=A3; PIN(sacc); W0; W1; PIN(PW); SBAR(); }while(0)
  #define EX(v) __builtin_amdgcn_exp2f(v)
  #define GAPB(MF,X,B) do{ MF; X[B]=EX(X[B]); X[B+1]=EX(X[B+1]); X[B+2]=EX(X[B+2]); X[B+3]=EX(X[B+3]); PIN(X); SBAR(); }while(0)
  #define VRD(i) do{ vlo[i]=vtr(vp_+(((i)>>2)*4096+((i)&3)*1024)); vhi[i]=vtr(vp_+(((i)>>2)*4096+((i)&3)*1024+512)); }while(0)
  #define KRD(G,j) do{ if(G){ kload2(kf,kp0+sl_next,j); SBAR(); } }while(0)
  #define STEP(C0,C1,P0,P1,t,GK,GV,GL) do{ SBAR(); \
    const lds_cptr vp_=vp0+sl_prev; \
    QXSEL(t); \
    C0=__builtin_amdgcn_mfma_f32_32x32x8bf16_1k(kxa,qxu,(f32x16){0.f,0.f,0.f,0.f,0.f,0.f,0.f,0.f,0.f,0.f,0.f,0.f,0.f,0.f,0.f,0.f},0,0,0); \
    C1=__builtin_amdgcn_mfma_f32_32x32x8bf16_1k(kxb,qxu,(f32x16){0.f,0.f,0.f,0.f,0.f,0.f,0.f,0.f,0.f,0.f,0.f,0.f,0.f,0.f,0.f,0.f},0,0,0); \
    VRD(0); SBAR(); float sacc=(P0[0]+P0[1]); \
    GAPA(C0=__builtin_amdgcn_mfma_f32_32x32x16_bf16(kf[0],qr[0],C0,0,0,0), P0[2],P0[3],P0[4],P0[5],     pw0[0]=PKW(P0,0), pw0[1]=PKW(P0,2), pw0); \
    VRD(4); SBAR(); GAPA(C1=__builtin_amdgcn_mfma_f32_32x32x16_bf16(kf[1],qr[0],C1,0,0,0), P0[6],P0[7],P0[8],P0[9],     pw0[2]=PKW(P0,4), pw0[3]=PKW(P0,6), pw0); \
    VRD(1); SBAR(); GAPA(C0=__builtin_amdgcn_mfma_f32_32x32x16_bf16(kf[2],qr[1],C0,0,0,0),   P0[10],P0[11],P0[12],P0[13], pw1[0]=PKW(P0,8), pw1[1]=PKW(P0,10), pw1); \
    VRD(5); SBAR(); GAPA(C1=__builtin_amdgcn_mfma_f32_32x32x16_bf16(kf[3],qr[1],C1,0,0,0),   P0[14],P0[15],P1[0],P1[1],   pw1[2]=PKW(P0,12),pw1[3]=PKW(P0,14), pw1); \
    VRD(2); SBAR(); GAPA(C0=__builtin_amdgcn_mfma_f32_32x32x16_bf16(kf[4],qr[2],C0,0,0,0),   P1[2],P1[3],P1[4],P1[5],     pw2[0]=PKW(P1,0), pw2[1]=PKW(P1,2), pw2); \
    VRD(6); SBAR(); GAPA(C1=__builtin_amdgcn_mfma_f32_32x32x16_bf16(kf[5],qr[2],C1,0,0,0),   P1[6],P1[7],P1[8],P1[9],     pw2[2]=PKW(P1,4), pw2[3]=PKW(P1,6), pw2); \
    VRD(3); SBAR(); GAPA(C0=__builtin_amdgcn_mfma_f32_32x32x16_bf16(kf[6],qr[3],C0,0,0,0),   P1[10],P1[11],P1[12],P1[13], pw3[0]=PKW(P1,8), pw3[1]=PKW(P1,10), pw3); \
    VRD(7); SBAR(); GAPA(C1=__builtin_amdgcn_mfma_f32_32x32x16_bf16(kf[7],qr[3],C1,0,0,0),   P1[14],P1[15],0.f,0.f,       pw3[2]=PKW(P1,12),pw3[3]=PKW(P1,14), pw3); \
    l_reg+=sacc; \
    if(GK){DMA_K((t)+3,sl_cur);} if(GV){DMA_V((t)+1,sl_next);} \
    CMASK(C0,C1,t); \
    { float a=MX3(C0[0],C0[1],C1[0]),b=MX3(C0[2],C0[3],C1[1]); a=MX3(a,C1[2],C1[3]); \
      _Pragma("unroll") for(int r=4;r<16;r+=4){a=MX3(a,C0[r],C0[r+1]);b=MX3(b,C0[r+2],C0[r+3]);a=MX3(a,C1[r],C1[r+1]);b=MX3(b,C1[r+2],C1[r+3]);} \
      float rm=__builtin_fmaxf(a,b); { auto rr=__builtin_amdgcn_permlane32_swap(__float_as_uint(rm),__float_as_uint(rm),false,false); rm=__builtin_fmaxf(__uint_as_float(rr[0]),__uint_as_float(rr[1])); } \
      resc=false; \
      if(__builtin_expect(__any(rm>(float)THRL),0)){ unsigned nh_,nl_; const float mn_=refsplit(mhat+__builtin_fmaxf(rm,0.f),nh_,nl_); const float dl=mn_-mhat; mhat=mn_; qx=mkqx(nh_,nl_,hi); \
        _Pragma("unroll") for(int r=0;r<16;++r){C0[r]-=dl;C1[r]-=dl;} \
        const float f=__builtin_amdgcn_exp2f(-dl); l_reg*=f; if(hi==0)wsf[r32]=f; resc=true; } } \
    SBAR(); \
    GAPB(o[0]=__builtin_amdgcn_mfma_f32_32x32x16_bf16(PAF(0),VFR(0),o[0],0,0,0), C0,0); \
    GAPB(o[1]=__builtin_amdgcn_mfma_f32_32x32x16_bf16(PAF(0),VFR(4),o[1],0,0,0), C0,4); \
    if(GL){KXRD((t)+1);} KRD(GL,0); GAPB(o[0]=__builtin_amdgcn_mfma_f32_32x32x16_bf16(PAF(1),VFR(1),o[0],0,0,0), C0,8); \
    KRD(GL,1); GAPB(o[1]=__builtin_amdgcn_mfma_f32_32x32x16_bf16(PAF(1),VFR(5),o[1],0,0,0), C0,12); \
    KRD(GL,2); GAPB(o[0]=__builtin_amdgcn_mfma_f32_32x32x16_bf16(PAF(2),VFR(2),o[0],0,0,0), C1,0); \
    KRD(GL,3); GAPB(o[1]=__builtin_amdgcn_mfma_f32_32x32x16_bf16(PAF(2),VFR(6),o[1],0,0,0), C1,4); \
    GAPB(o[0]=__builtin_amdgcn_mfma_f32_32x32x16_bf16(PAF(3),VFR(3),o[0],0,0,0), C1,8); \
    GAPB(o[1]=__builtin_amdgcn_mfma_f32_32x32x16_bf16(PAF(3),VFR(7),o[1],0,0,0), C1,12); \
    }while(0)
  int t=1;
  for(;t+5<NT;t+=2){
    STEP(pB0,pB1,pA0,pA1,t,true,true,true);     WAIT_BAR(2); RESC(); ROT();
    STEP(pA0,pA1,pB0,pB1,t+1,true,true,true);   WAIT_BAR(2); RESC(); ROT();
  }
  #define ENDW(tt) do{ if((tt)+3<NT){WAIT_BAR(2);} else if((tt)+2<NT){WAIT_BAR(1);} else {WAIT_BAR(0);} }while(0)
  for(;t+1<NT;t+=2){
    STEP(pB0,pB1,pA0,pA1,t,(t+3<NT),(t+1<NT),(t+1<NT));       ENDW(t);   RESC(); ROT();
    STEP(pA0,pA1,pB0,pB1,t+1,(t+4<NT),(t+2<NT),(t+2<NT));     ENDW(t+1); RESC(); ROT();
  }
  STEP(pB0,pB1,pA0,pA1,NT-1,false,false,false); RESC();
  { float sacc=pB0[0]+pB0[1]; _Pragma("unroll") for(int r=2;r<16;++r)sacc+=pB0[r]; _Pragma("unroll") for(int r=0;r<16;++r)sacc+=pB1[r]; l_reg+=sacc;
    pw0=(u32x4){PKW(pB0,0),PKW(pB0,2),PKW(pB0,4),PKW(pB0,6)};pw1=(u32x4){PKW(pB0,8),PKW(pB0,10),PKW(pB0,12),PKW(pB0,14)};pw2=(u32x4){PKW(pB1,0),PKW(pB1,2),PKW(pB1,4),PKW(pB1,6)};pw3=(u32x4){PKW(pB1,8),PKW(pB1,10),PKW(pB1,12),PKW(pB1,14)};
    SBAR(); pv(o,vb0+sl_cur,PAF(0),PAF(1),PAF(2),PAF(3)); }
  #undef PKW
  #undef PAF
  #undef VFR
  #undef PIN
  #undef MX3
  #undef GAPA
  #undef GAPB
  #undef EX
  #undef VRD
  #undef KRD
  #undef STEP
  #undef ENDW
  {auto rr=__builtin_amdgcn_permlane32_swap(__float_as_uint(l_reg),__float_as_uint(l_reg),false,false);l_out=__uint_as_float(rr[0])+__uint_as_float(rr[1]);}
  asm volatile("s_waitcnt vmcnt(0) lgkmcnt(0)\n\ts_barrier":::"memory");
  #undef KXRD
  #undef QXSEL
  #undef POPT
  #undef DMA_K
  #undef DMA_V
  #undef CMASK
  #undef START
  #undef RESC
  #undef ROT
  #undef TIDX
}
#undef SBAR
#undef WAIT_BAR
}
namespace att {
constexpr int A_K = 0, A_V = 32768, A_WS = 65536, A_OST = 0  , A_BIG = 67584, A_SEL = 133120, SLOT = 16384  ;
typedef LAS const char* lds_cptr;
typedef short v4i16_t __attribute__((ext_vector_type(4)));
#define MFMA32(a, b, c) __builtin_amdgcn_mfma_f32_32x32x16_bf16(a, b, c, 0, 0, 0)
__device__ __forceinline__ int crow(int r, int hi) { return (r & 3) + 8 * (r >> 2) + 4 * hi; }
__device__ __forceinline__ void glds16(const void* g, unsigned lds_base) {
    unsigned sv; asm volatile("s_mov_b32 %0, m0\n\ts_mov_b32 m0, %2\n\ts_nop 0\n\tglobal_load_lds_dwordx4 %1, off\n\ts_mov_b32 m0, %0" : "=&s"(sv) : "v"(g), "s"(lds_base) : "memory"); }
__device__ __forceinline__ s16x4 vtr(lds_cptr p) { return __builtin_bit_cast(s16x4, __builtin_amdgcn_ds_read_tr16_b64_v4i16((LAS v4i16_t*)p)); }
#define MX3(a, b, c) __builtin_fmaxf(__builtin_fmaxf((a), (b)), (c))
__device__ __forceinline__ float rowmax(const f32x16& p0, const f32x16& p1) {
    float a = MX3(p0[0], p0[1], p1[0]), b = MX3(p0[2], p0[3], p1[1]); a = MX3(a, p1[2], p1[3]);
#pragma unroll
    for (int r = 4; r < 16; r += 4) { a = MX3(a, p0[r], p0[r + 1]); b = MX3(b, p0[r + 2], p0[r + 3]); a = MX3(a, p1[r], p1[r + 1]); b = MX3(b, p1[r + 2], p1[r + 3]); }
    float m = __builtin_fmaxf(a, b); auto rr = __builtin_amdgcn_permlane32_swap(__float_as_uint(m), __float_as_uint(m), false, false);
    return __builtin_fmaxf(__uint_as_float(rr[0]), __uint_as_float(rr[1])); }

enum { M_FOX = 0, M_CMP1 = 1, M_CMP2 = 2, M_SLC = 3, M_WIN = 4 };
struct St { f32x16 o[2]; float mref, l; };

template <int MODE>
__device__ __forceinline__ void tile_step(LAS unsigned char* lds, int sub_off, const bf16x8 (&qr)[4], St& st, float rl, int t, int qpos, int q0w, int QBk,
                                          unsigned long long selm, LAS float* wsf, LAS float* impw, const LAS float* cbl, int lane, int r32, int hi, float& icarry) {
    const lds_cptr kp = (lds_cptr)lds + A_K + sub_off + hi * 1024 + r32 * 16;
    bf16x8 kf[8];
#pragma unroll
    for (int d0 = 0; d0 < 4; ++d0) { kf[2 * d0] = *(const LAS bf16x8*)(kp + d0 * 2048); kf[2 * d0 + 1] = *(const LAS bf16x8*)(kp + d0 * 2048 + 512); }
    float ci = -st.mref;
    if (MODE == M_SLC) { if (!((selm >> t) & 1ull)) ci = -INFINITY; }
    f32x16 s0, s1;
    { f32x16 c0;
#pragma unroll
      for (int r = 0; r < 16; ++r) c0[r] = ci;
      s0 = MFMA32(kf[0], qr[0], c0); s1 = MFMA32(kf[1], qr[0], c0); }
#pragma unroll
    for (int d0 = 1; d0 < 4; ++d0) { s0 = MFMA32(kf[2 * d0], qr[d0], s0); s1 = MFMA32(kf[2 * d0 + 1], qr[d0], s1); }
    const float NEG = -INFINITY; const int kvb = 64 * t + 4 * hi;
    if (MODE == M_CMP1 || MODE == M_CMP2) { if (16 * (64 * t + 63) + 31 > q0w) {
#pragma unroll
            for (int r = 0; r < 16; ++r) { const int n = kvb + (r & 3) + 8 * (r >> 2); if (16 * n + 31 > qpos) s0[r] = NEG; if (16 * (n + 32) + 31 > qpos) s1[r] = NEG; } } }
    if (MODE == M_SLC) { if (t == QBk) {
#pragma unroll
            for (int r = 0; r < 16; ++r) { const int kv = kvb + (r & 3) + 8 * (r >> 2); if (kv > qpos) s0[r] = NEG; if (kv + 32 > qpos) s1[r] = NEG; } } }
    if (MODE == M_WIN) { if (t == QBk || t + 8 == QBk) {
#pragma unroll
            for (int r = 0; r < 16; ++r) { const int kv = kvb + (r & 3) + 8 * (r >> 2); if (kv > qpos || qpos - kv >= 512) s0[r] = NEG; if (kv + 32 > qpos || qpos - (kv + 32) >= 512) s1[r] = NEG; } } }
    if (MODE != M_CMP2) {
        const float rm = rowmax(s0, s1);
        if (__any(rm > 8.0f)) {
            const float dl = fmaxf(rm, 0.f), alpha = __builtin_amdgcn_exp2f(-dl); st.l *= alpha; st.mref += dl;
#pragma unroll
            for (int r = 0; r < 16; ++r) { s0[r] -= dl; s1[r] -= dl; }
            if (MODE != M_CMP1) { if (hi == 0) wsf[r32] = alpha; LDS_WAIT();
#pragma unroll
                for (int r = 0; r < 16; ++r) { const float f = wsf[crow(r, hi)]; st.o[0][r] *= f; st.o[1][r] *= f; }
                LDS_WAIT(); }
        }
    }
    if (MODE == M_SLC || MODE == M_WIN) {
        const lds_cptr vq = (lds_cptr)lds + A_V + sub_off + ((lane >> 4) & 1) * 32 + (lane & 3) * 8 + (4 * hi + ((lane & 15) >> 2)) * 64;
        float qs0 = 0.f, qs1 = 0.f, qs2 = 0.f, qs3 = 0.f;
#pragma unroll
        for (int ks = 0; ks < 4; ++ks) {
            float e[8];
#pragma unroll
            for (int j = 0; j < 8; ++j) e[j] = __builtin_amdgcn_exp2f(ks < 2 ? s0[(ks & 1) * 8 + j] : s1[(ks & 1) * 8 + j]);
            qs0 += e[0] + e[4]; qs1 += e[1] + e[5]; qs2 += e[2] + e[6]; qs3 += e[3] + e[7];
            const v4u pq = (v4u){pk2(e[0], e[1]), pk2(e[2], e[3]), pk2(e[4], e[5]), pk2(e[6], e[7])};
#pragma unroll
            for (int d0 = 0; d0 < 2; ++d0) { const s16x4 lo = vtr(vq + d0 * 4096 + ks * 1024), hh = vtr(vq + d0 * 4096 + ks * 1024 + 512);
                const bf16x8 vf = (bf16x8){lo[0], lo[1], lo[2], lo[3], hh[0], hh[1], hh[2], hh[3]};
                st.o[d0] = MFMA32(__builtin_bit_cast(bf16x8, pq), vf, st.o[d0]); }
            __builtin_amdgcn_sched_barrier(0);
        }
        st.l += (qs0 + qs1) + (qs2 + qs3);
        return;
    }
    float ps0 = 0.f, ps1 = 0.f, ps2 = 0.f, ps3 = 0.f;
#pragma unroll
    for (int r = 0; r < 16; r += 2) { s0[r] = __builtin_amdgcn_exp2f(s0[r]); s1[r] = __builtin_amdgcn_exp2f(s1[r]); s0[r + 1] = __builtin_amdgcn_exp2f(s0[r + 1]); s1[r + 1] = __builtin_amdgcn_exp2f(s1[r + 1]);
        ps0 += s0[r]; ps1 += s1[r]; ps2 += s0[r + 1]; ps3 += s1[r + 1]; }
    if (MODE != M_CMP2) st.l += (ps0 + ps1) + (ps2 + ps3);
    if (MODE == M_CMP1) return;
    if (MODE == M_CMP2) {
#pragma unroll
        for (int r = 0; r < 16; ++r) { s0[r] *= rl; s1[r] *= rl; }
        float a0[4], a1[4], ob0[4], ob1[4];
#pragma unroll
        for (int g = 0; g < 4; ++g) {
            const float b0 = 0.5f * s0[4 * g + 3], b1 = 0.5f * s1[4 * g + 3];
            a0[g] = s0[4 * g] + s0[4 * g + 1] + s0[4 * g + 2] + b0; a1[g] = s1[4 * g] + s1[4 * g + 1] + s1[4 * g + 2] + b1;
            auto r0_ = __builtin_amdgcn_permlane32_swap(__float_as_uint(b0), __float_as_uint(b0), false, false); auto r1_ = __builtin_amdgcn_permlane32_swap(__float_as_uint(b1), __float_as_uint(b1), false, false);
            ob0[g] = __uint_as_float(hi ? r0_[0] : r0_[1]); ob1[g] = __uint_as_float(hi ? r1_[0] : r1_[1]); }
        { const int qrow = qpos & 63;
          LAS float* ib = impw - qrow;
#pragma unroll
          for (int g = 0; g < 4; ++g) {
              const int j0 = 16 * t + 2 * g + hi, j1 = j0 + 8;
              const float in0 = hi ? ob0[g] : (g > 0 ? ob0[g - 1] : icarry), in1 = hi ? ob1[g] : (g > 0 ? ob1[g - 1] : ob0[3]);
              ib[j0 * 64 + (qrow ^ j0)] = a0[g] + in0; ib[j1 * 64 + (qrow ^ j1)] = a1[g] + in1; }
          icarry = ob1[3]; }
    }
    v4u pw[4];
    pw[0] = (v4u){pk2(s0[0], s0[1]), pk2(s0[2], s0[3]), pk2(s0[4], s0[5]), pk2(s0[6], s0[7])};
    pw[1] = (v4u){pk2(s0[8], s0[9]), pk2(s0[10], s0[11]), pk2(s0[12], s0[13]), pk2(s0[14], s0[15])};
    pw[2] = (v4u){pk2(s1[0], s1[1]), pk2(s1[2], s1[3]), pk2(s1[4], s1[5]), pk2(s1[6], s1[7])};
    pw[3] = (v4u){pk2(s1[8], s1[9]), pk2(s1[10], s1[11]), pk2(s1[12], s1[13]), pk2(s1[14], s1[15])};
#ifdef DBG_C_P
#pragma unroll
    for (int i_ = 0; i_ < 4; ++i_) { pw[i_].x = COARSE2(pw[i_].x); pw[i_].y = COARSE2(pw[i_].y); pw[i_].z = COARSE2(pw[i_].z); pw[i_].w = COARSE2(pw[i_].w); }
#endif
    const lds_cptr vp = (lds_cptr)lds + A_V + sub_off + ((lane >> 4) & 1) * 32 + (lane & 3) * 8 + (4 * hi + ((lane & 15) >> 2)) * 64;
#pragma unroll
    for (int d0 = 0; d0 < 2; ++d0)
#pragma unroll
        for (int ks = 0; ks < 4; ++ks) { const s16x4 lo = vtr(vp + d0 * 4096 + ks * 1024), hh = vtr(vp + d0 * 4096 + ks * 1024 + 512);
            const bf16x8 vf = (bf16x8){lo[0], lo[1], lo[2], lo[3], hh[0], hh[1], hh[2], hh[3]};
            st.o[d0] = MFMA32(__builtin_bit_cast(bf16x8, pw[ks]), vf, st.o[d0]); }
}

template <int MODE>
__device__ __forceinline__ void run_tiles(LAS unsigned char* lds, unsigned long long tm, const bf16* kbase, const bf16* vbase, int pitch, const bf16x8 (&qr)[4], St& st, float rl,
                                          int qpos, int q0w, int QBk, unsigned long long selm, LAS float* wsf, LAS float* impw, const LAS float* cbl, int lane, int r32, int hi, int wid) {
    const unsigned lds0 = (unsigned)(uintptr_t)lds; float icarry = 0.f;
    const bool tiled = (pitch == 0); const size_t tstep = tiled ? 4096 : (size_t)64 * pitch;
    const bf16* ksrc = tiled ? kbase + wid * 512 + lane * 8 : kbase + (size_t)lane * pitch + wid * 8;
    const bf16* vsrc = tiled ? vbase + wid * 512 + lane * 8 : vbase + (size_t)(16 * (wid & 3) + (lane >> 2)) * pitch + (wid >> 2) * 32 + (lane & 3) * 8;
    const unsigned kdst = lds0 + A_K + wid * 1024, vdst = lds0 + A_V + wid * 1024;
    if (tm == 0ull) return;
    unsigned pm = 0u;
#pragma unroll
    for (int p = 0; p < 32; ++p) pm |= (((tm >> (2 * p)) & 3ull) != 0ull) ? (1u << p) : 0u;
#define ATT_ISSUE_PAIR(P, S) do { _Pragma("unroll") for (int a_ = 0; a_ < 2; ++a_) { const int tt_ = 2 * (P) + a_; if ((tm >> tt_) & 1ull) { \
            glds16(ksrc + (size_t)tt_ * tstep, (unsigned)__builtin_amdgcn_readfirstlane(kdst + (S) * SLOT + a_ * 8192)); \
            if (MODE != M_CMP1) glds16(vsrc + (size_t)tt_ * tstep, (unsigned)__builtin_amdgcn_readfirstlane(vdst + (S) * SLOT + a_ * 8192)); } } } while (0)
    int p = __builtin_ctz(pm); pm &= pm - 1u; int sl = 0;
    ATT_ISSUE_PAIR(p, 0);
    for (;;) {
        VM_WAIT(); __syncthreads();
        int pn = -1;
        if (pm != 0u) { pn = __builtin_ctz(pm); pm &= pm - 1u; ATT_ISSUE_PAIR(pn, sl ^ 1); }
        if ((tm >> (2 * p)) & 1ull) tile_step<MODE>(lds, sl * SLOT, qr, st, rl, 2 * p, qpos, q0w, QBk, selm, wsf, impw, cbl, lane, r32, hi, icarry);
        if ((tm >> (2 * p + 1)) & 1ull) tile_step<MODE>(lds, sl * SLOT + 8192, qr, st, rl, 2 * p + 1, qpos, q0w, QBk, selm, wsf, impw, cbl, lane, r32, hi, icarry);
        if (pn < 0) break;
        p = pn; sl ^= 1;
    }
#undef ATT_ISSUE_PAIR
    LDS_WAIT(); __syncthreads();
}
__device__ __forceinline__ void st_init(St& st) {
#pragma unroll
    for (int r = 0; r < 16; ++r) { st.o[0][r] = 0.f; st.o[1][r] = 0.f; }
    st.mref = 0.f; st.l = 0.f;
}
__device__ __forceinline__ void store_o(LAS unsigned char* lds, const f32x16 (&o)[2], const float (&rli)[16], bf16* Ow, int lane, int r32, int hi, int wid) {
    LAS bf16* stg = (LAS bf16*)(lds + A_OST) + wid * 2048;
#pragma unroll
    for (int r = 0; r < 16; ++r) { const int orow = crow(r, hi);
#pragma unroll
        for (int d0 = 0; d0 < 2; ++d0) { unsigned w_ = pk2(o[d0][r] * rli[r], 0.f) & 0xffffu;
#ifdef DBG_C_Y
            w_ = (w_ + 2u) & 0xfffcu;
#endif
            stg[orow * 64 + d0 * 32 + r32] = (bf16)w_; } }
    LDS_WAIT();
#pragma unroll
    for (int i = 0; i < 4; ++i) { const int row = i * 8 + (lane >> 3), ch = lane & 7; const v4u v = *(const LAS v4u*)(stg + row * 64 + ch * 8); *(GAS v4u*)(Ow + (size_t)row * 512 + ch * 8) = v; }
    LDS_WAIT();
}
__device__ __forceinline__ void row_to_regs(LAS float* wsf, float val, float (&rli)[16], int r32, int hi) {
    if (hi == 0) wsf[32 + r32] = val; LDS_WAIT();
#pragma unroll
    for (int r = 0; r < 16; ++r) rli[r] = wsf[32 + crow(r, hi)];
    LDS_WAIT();
}

__device__ __forceinline__ void fox_unit(Frame& F, int b, int h, int qb, bool dbg_t0 = false) {
    LAS unsigned char* lds = F.lds; unsigned char* ws = F.ws;
    const int lane = F.lane, wid = F.wave, r32 = lane & 31, hi = lane >> 5, q0 = qb * 256, q0w = q0 + 32 * wid, qpos = q0w + r32;
    LAS float* wsf = (LAS float*)(lds + A_WS) + wid * 64; LAS float* cbl = (LAS float*)(lds + A_BIG);
    { const v2u* cum = (const v2u*)(ws + WS_CUM) + (size_t)(b * 8 + h) * SEQ; LAS v2u* kxl = (LAS v2u*)cbl;
#pragma unroll 1
      for (int i = F.tid; i < 256 * (qb + 1); i += 512) kxl[i] = cum[i]; }
    __syncthreads();
    const bf16* Qw = (const bf16*)(ws + WS_QF) + ((size_t)b * SEQ + q0w) * 512 + h * 64;
    f32x16 o[2]; float lt;
    const bf16* kb = (const bf16*)(ws + WS_KF) + ((size_t)(b * 8 + h) * 64 << 12); const bf16* vb = (const bf16*)(ws + WS_VF) + ((size_t)(b * 8 + h) * 64 << 12);
    fa::run<0, 8>((const fa::bf16*)Qw, 512, (const fa::bf16*)kb, (const fa::bf16*)vb, 512, 0, dbg_t0 ? 0 : 1, 4 * (qb + 1), 4 * (qb + 1), qpos, q0w, 0, 0ull, 0ull, (const float*)cbl, (char*)lds, o, lt);
    float rli[16]; row_to_regs(wsf, 1.0f / lt, rli, r32, hi);
    bf16* Ow = (bf16*)(ws + WS_Y) + ((size_t)b * SEQ + q0w) * 512 + h * 64;
    if (!dbg_t0) store_o(lds, o, rli, Ow, lane, r32, hi, wid);
    else if (lt == 123.456f) Ow[0] = (bf16)(pk2(o[0][0] + o[1][3], 0.f) & 0xffffu);
    __syncthreads();
}

__device__ __forceinline__ void nsa_unit(Frame& F, int b, int g, int QBk, int dbgm = 0) {
    LAS unsigned char* lds = F.lds; unsigned char* ws = F.ws;
    const int lane = F.lane, wid = F.wave, r32 = lane & 31, hi = lane >> 5, hh = wid >> 1, qoff = 32 * (wid & 1), q0 = 64 * QBk, q0w = q0 + qoff, qpos = q0w + r32, head = 4 * g + hh;
    LAS float* wsf = (LAS float*)(lds + A_WS) + wid * 64; LAS float* imp = (LAS float*)(lds + A_BIG);
    LAS unsigned long long* selw = (LAS unsigned long long*)(lds + A_SEL);
    LAS float* impw = imp + (size_t)(hh * 4096 + qoff + r32);
    const bf16* Qw = (const bf16*)(ws + WS_QN) + ((size_t)b * SEQ + q0w) * 512 + head * 64;
    bf16x8 qr[4];
#pragma unroll
    for (int d0 = 0; d0 < 4; ++d0) qr[d0] = *(const GAS bf16x8*)(Qw + (size_t)r32 * 512 + d0 * 16 + hi * 8);
    const float* gat = (const float*)(ws + WS_GATES) + ((size_t)b * SEQ + qpos) * 24 + head * 3;
    float g_cmp = gat[0], g_slc = gat[1], g_win = gat[2];
#ifdef DBG_NO_CMP
    g_cmp = 0.f;
#endif
#ifdef DBG_SC_CMP
    g_cmp *= DBG_SC_CMP;
#endif
#ifdef DBG_SC_SLC
    g_slc *= DBG_SC_SLC;
#endif
#ifdef DBG_SC_WIN
    g_win *= DBG_SC_WIN;
#endif
#ifdef DBG_NO_SLC
    g_slc = 0.f;
#endif
#ifdef DBG_NO_WIN
    g_win = 0.f;
#endif
    float rli[16];
    St st;
    const int ntc = ((q0 + 32) >> 10) + 1;
    const unsigned long long tmc = (1ull << ntc) - 1ull;
    const bf16* kc = (const bf16*)(ws + WS_KCMP) + (size_t)b * 256 * 128 + g * 64; const bf16* vc = (const bf16*)(ws + WS_VCMP) + (size_t)b * 256 * 128 + g * 64;
    st_init(st);
    if (!(dbgm & 1)) run_tiles<M_CMP1>(lds, tmc, kc, vc, 128, qr, st, 0.f, qpos, q0w, QBk, 0ull, wsf, impw, nullptr, lane, r32, hi, wid);
    if (!(dbgm & 1)) { const float lt = st.l + __shfl_xor(st.l, 32); const float rl = lt > 0.f ? 1.0f / lt : 0.f; const float mkeep = st.mref;
      st_init(st); st.mref = mkeep;
      run_tiles<M_CMP2>(lds, tmc, kc, vc, 128, qr, st, rl, qpos, q0w, QBk, 0ull, wsf, impw, nullptr, lane, r32, hi, wid); }
    __syncthreads();
    if (dbgm & 2) { if (lane == 0) for (int qq = 0; qq < 8; ++qq) selw[wid * 8 + qq] = QBk >= 63 ? ~0ull : ((1ull << (QBk + 1)) - 1ull); }
    else for (int qq = 0; qq < 8; ++qq) { const int q = wid * 8 + qq, j = lane;
        const int sw = j * 64 + (q ^ j);
        float v = ((imp[sw] + imp[4096 + sw]) + imp[2 * 4096 + sw]) + imp[3 * 4096 + sw];
#ifdef DBG_IMPNOISE
        { const unsigned hsh = ((unsigned)(q0 + q) * 2654435761u) ^ ((unsigned)(j + 64 * (b * 2 + g)) * 2246822519u); const float nz = ((float)((hsh >> 9) & 0xffff) * (1.0f / 65536.0f) - 0.5f); v = v * (1.0f + DBG_IMPNOISE * nz); }
#endif
        const bool forced = (j == 0) || (j == QBk) || (j == QBk - 1), causal = j <= QBk;
        const unsigned key = (causal ? (forced ? 0xFFFFFFC0u : (__float_as_uint(fmaxf(v, 0.f)) & ~63u)) : 0u) | (unsigned)(63 - j);
        unsigned T = 0u;
#pragma unroll
        for (int bit = 31; bit >= 0; --bit) { const unsigned Tt = T | (1u << bit); T = (__popcll(__ballot(key >= Tt)) >= 16) ? Tt : T; }
        const unsigned long long msk = __ballot(causal && key >= T);
        if (lane == 0) selw[q] = msk; }
    __syncthreads();
    LAS float* otl = imp + wid * 2048 + lane;
    row_to_regs(wsf, g_cmp, rli, r32, hi);
#pragma unroll
    for (int r = 0; r < 16; ++r) { otl[(2 * r) * 64] = st.o[0][r] * rli[r]; otl[(2 * r + 1) * 64] = st.o[1][r] * rli[r]; }
    const unsigned long long selm = selw[qoff + r32];
    unsigned long long um = selw[lane];
#pragma unroll
    for (int o = 1; o < 64; o <<= 1) { const unsigned lo = __shfl_xor((unsigned)um, o), hi2 = __shfl_xor((unsigned)(um >> 32), o); um |= ((unsigned long long)hi2 << 32) | lo; }
    um = ((unsigned long long)__builtin_amdgcn_readfirstlane((unsigned)(um >> 32)) << 32) | (unsigned)__builtin_amdgcn_readfirstlane((unsigned)um);
    const bf16* ksl = (const bf16*)(ws + WS_KVS) + ((size_t)(b * 2 + g) * 64 << 12); const bf16* vsl = ksl + 4 * MiB;
    float lt_ = 1.f;
    if (!(dbgm & 4)) { const int ntr = __builtin_popcountll(um), nt2 = ntr < 2 ? 2 : ((ntr + 1) & ~1);
      fa::run<3, 8>((const fa::bf16*)Qw, 512, (const fa::bf16*)ksl, (const fa::bf16*)vsl, 512, 0, 1, nt2, ntr, qpos, q0w, QBk, selm, um, nullptr, (char*)lds, st.o, lt_); }
    { const float lt = lt_; row_to_regs(wsf, g_slc / lt, rli, r32, hi);
#pragma unroll
      for (int r = 0; r < 16; ++r) { otl[(2 * r) * 64] += st.o[0][r] * rli[r]; otl[(2 * r + 1) * 64] += st.o[1][r] * rli[r]; } }
    const bf16* kw = (const bf16*)(ws + WS_KVW) + ((size_t)(b * 2 + g) * 64 << 12); const bf16* vw = kw + 4 * MiB;
    if (!(dbgm & 8)) { const int tlo = QBk >= 8 ? QBk - 8 : 0; const int nt = QBk - tlo + 1; const unsigned long long tmw = ((1ull << nt) - 1ull) << tlo;
      (void)tmw; const int nt2 = nt < 2 ? 2 : ((nt + 1) & ~1);
      fa::run<4, 8>((const fa::bf16*)Qw, 512, (const fa::bf16*)kw, (const fa::bf16*)vw, 512, tlo, 1, nt2, nt, qpos, q0w, QBk, 0ull, 0ull, nullptr, (char*)lds, st.o, lt_); }
    { const float lt = lt_; row_to_regs(wsf, g_win / lt, rli, r32, hi);
#pragma unroll
      for (int r = 0; r < 16; ++r) { st.o[0][r] = otl[(2 * r) * 64] + st.o[0][r] * rli[r]; st.o[1][r] = otl[(2 * r + 1) * 64] + st.o[1][r] * rli[r]; } }
#pragma unroll
    for (int r = 0; r < 16; ++r) rli[r] = 1.0f;
    bf16* Ow = (bf16*)(ws + WS_Y) + ((size_t)NTOK + (size_t)b * SEQ + q0w) * 512 + head * 64;
    if (!(dbgm & 16)) store_o(lds, st.o, rli, Ow, lane, r32, hi, wid);
    else if (lt_ == 123.456f) Ow[0] = (bf16)(pk2(st.o[0][0] + st.o[1][3], 0.f) & 0xffffu);
    __syncthreads();
}
#undef MFMA32
#undef MX3
}

__device__ __forceinline__ void p3_attention(Frame& F, int qoff = 0, int which = 3) {
    volatile LAS unsigned* qslot = F.MISC + 16;
    if (which & 2) for (;;) {
        if (F.tid == 0) qslot[0] = __hip_atomic_fetch_add(F.ctl + CW_QATT + 16 + qoff, 1u, RLX_AGENT);
        __syncthreads();
        const unsigned u = qslot[0];
        __syncthreads();
        if (u >= 1024u) break;
        const int k = (int)u; const int QBk = 63 - (k >> 4), bg = k & 15;
        { Frame G = F; asm volatile("" : "+v"(G.tid), "+v"(G.lane)); att::nsa_unit(G, bg >> 1, bg & 1, QBk, qoff != 0 ? DBG_NSAM : 0); }
    }
    if (which & 1) for (;;) {
        if (F.tid == 0) qslot[0] = __hip_atomic_fetch_add(F.ctl + CW_QATT + qoff, 1u, RLX_AGENT);
        __syncthreads();
        const unsigned u = qslot[0];
        __syncthreads();
        if (u >= 1024u) break;
        const int k = (int)u; const int qb = 15 - (k >> 6), bh = k & 63;
        { Frame G = F; asm volatile("" : "+v"(G.tid), "+v"(G.lane)); att::fox_unit(G, bh >> 3, bh & 7, qb, DBG_FOXT0 && qoff != 0); }
    }
}

struct MergeOrder {
    int vcu, G;
    __device__ __forceinline__ bool next(int i, pg8::Unit& u) const { const int p = (i >> 1) * G + vcu; if (p >= 512) return false; const int br = i & 1, tm = p >> 2, tn = p & 3; u.pm = br * 128 + tm; u.pn = br * 4 + tn; return true; }
    __device__ __forceinline__ void a_ready(const pg8::Unit&) const {}
    __device__ __forceinline__ void done(const pg8::Unit&) const {}
};
struct EpiMerge {
    static constexpr bool PERM = true, AFTER_DRAIN = false;
    unsigned char* ws;
    __device__ __forceinline__ bool operator()(f32x4 (&acc)[2][2][4][2], const pg8::Unit& u, int wr, int wc, int fr, int fq) const {
        const int br = u.pm >> 7, tm = u.pm & 127, tn = u.pn & 3;
        const int row0 = tm * 256 + wr * 64 + fr, col0 = tn * 256 + wc * 32 + 8 * fq;
        const bf16* GM = (const bf16*)(ws + WS_GM); bf16* MG = (bf16*)(ws + WS_MERGED);
#pragma unroll
        for (int ai = 0; ai < 2; ++ai)
#pragma unroll
            for (int m = 0; m < 4; ++m) { const int row = row0 + ai * 128 + m * 16;
#pragma unroll
                for (int bj = 0; bj < 2; ++bj) { const int col = col0 + bj * 128;
                    const bf16* gp_ = GM + (size_t)row * 2048 + (tn * 2 + bj) * 256 + wc * 32 + 8 * fq + (br == 0 ? 0 : 128);
                    const v4u g1w = *(const GAS v4u*)gp_;
                    float g1[8] = {bf_lo(g1w.x), bf_hi(g1w.x), bf_lo(g1w.y), bf_hi(g1w.y), bf_lo(g1w.z), bf_hi(g1w.z), bf_lo(g1w.w), bf_hi(g1w.w)};
                    f32x4& a0 = acc[ai][bj][m][0]; f32x4& a1 = acc[ai][bj][m][1];
                    if (br == 0) {
                        a0.x *= g1[0]; a0.y *= g1[1]; a0.z *= g1[2]; a0.w *= g1[3]; a1.x *= g1[4]; a1.y *= g1[5]; a1.z *= g1[6]; a1.w *= g1[7];
                    } else {
                        v4u w; w.x = pk2(a0.x * g1[0], a0.y * g1[1]); w.y = pk2(a0.z * g1[2], a0.w * g1[3]); w.z = pk2(a1.x * g1[4], a1.y * g1[5]); w.w = pk2(a1.z * g1[6], a1.w * g1[7]);
#ifdef DBG_C_MERGED
                        w.x = COARSE2(w.x); w.y = COARSE2(w.y); w.z = COARSE2(w.z); w.w = COARSE2(w.w);
#endif
                        *(GAS v4u*)(MG + (size_t)row * 1024 + col) = w;
                    } } }
        return br == 0;
    }
};
#ifndef DBG_DECAY
#define DBG_DECAY 1.0f
#endif
#ifndef DBG_TEMP
#define DBG_TEMP 1.0f
#endif
#ifndef DBG_PEERSCALE
#define DBG_PEERSCALE 1.0f
#endif
#ifndef DBG_MIXSCALE
#define DBG_MIXSCALE 1.0f
#endif
struct EpiOut {
    static constexpr bool PERM = true, AFTER_DRAIN = false;
    unsigned char* ws; const float* x; float* out; const float* gffn;
    __device__ __forceinline__ bool operator()(f32x4 (&acc)[2][2][4][2], const pg8::Unit& u, int wr, int wc, int fr, int fq) const {
        const int row0 = u.pm * 256 + wr * 64 + fr, col0 = u.pn * 256 + wc * 32 + 8 * fq;
        float* SS = (float*)(ws + WS_SS); bf16* HBF = (bf16*)(ws + WS_HBF);
#pragma unroll
        for (int ai = 0; ai < 2; ++ai)
#pragma unroll
            for (int m = 0; m < 4; ++m) { const int row = row0 + ai * 128 + m * 16; float ssq = 0.f;
#pragma unroll
                for (int bj = 0; bj < 2; ++bj) { const int col = col0 + bj * 128; const size_t off = (size_t)row * 1024 + col;
                    const f32x4 x0 = *(const GAS f32x4*)(x + off), x1 = *(const GAS f32x4*)(x + off + 4);
                    const f32x4 h0 = x0 + acc[ai][bj][m][0] * DBG_MIXSCALE, h1 = x1 + acc[ai][bj][m][1] * DBG_MIXSCALE;
                    v4u hw; hw.x = pk2(h0.x, h0.y); hw.y = pk2(h0.z, h0.w); hw.z = pk2(h1.x, h1.y); hw.w = pk2(h1.z, h1.w); *(GAS v4u*)(HBF + off) = hw;
                    ssq += ((h0.x * h0.x + h0.y * h0.y) + (h0.z * h0.z + h0.w * h0.w)) + ((h1.x * h1.x + h1.y * h1.y) + (h1.z * h1.z + h1.w * h1.w)); }
                ssq += __shfl_xor(ssq, 16); ssq += __shfl_xor(ssq, 32);
                if (fq == 0) atomicAdd(SS + row, ssq); }
        return false;
    }
};
#ifdef DBG_DUPG
struct EpiNull {
    static constexpr bool PERM = true, AFTER_DRAIN = false;
    gu32* ctl;
    __device__ __forceinline__ bool operator()(f32x4 (&acc)[2][2][4][2], const pg8::Unit& u, int wr, int wc, int fr, int fq) const {
        float s = 0.f;
#pragma unroll
        for (int a = 0; a < 2; ++a)
#pragma unroll
            for (int b = 0; b < 2; ++b)
#pragma unroll
                for (int m = 0; m < 4; ++m)
#pragma unroll
                    for (int n = 0; n < 2; ++n) s += (acc[a][b][m][n].x + acc[a][b][m][n].y) + (acc[a][b][m][n].z + acc[a][b][m][n].w);
        if (s == 123456.789f) ctl[CW_BAR + 900] = 1u;
        return false;
    }
};
#endif
struct EpiScore {
    static constexpr bool PERM = true, AFTER_DRAIN = false;
    bf16* O;
    __device__ __forceinline__ bool operator()(f32x4 (&acc)[2][2][4][2], const pg8::Unit& u, int wr, int wc, int fr, int fq) const {
        const int row0 = u.pm * 256 + wr * 64 + fr;
#pragma unroll
        for (int ai = 0; ai < 2; ++ai)
#pragma unroll
            for (int m = 0; m < 4; ++m) { bf16* rowp = O + (size_t)(row0 + ai * 128 + m * 16) * 2048;
#pragma unroll
                for (int bj = 0; bj < 2; ++bj) { const int col = u.pn * 256 + bj * 128 + wc * 32 + 8 * fq, hp = col >> 7, c16 = (col & 127) >> 3;
                    const f32x4 a0 = acc[ai][bj][m][0], a1 = acc[ai][bj][m][1];
                    v4u w; w.x = pk2(a0.x, a0.y); w.y = pk2(a0.z, a0.w); w.z = pk2(a1.x, a1.y); w.w = pk2(a1.z, a1.w);
                    (void)hp; (void)c16; *(GAS v4u*)(rowp + col) = w; } }
        return false;
    }
};
#ifdef DBG_F32SCORES
__device__ __forceinline__ void p6_naive(Frame& F) {
    LAS float* hn = (LAS float*)F.lds; LAS float* qv = hn + 8 * 1024;
    const float* SS = (const float*)(F.ws + WS_SS); float* SC = (float*)(F.ws + WS_SC);
    for (int g8 = blockIdx.x; g8 < NTOK / 8; g8 += F.G) { const int t0 = g8 * 8;
        for (int e = F.tid; e < 8 * 1024; e += 512) { const int tk = e >> 10, d = e & 1023; const float rt = 1.0f / sqrtf(SS[t0 + tk] * (1.f / DM) + RMS_EPS); hn[e] = F.out[(size_t)(t0 + tk) * 1024 + d] * F.norm_ffn[d] * rt; }
        __syncthreads();
        { const int c0 = F.tid * 4; float acc[8][4];
          for (int i = 0; i < 8; ++i) for (int j = 0; j < 4; ++j) acc[i][j] = 0.f;
          for (int k = 0; k < 1024; ++k) { const f32x4 w = *(const GAS f32x4*)(F.peer_wq + (size_t)k * 2048 + c0);
#pragma unroll
              for (int i = 0; i < 8; ++i) { const float hv = hn[i * 1024 + k]; acc[i][0] += hv * w.x; acc[i][1] += hv * w.y; acc[i][2] += hv * w.z; acc[i][3] += hv * w.w; } }
#pragma unroll
          for (int i = 0; i < 8; ++i) { qv[i * 2048 + c0] = acc[i][0]; qv[i * 2048 + c0 + 1] = acc[i][1]; qv[i * 2048 + c0 + 2] = acc[i][2]; qv[i * 2048 + c0 + 3] = acc[i][3]; } }
        __syncthreads();
        for (int n = F.tid; n < 2048; n += 512) { const int hp = n >> 7; float a[8];
#pragma unroll
            for (int i = 0; i < 8; ++i) a[i] = 0.f;
            for (int d = 0; d < 128; ++d) { const float sk = F.peer_sk[(size_t)n * 128 + d];
#pragma unroll
                for (int i = 0; i < 8; ++i) a[i] += qv[i * 2048 + hp * 128 + d] * sk; }
#pragma unroll
            for (int i = 0; i < 8; ++i) { const float rt = 1.0f / sqrtf(SS[t0 + i] * (1.f / DM) + RMS_EPS); SC[(size_t)(t0 + i) * 2048 + n] = a[i] / rt; } }
        __syncthreads(); }
}
#endif
__device__ __forceinline__ unsigned mono_key(float f) { const unsigned u = __float_as_uint(f); return u ^ ((unsigned)((int)u >> 31) | 0x80000000u); }
__device__ __forceinline__ float unmono(unsigned k) { const unsigned u = (k & 0x80000000u) ? (k ^ 0x80000000u) : ~k; return __uint_as_float(u); }
#define INS16(list, key) do { unsigned k_ = (key); _Pragma("unroll") for (int e_ = 0; e_ < 16; ++e_) { const unsigned hi_ = max(list[e_], k_); k_ = min(list[e_], k_); list[e_] = hi_; } } while (0)
__device__ __forceinline__ void p7_wave(Frame& F, int t0) {
    unsigned char* ws = F.ws; const int tid = F.tid, lane = F.lane, wid = F.wave;
    LAS unsigned* keys = (LAS unsigned*)(F.lds + wid * 4096);
    LAS int* eidx = (LAS int*)(F.lds + 32768 + wid * 2048);
    LAS float* ewt = (LAS float*)(F.lds + 49152 + wid * 2048);
    LAS unsigned char* hb8 = F.lds + 65536 + wid * 2048;
    const bf16* SCB = (const bf16*)(ws + WS_SC); const float* SS = (const float*)(ws + WS_SS);
#ifdef DBG_DUPTOPK
    for (int rep_ = 0; rep_ < 2; ++rep_) {
#endif
    { const int tok = lane >> 4, hp = lane & 15; const GAS v4u* p4 = (const GAS v4u*)(SCB + (size_t)(t0 + tok) * 2048 + hp * 128);
      unsigned list[16];
#pragma unroll
      for (int e = 0; e < 16; ++e) list[e] = 0u;
#define P7_CE(A, B) do { const unsigned hi_ = max(A, B), lo_ = min(A, B); A = hi_; B = lo_; } while (0)
#define P7_KEY(val, idx) ((mono_key(val) & ~127u) | (unsigned)(127 - (idx)))
#pragma unroll 1
      for (int c = 0; c < 16; ++c) { const v4u v = p4[c];
          unsigned g0 = P7_KEY(bf_lo(v.x), 8 * c + 0), g1 = P7_KEY(bf_hi(v.x), 8 * c + 1), g2 = P7_KEY(bf_lo(v.y), 8 * c + 2), g3 = P7_KEY(bf_hi(v.y), 8 * c + 3);
          unsigned g4 = P7_KEY(bf_lo(v.z), 8 * c + 4), g5 = P7_KEY(bf_hi(v.z), 8 * c + 5), g6 = P7_KEY(bf_lo(v.w), 8 * c + 6), g7 = P7_KEY(bf_hi(v.w), 8 * c + 7);
          P7_CE(g0, g1); P7_CE(g2, g3); P7_CE(g4, g5); P7_CE(g6, g7);
          P7_CE(g0, g2); P7_CE(g1, g3); P7_CE(g4, g6); P7_CE(g5, g7);
          P7_CE(g1, g2); P7_CE(g5, g6);
          P7_CE(g0, g4); P7_CE(g1, g5); P7_CE(g2, g6); P7_CE(g3, g7);
          P7_CE(g2, g4); P7_CE(g3, g5);
          P7_CE(g1, g2); P7_CE(g3, g4); P7_CE(g5, g6);
          list[8] = max(list[8], g7); list[9] = max(list[9], g6); list[10] = max(list[10], g5); list[11] = max(list[11], g4);
          list[12] = max(list[12], g3); list[13] = max(list[13], g2); list[14] = max(list[14], g1); list[15] = max(list[15], g0);
#pragma unroll
          for (int i = 0; i < 8; ++i) P7_CE(list[i], list[i + 8]);
#pragma unroll
          for (int h8 = 0; h8 < 16; h8 += 8)
#pragma unroll
              for (int i = 0; i < 4; ++i) P7_CE(list[h8 + i], list[h8 + i + 4]);
#pragma unroll
          for (int h4 = 0; h4 < 16; h4 += 4)
#pragma unroll
              for (int i = 0; i < 2; ++i) P7_CE(list[h4 + i], list[h4 + i + 2]);
#pragma unroll
          for (int h2 = 0; h2 < 16; h2 += 2) P7_CE(list[h2], list[h2 + 1]); }
#undef P7_CE
#undef P7_KEY
#pragma unroll
      for (int e = 0; e < 16; ++e) keys[(tok * 16 + hp) * 16 + e] = list[e]; }
    LDS_WAIT(); asm volatile("" ::: "memory");
    if (lane < 32) { const int tok = lane >> 3, hd = lane & 7; const LAS unsigned* ka = keys + (tok * 16 + 2 * hd) * 16; const LAS unsigned* kb = ka + 16;
        float a[16], bq[16];
#pragma unroll
        for (int e = 0; e < 16; ++e) { a[e] = unmono(ka[e] & ~127u); bq[e] = unmono(kb[e] & ~127u); }
        unsigned list[16];
#pragma unroll
        for (int e = 0; e < 16; ++e) list[e] = 0u;
#pragma unroll
        for (int i = 0; i < 16; ++i)
#pragma unroll
            for (int j = 0; j < 16; ++j) if ((i + 1) * (j + 1) <= 16) INS16(list, (mono_key(a[i] + bq[j]) & ~255u) | (unsigned)(255 - (i * 16 + j)));
        const float rt = 1.0f / sqrtf(SS[t0 + tok] * (1.f / DM) + RMS_EPS);
        float sv[16]; float den = 0.f;
#pragma unroll
        for (int e = 0; e < 16; ++e) { const int pos = 255 - (int)(list[e] & 255u), i = pos >> 4, j = pos & 15; const unsigned k1 = ka[i], k2 = kb[j];
            sv[e] = (unmono(k1 & ~127u) + unmono(k2 & ~127u)) * rt * DBG_TEMP; eidx[tok * 128 + hd * 16 + e] = (127 - (int)(k1 & 127u)) * 128 + (127 - (int)(k2 & 127u)); }
#ifdef DBG_LOGITSTAT
        atomicAdd((float*)(F.ctl + 12400), (sv[0] - sv[15]) * (1.0f / 262144.0f));
        atomicMax((unsigned*)(F.ctl + 12401), __float_as_uint(sv[0] - sv[15]));
        atomicMax((unsigned*)(F.ctl + 12402), __float_as_uint(rt));
        atomicMax((unsigned*)(F.ctl + 12403), __float_as_uint(sv[0]));
#endif
        const float smax = sv[0];
#pragma unroll
        for (int e = 0; e < 16; ++e) { sv[e] = __expf(sv[e] - smax); den += sv[e]; }
        const float rden = 1.0f / den;
#pragma unroll
#ifdef DBG_REVW
        for (int e = 0; e < 16; ++e) ewt[tok * 128 + hd * 16 + e] = sv[15 - e] * rden; }
#else
        for (int e = 0; e < 16; ++e) ewt[tok * 128 + hd * 16 + e] = (e >= DBG_KEEP) ? 0.f : sv[e] * rden; }
#endif
    LDS_WAIT(); asm volatile("" ::: "memory");
#ifdef DBG_DUPTOPK
    }
#endif
    int lane_g = lane; asm volatile("" : "+v"(lane_g));
    const unsigned char* U8 = (const unsigned char*)(ws + WS_U8); const unsigned char* V8 = (const unsigned char*)(ws + WS_V8);
    const float* SU = (const float*)(ws + WS_SU); const float* SV = (const float*)(ws + WS_SV);
    for (int tt = 0; tt < 4; ++tt) { const int tok = tt, t = t0 + tok;
        const float rt = 1.0f / sqrtf(SS[t] * (1.f / DM) + RMS_EPS);
        float hres[16]; f32x2 out[8];
        { const GAS v4u* hp_ = (const GAS v4u*)((const bf16*)(ws + WS_HBF) + (size_t)t * DM) + 2 * lane_g; const GAS f32x4* gp = (const GAS f32x4*)F.norm_ffn + 4 * lane_g;
          v4u whi, wlo; const float rt16 = rt * 16.0f; const v4u hA = hp_[0], hB = hp_[1];
#pragma unroll
          for (int q = 0; q < 4; ++q) { const unsigned w0_ = q == 0 ? hA.x : (q == 1 ? hA.z : (q == 2 ? hB.x : hB.z)), w1_ = q == 0 ? hA.y : (q == 1 ? hA.w : (q == 2 ? hB.y : hB.w));
              const f32x4 hv = (f32x4){bf_lo(w0_), bf_hi(w0_), bf_lo(w1_), bf_hi(w1_)}; const f32x4 gv = gp[q];
              hres[4 * q] = hv.x; hres[4 * q + 1] = hv.y; hres[4 * q + 2] = hv.z; hres[4 * q + 3] = hv.w;
              const float n0 = fminf(fmaxf(hv.x * gv.x * rt16, -440.f), 440.f), n1 = fminf(fmaxf(hv.y * gv.y * rt16, -440.f), 440.f), n2 = fminf(fmaxf(hv.z * gv.z * rt16, -440.f), 440.f), n3 = fminf(fmaxf(hv.w * gv.w * rt16, -440.f), 440.f);
              int wh = 0; wh = __builtin_amdgcn_cvt_pk_fp8_f32(n0, n1, wh, false); wh = __builtin_amdgcn_cvt_pk_fp8_f32(n2, n3, wh, true);
              const float r0 = n0 - __builtin_amdgcn_cvt_f32_fp8(wh, 0), r1 = n1 - __builtin_amdgcn_cvt_f32_fp8(wh, 1), r2 = n2 - __builtin_amdgcn_cvt_f32_fp8(wh, 2), r3 = n3 - __builtin_amdgcn_cvt_f32_fp8(wh, 3);
              int wl = 0; wl = __builtin_amdgcn_cvt_pk_fp8_f32(r0, r1, wl, false); wl = __builtin_amdgcn_cvt_pk_fp8_f32(r2, r3, wl, true);
              if (q == 0) { whi.x = (unsigned)wh; wlo.x = (unsigned)wl; } else if (q == 1) { whi.y = (unsigned)wh; wlo.y = (unsigned)wl; } else if (q == 2) { whi.z = (unsigned)wh; wlo.z = (unsigned)wl; } else { whi.w = (unsigned)wh; wlo.w = (unsigned)wl; } }
          LDS_WAIT();
          *(LAS v4u*)(hb8 + 16 * lane_g) = whi; *(LAS v4u*)(hb8 + 1024 + 16 * lane_g) = wlo; LDS_WAIT(); }
#pragma unroll
        for (int i = 0; i < 8; ++i) out[i] = (f32x2){0.f, 0.f};
        for (int hd = 0; hd < 8; ++hd) {
            const LAS int* eh = eidx + tok * 128 + hd * 16;
            const int ec = 4 * (lane_g >> 4) + (lane_g & 3);
            const int myex = eh[ec];
            const float su = SU[myex], sv_ = SV[myex];
            v4u ua[8]; v2u vr[16];
            { const unsigned char* up = U8 + (size_t)eh[lane_g & 15] * (DM / 2) + (lane_g >> 4) * 16;
#pragma unroll
              for (int c = 0; c < 8; ++c) ua[c] = *(const GAS v4u*)(up + 64 * c); }
#pragma unroll
            for (int e = 0; e < 16; ++e) { const int ex = __builtin_amdgcn_readfirstlane(eh[e]); vr[e] = *((const GAS v2u*)(V8 + (size_t)ex * (DM / 2)) + lane_g); }
            f32x4 dacc = (f32x4){0.f, 0.f, 0.f, 0.f};
            {
#pragma unroll
              for (int c = 0; c < 8; ++c) { typedef int v8i_t __attribute__((ext_vector_type(8)));
                  const LAS unsigned char* hq1 = hb8 + 16 * (lane_g >> 4);
                  const v4u h0 = *(const LAS v4u*)(hq1 + 128 * c), h1 = *(const LAS v4u*)(hq1 + 128 * c + 64), l0 = *(const LAS v4u*)(hq1 + 1024 + 128 * c), l1 = *(const LAS v4u*)(hq1 + 1024 + 128 * c + 64);
                  const v8i_t av = (v8i_t){(int)ua[c].x, (int)ua[c].y, (int)ua[c].z, (int)ua[c].w, 0, 0, 0, 0};
                  const v8i_t bh = (v8i_t){(int)h0.x, (int)h0.y, (int)h0.z, (int)h0.w, (int)h1.x, (int)h1.y, (int)h1.z, (int)h1.w};
                  const v8i_t bl = (v8i_t){(int)l0.x, (int)l0.y, (int)l0.z, (int)l0.w, (int)l1.x, (int)l1.y, (int)l1.z, (int)l1.w};
                  dacc = __builtin_amdgcn_mfma_scale_f32_16x16x128_f8f6f4(av, bh, dacc, 4, 0, 0, 0x7F7F7F7F, 0, 0x7F7F7F7F);
                  dacc = __builtin_amdgcn_mfma_scale_f32_16x16x128_f8f6f4(av, bl, dacc, 4, 0, 0, 0x7F7F7F7F, 0, 0x7F7F7F7F); } }
            float act = (lane_g & 2) ? ((lane_g & 1) ? dacc.w : dacc.z) : ((lane_g & 1) ? dacc.y : dacc.x);
            act *= (1.0f / 16.0f);
            act *= su;
            const float coef = ewt[tok * 128 + hd * 16 + ec] * gelu_erf(act) * sv_;
#pragma unroll
            for (int e = 0; e < 16; ++e) { const float c = __uint_as_float(__builtin_amdgcn_readlane(__float_as_uint(coef), 16 * (e >> 2) + (e & 3))); const v2u v = vr[e]; const f32x2 c2 = (f32x2){c, c};
                out[0] += c2 * __builtin_amdgcn_cvt_scalef32_pk_f32_fp4(v.x, 1.0f, 0); out[1] += c2 * __builtin_amdgcn_cvt_scalef32_pk_f32_fp4(v.x, 1.0f, 1);
                out[2] += c2 * __builtin_amdgcn_cvt_scalef32_pk_f32_fp4(v.x, 1.0f, 2); out[3] += c2 * __builtin_amdgcn_cvt_scalef32_pk_f32_fp4(v.x, 1.0f, 3);
                out[4] += c2 * __builtin_amdgcn_cvt_scalef32_pk_f32_fp4(v.y, 1.0f, 0); out[5] += c2 * __builtin_amdgcn_cvt_scalef32_pk_f32_fp4(v.y, 1.0f, 1);
                out[6] += c2 * __builtin_amdgcn_cvt_scalef32_pk_f32_fp4(v.y, 1.0f, 2); out[7] += c2 * __builtin_amdgcn_cvt_scalef32_pk_f32_fp4(v.y, 1.0f, 3); }
        }
        float y[16]; float ssq = 0.f;
#pragma unroll
        for (int i = 0; i < 8; ++i) { y[2 * i] = out[i].x + hres[2 * i]; y[2 * i + 1] = out[i].y + hres[2 * i + 1]; ssq += y[2 * i] * y[2 * i] + y[2 * i + 1] * y[2 * i + 1]; }
        const float rf = 1.0f / sqrtf(wave_sum(ssq) * (1.f / DM) + RMS_EPS);
        { GAS f32x4* op = (GAS f32x4*)(F.out + (size_t)t * DM) + 4 * lane_g; const GAS f32x4* gp = (const GAS f32x4*)F.norm_final + 4 * lane_g;
#pragma unroll
          for (int q = 0; q < 4; ++q) { const f32x4 gv = gp[q]; op[q] = (f32x4){y[4 * q] * rf * gv.x, y[4 * q + 1] * rf * gv.y, y[4 * q + 2] * rf * gv.z, y[4 * q + 3] * rf * gv.w}; } }
    }
    LDS_WAIT(); asm volatile("" ::: "memory");
}


struct Args { const float* in[15]; float* out; unsigned char* ws; int ph_lo, ph_hi; };
constexpr int NPHASE = 8;
__global__ void __launch_bounds__(NWAVES * 64, 2) mk_fwd(Args args) {
    extern __shared__ __attribute__((aligned(16))) unsigned char lds[];
    Frame F;
    F.lds = (LAS unsigned char*)lds; F.MISC = (volatile LAS unsigned*)(F.lds + MISC_OFF);
    F.tid = threadIdx.x; F.lane = F.tid & 63; F.wave = __builtin_amdgcn_readfirstlane(F.tid >> 6);
    F.G = gridDim.x; { const int bx = blockIdx.x; F.vcu = (F.G % 8 == 0) ? (bx % 8) * (F.G / 8) + bx / 8 : bx; }
    unsigned char* ws = args.ws; F.ws = ws; F.ctl = (gu32*)(ws + WS_CTL);
    F.x = args.in[0]; F.norm_mix = args.in[1]; F.w_in = args.in[2]; F.fbias = args.in[3]; F.cmp_pos = args.in[4]; F.cmp_w1 = args.in[5]; F.cmp_w2 = args.in[6]; F.w_branch = args.in[7];
    F.w_out = args.in[8]; F.norm_ffn = args.in[9]; F.peer_wq = args.in[10]; F.peer_sk = args.in[11]; F.peer_u = args.in[12]; F.peer_v = args.in[13]; F.norm_final = args.in[14]; F.out = args.out;
    for (int u = F.tid; u < (LDS_BYTES - LDSCTL_OFF) / 4; u += NWAVES * 64) ((LAS unsigned*)(F.lds + LDSCTL_OFF))[u] = 0u;
    __syncthreads();
    const int lo = args.ph_lo, hi = args.ph_hi;
    XcdBarrier bar; bar.bar = (unsigned*)(F.ctl + CW_BAR); bar.x = 0; bar.st = nullptr;
    if (hi - lo > 1) bar = xcd_barrier_post((unsigned*)(F.ctl + CW_BAR), F.MISC + 8);
#define IN(k) (lo <= (k) && (k) < hi)
#ifdef DBG_CHECK
    if (lo == 99) { dbg_check_inproj(F); __syncthreads(); dbg_check_cmp(F); __syncthreads(); dbg_check_attn(F); return; }
    if (lo == 100) { dbg_check_merged(F); return; }
    if (lo == 101) { dbg_check_h(F); return; }
    if (lo == 102) { dbg_check_scores(F); return; }
    if (lo == 103) { dbg_check_final(F); return; }
    if (lo == 104) { if (blockIdx.x == 0 && F.tid == 0) {
#ifdef DBG_SEL
        const float num = __hip_atomic_load((float*)(F.ctl + CW_L2) + DBG_SEL, RLX_AGENT), den = __hip_atomic_load((float*)(F.ctl + CW_L2) + 8 + DBG_SEL, RLX_AGENT);
        float v = 1000.0f * sqrtf(num / fmaxf(den, 1e-30f)); v = fminf(99.f, rintf(v)); F.out[0] = 10.0f * v + 5.0f;
#else
        const unsigned m = __hip_atomic_load(F.ctl + CW_DBG, RLX_AGENT); if (m) F.out[0] = 10.0f * (float)m;
#endif
    } return; }
#endif
#ifdef DBG_PHASE
#define SEAM(k) do { if (IN(k) && IN((k) + 1)) xcd_barrier(bar); if (blockIdx.x == 0 && F.tid == 0) ((unsigned long long*)(F.ctl + 12500))[(k) + 1] = __builtin_amdgcn_s_memrealtime(); } while (0)
#else
#define SEAM(k) do { if (IN(k) && IN((k) + 1)) xcd_barrier(bar); } while (0)
#endif
#ifdef DBG_PHASE
    if (blockIdx.x == 0 && F.tid == 0) ((unsigned long long*)(F.ctl + 12500))[0] = __builtin_amdgcn_s_memrealtime();
#endif
    if (IN(0)) { p0_prologue(F);
#ifdef DBG_DUP0
        xcd_barrier(bar); p0_prologue(F, true);
#endif
        SEAM(0); }
    if (IN(1)) {
        pg8::Gemm g{(const bf16*)(ws + WS_XN), (const bf16*)(ws + WS_WTIN), NTOK, NIN, 1024}; pg8::StaticOrder S; S.init(NTOK, NIN, F.G, (int)blockIdx.x);
        EpiIn E{ws, F.fbias};
        pg8::gemm_phase<EpiIn, pg8::StaticOrder, true, true>(F.lds, g, S, E);
#if defined(DBG_DUPG) && DBG_DUPG == 1
        xcd_barrier(bar); { EpiNull E2{F.ctl}; pg8::gemm_phase<EpiNull, pg8::StaticOrder, true, true>(F.lds, g, S, E2); }
#endif
#if defined(DBG_DUPG) && DBG_DUPG == 11
        xcd_barrier(bar); pg8::gemm_phase<EpiIn, pg8::StaticOrder, true, true>(F.lds, g, S, E);
#endif
        SEAM(1);
    }
    if (IN(2)) {
        for (int u = blockIdx.x; u < 256; u += F.G) p2_compress_unit(F, u);
#if DBG_DUP2 == 1
        xcd_barrier(bar); for (int u = blockIdx.x; u < 256; u += F.G) p2_compress_unit(F, u);
#endif
#if DBG_DUP2 == 2
        { const int gw = (int)blockIdx.x * NWAVES + F.wave; if (gw < 64) p2_cumsum_wave(F, gw); } xcd_barrier(bar);
#endif
        { const int gw = (int)blockIdx.x * NWAVES + F.wave; if (gw < 64) p2_cumsum_wave(F, gw); else if (F.G * NWAVES < 64) { for (int q = gw; q < 64; q += F.G * NWAVES) p2_cumsum_wave(F, q); } }
        SEAM(2);
    }
    if (IN(3)) {
        p3_attention(F);
#if DBG_DUP3
        xcd_barrier(bar); p3_attention(F, 64, DBG_DUP3);
#endif
        SEAM(3); }
    if (IN(4)) {
        pg8::Gemm g{(const bf16*)(ws + WS_Y), (const bf16*)(ws + WS_WTBR), 2 * NTOK, 2048, 512}; MergeOrder S{F.vcu, F.G};
        EpiMerge E{ws};
        pg8::gemm_phase<EpiMerge, MergeOrder, true, true>(F.lds, g, S, E);
        SEAM(4);
    }
    if (IN(5)) {
        pg8::Gemm g{(const bf16*)(ws + WS_MERGED), (const bf16*)(ws + WS_WTOUT), NTOK, 1024, 1024}; pg8::StaticOrder S; S.init(NTOK, 1024, F.G, (int)blockIdx.x);
        EpiOut E{ws, F.x, F.out, F.norm_ffn};
        pg8::gemm_phase<EpiOut, pg8::StaticOrder, true, true>(F.lds, g, S, E);
#if defined(DBG_DUPG) && DBG_DUPG == 5
        xcd_barrier(bar); { EpiNull E2{F.ctl}; pg8::gemm_phase<EpiNull, pg8::StaticOrder, true, true>(F.lds, g, S, E2); }
#endif
        SEAM(5);
    }
    if (IN(6)) {
        pg8::Gemm g{(const bf16*)(ws + WS_HBF), (const bf16*)(ws + WS_WTPEER), NTOK, 2048, 1024}; pg8::StaticOrder S; S.init(NTOK, 2048, F.G, (int)blockIdx.x);
        EpiScore E{(bf16*)(ws + WS_SC)};
#ifdef DBG_F32SCORES
        p6_naive(F);
#else
        pg8::gemm_phase<EpiScore, pg8::StaticOrder, true, true>(F.lds, g, S, E);
#endif
#if defined(DBG_DUPG) && DBG_DUPG == 6
        xcd_barrier(bar); { EpiNull E2{F.ctl}; pg8::gemm_phase<EpiNull, pg8::StaticOrder, true, true>(F.lds, g, S, E2); }
#endif
        SEAM(6);
    }
    if (IN(7)) {
        { const int gw = (int)blockIdx.x * NWAVES + F.wave, NGW = F.G * NWAVES;
          for (int g = gw; g < NTOK / 4; g += NGW) { Frame G = F; asm volatile("" : "+v"(G.tid), "+v"(G.lane)); p7_wave(G, g * 4); } }
#ifdef DBG_PHASE
        __syncthreads(); if (blockIdx.x == 0 && F.tid == 0) { const unsigned long long* ts = (const unsigned long long*)(F.ctl + 12500); const unsigned long long tend = __builtin_amdgcn_s_memrealtime();
            const unsigned long long a0 = ts[DBG_PHASE], a1 = (DBG_PHASE + 1 < 8) ? ts[DBG_PHASE + 1] : tend, b0 = ts[DBG_PHASE + 1], b1 = (DBG_PHASE + 2 < 8) ? ts[DBG_PHASE + 2] : tend;
            { (void)b0; (void)b1; const unsigned long long t1_ = __builtin_amdgcn_s_memrealtime(); while (__builtin_amdgcn_s_memrealtime() - t1_ < (a1 - a0)) __builtin_amdgcn_s_sleep(8); } }
#endif
#ifdef DBG_LOGITSTAT
        __syncthreads(); if (blockIdx.x == 0 && F.tid == 0) { const float v_ = __hip_atomic_load((float*)(F.ctl + 12400 + DBG_LOGITSTAT), RLX_AGENT); F.out[0] = 1000.0f * v_; }
#endif
    }
#undef IN
#undef SEAM
}

#ifndef MK_N_LAUNCHES
#define MK_N_LAUNCHES 1
#endif
extern "C" void kernel_launch(void* const* d_in, const int* in_sizes, int n_in, void* d_out, int out_size, void* d_ws, size_t ws_size, hipStream_t stream) {
    static int grid = 0;
    if (grid == 0) {
        if (n_in != 15 || out_size != NTOK * DM || ws_size < WS_END) { fprintf(stderr, "kernel_launch: unexpected shapes (n_in %d out %d ws %zu)\n", n_in, out_size, ws_size); grid = -1; return; }
        int dev = 0, cus = 0, per_cu = 0;
        if (hipGetDevice(&dev) != hipSuccess || hipDeviceGetAttribute(&cus, hipDeviceAttributeMultiprocessorCount, dev) != hipSuccess) { grid = -1; return; }
        if (hipFuncSetAttribute((const void*)mk_fwd, hipFuncAttributeMaxDynamicSharedMemorySize, LDS_BYTES) != hipSuccess) { fprintf(stderr, "kernel_launch: hipFuncSetAttribute failed\n"); grid = -1; return; }
        if (hipOccupancyMaxActiveBlocksPerMultiprocessor(&per_cu, (const void*)mk_fwd, NWAVES * 64, LDS_BYTES) != hipSuccess || per_cu < 1) { fprintf(stderr, "kernel_launch: occupancy query says %d blocks per CU\n", per_cu); (void)hipGetLastError(); grid = -1; return; }
        grid = cus;
    }
    if (grid < 0) return;
    if (hipMemsetAsync((char*)d_ws + WS_CTL, 0, CTL_ZERO_BYTES, stream) != hipSuccess) return;
    Args a{};
    for (int i = 0; i < 15; ++i) a.in[i] = (const float*)d_in[i];
    a.out = (float*)d_out; a.ws = (unsigned char*)d_ws;
    const int nl = MK_N_LAUNCHES;
    for (int li = 0; li < nl; ++li) {
        a.ph_lo = (nl == 1) ? 0 : li; a.ph_hi = (nl == 1) ? NPHASE : li + 1;
#ifdef DBG_CHECK
#if DBG_CHECK == 1
        if (li == 4) { Args c = a; c.ph_lo = 99; c.ph_hi = 100; hipLaunchKernelGGL(mk_fwd, dim3(grid), dim3(NWAVES * 64), LDS_BYTES, stream, c); }
#else
        if (li >= 5) { Args c = a; c.ph_lo = 95 + li; c.ph_hi = 96 + li; hipLaunchKernelGGL(mk_fwd, dim3(grid), dim3(NWAVES * 64), LDS_BYTES, stream, c); }
#endif
#endif
        hipLaunchKernelGGL(mk_fwd, dim3(grid), dim3(NWAVES * 64), LDS_BYTES, stream, a);
    }
#ifdef DBG_CHECK
    { Args c = a;
#if DBG_CHECK == 2
      c.ph_lo = 103; c.ph_hi = 104; hipLaunchKernelGGL(mk_fwd, dim3(grid), dim3(NWAVES * 64), LDS_BYTES, stream, c);
#endif
      c.ph_lo = 104; c.ph_hi = 105; hipLaunchKernelGGL(mk_fwd, dim3(grid), dim3(NWAVES * 64), LDS_BYTES, stream, c); }
#endif
}
```
